# Optimizing an MI355X kernel written in HIP

```python
import jax, jax.numpy as jnp
from jax import lax
import numpy as np

D_MODEL = 1024
BATCH = 32
SEQ = 2048
DEPTH = 1

CHUNK = 64
Q_BLOCK = 128
GLA_HEADS = 4
GLA_DK = 128
GLA_DV = 256
GLA_GATE_RANK = 16
GLA_GATE_TAU = 16.0
MLA_HEADS = 8
MLA_Q_RANK = 768
MLA_KV_RANK = 256
MLA_NOPE = 128
MLA_ROPE = 64
MLA_V = 128
ROPE_THETA = 10000.0
N_EXPERTS = 256
TOP_K = 8
N_GROUPS = 8
TOPK_GROUPS = 4
D_EXPERT = 256
ROUTED_SCALE = 2.5
MOE_BLOCK = 256
LN_EPS = 1e-5
RMS_EPS = 1e-6
DEEPNORM_ALPHA = (2.0 * DEPTH) ** 0.25
DEEPNORM_BETA = (8.0 * DEPTH) ** -0.25
IN_SPLITS = (GLA_HEADS * GLA_DK, GLA_HEADS * GLA_DK, GLA_HEADS * GLA_DV, GLA_HEADS * GLA_DV, GLA_GATE_RANK, MLA_Q_RANK, MLA_KV_RANK, MLA_ROPE, D_MODEL, D_MODEL)
IN_TOTAL = sum(IN_SPLITS)

kernel_name = "hybrid_gla_mla_moe_deepnorm_adaln"


def layer_norm(x, g, b):
    xf = x.astype(jnp.float32)
    mu = jnp.mean(xf, -1, keepdims=True)
    var = jnp.mean(jnp.square(xf - mu), -1, keepdims=True)
    return ((xf - mu) * lax.rsqrt(var + LN_EPS)).astype(x.dtype) * g + b


def rms_norm(x, g):
    xf = x.astype(jnp.float32)
    return (xf * lax.rsqrt(jnp.mean(xf * xf, -1, keepdims=True) + RMS_EPS)).astype(x.dtype) * g


def rope_tables(positions):
    half = MLA_ROPE // 2
    inv_freq = ROPE_THETA ** (-jnp.arange(half, dtype=jnp.float32) * (2.0 / MLA_ROPE))
    ang = positions.astype(jnp.float32)[..., None] * inv_freq
    return jnp.cos(ang), jnp.sin(ang)


def apply_rope(x, cos, sin):
    x1, x2 = jnp.split(x, 2, axis=-1)
    return jnp.concatenate([x1 * cos - x2 * sin, x2 * cos + x1 * sin], axis=-1).astype(x.dtype)


def gla_chunked(q, k, v, log_a):
    B, S = q.shape[:2]
    nc = S // CHUNK

    def chunks(t):
        return t.reshape(B, nc, CHUNK, *t.shape[2:]).swapaxes(0, 1).astype(jnp.float32)

    G = jnp.cumsum(chunks(log_a), axis=2)
    G_end = G[:, :, -1]
    k_dec = chunks(k) * jnp.exp(G_end[:, :, None] - G)

    def step(state, inp):
        q_c, k_c, v_c, g_end = inp
        state = state * jnp.exp(g_end)[..., None] + jnp.einsum('bchk,bchv->bhkv', k_c, v_c)
        return state, jnp.einsum('bchk,bhkv->bchv', q_c, state)

    state0 = jnp.zeros((B, GLA_HEADS, GLA_DK, GLA_DV), jnp.float32)
    _, o = lax.scan(step, state0, (chunks(q), k_dec, chunks(v), G_end))
    return o.swapaxes(0, 1).reshape(B, S, GLA_HEADS, GLA_DV)


def mla_attention(q_nope, q_rope, k_nope, k_rope, v):
    S = q_nope.shape[1]
    scale = (MLA_NOPE + MLA_ROPE) ** -0.5
    chunk_id = jnp.arange(S) // CHUNK
    outs = []
    for start in range(0, S, Q_BLOCK):
        end = start + Q_BLOCK
        s = (jnp.einsum('bqhd,bkhd->bhqk', q_nope[:, start:end], k_nope[:, :end])
             + jnp.einsum('bqhr,bkr->bhqk', q_rope[:, start:end], k_rope[:, :end]))
        s = s.astype(jnp.float32) * scale
        mask = chunk_id[None, :end] <= chunk_id[start:end, None]
        p = jax.nn.softmax(jnp.where(mask, s, -jnp.inf), axis=-1).astype(v.dtype)
        outs.append(jnp.einsum('bhqk,bkhv->bqhv', p, v[:, :end]))
    return jnp.concatenate(outs, axis=1)


def hybrid_mixer(h, cos, sin, w_in, w_gla_a2, b_gla_a, g_gla_norm, w_gla_o, g_cq, w_uq, g_ckv, w_ukv, w_mla_o, w_out):
    B, S, _ = h.shape
    bounds, acc = [], 0
    for n in IN_SPLITS[:-1]:
        acc += n
        bounds.append(acc)
    gq, gk, gv, gr, ga, cq, ckv, kr, gate_a, gate_b = jnp.split(h @ w_in, bounds, axis=-1)

    q = gq.reshape(B, S, GLA_HEADS, GLA_DK) * (GLA_DK ** -0.5)
    k = gk.reshape(B, S, GLA_HEADS, GLA_DK)
    v = gv.reshape(B, S, GLA_HEADS, GLA_DV)
    log_a = (jax.nn.log_sigmoid((ga @ w_gla_a2 + b_gla_a).astype(jnp.float32)) / GLA_GATE_TAU).reshape(B, S, GLA_HEADS, GLA_DK)
    o_a = gla_chunked(q, k, v, log_a).astype(h.dtype)
    o_a = rms_norm(o_a, g_gla_norm).reshape(B, S, GLA_HEADS * GLA_DV) * jax.nn.silu(gr)
    y_a = o_a @ w_gla_o

    qf = (rms_norm(cq, g_cq) @ w_uq).reshape(B, S, MLA_HEADS, MLA_NOPE + MLA_ROPE)
    q_nope = qf[..., :MLA_NOPE]
    q_rope = apply_rope(qf[..., MLA_NOPE:], cos[:, :, None], sin[:, :, None])
    kv = (rms_norm(ckv, g_ckv) @ w_ukv).reshape(B, S, MLA_HEADS, MLA_NOPE + MLA_V)
    k_nope, v_b = kv[..., :MLA_NOPE], kv[..., MLA_NOPE:]
    k_rope = apply_rope(kr, cos, sin)
    o_b = mla_attention(q_nope, q_rope, k_nope, k_rope, v_b).reshape(B, S, MLA_HEADS * MLA_V)
    y_b = o_b @ w_mla_o

    y = jax.nn.sigmoid(gate_a) * y_a + jax.nn.sigmoid(gate_b) * y_b
    return y @ w_out


def moe_ffn(h, w_router, b_router, w_e1, w_e3, w_e2, w_s1, w_s3, w_s2):
    B, S, D = h.shape
    N = B * S
    t = h.reshape(N, D)
    scores = jax.nn.sigmoid((t @ w_router).astype(jnp.float32))
    biased = scores + b_router.astype(jnp.float32)
    grp_score = lax.top_k(biased.reshape(N, N_GROUPS, N_EXPERTS // N_GROUPS), 2)[0].sum(-1)
    _, grp_idx = lax.top_k(grp_score, TOPK_GROUPS)
    grp_mask = jnp.sum(jax.nn.one_hot(grp_idx, N_GROUPS, dtype=jnp.float32), axis=1) > 0
    expert_mask = jnp.repeat(grp_mask, N_EXPERTS // N_GROUPS, axis=1)
    _, idx = lax.top_k(jnp.where(expert_mask, biased, -jnp.inf), TOP_K)
    w = jnp.take_along_axis(scores, idx, axis=1)
    w = w / jnp.sum(w, -1, keepdims=True) * ROUTED_SCALE

    A = N * TOP_K
    flat_e = idx.reshape(A).astype(jnp.int32)
    order = jnp.argsort(flat_e).astype(jnp.int32)
    sorted_e = flat_e[order]
    counts = jnp.bincount(flat_e, length=N_EXPERTS).astype(jnp.int32)
    padded = (counts + MOE_BLOCK - 1) // MOE_BLOCK * MOE_BLOCK
    pad_end = jnp.cumsum(padded)
    pad_start = pad_end - padded
    raw_start = jnp.cumsum(counts) - counts
    dest = pad_start[sorted_e] + jnp.arange(A, dtype=jnp.int32) - raw_start[sorted_e]
    n_slots = -(-A // MOE_BLOCK) * MOE_BLOCK + N_EXPERTS * MOE_BLOCK
    n_blocks = n_slots // MOE_BLOCK
    slot_tok = jnp.full((n_slots,), N, jnp.int32).at[dest].set(order // TOP_K)
    slot_w = jnp.zeros((n_slots,), h.dtype).at[dest].set(w.reshape(A)[order].astype(h.dtype))
    blk_start = jnp.arange(n_blocks, dtype=jnp.int32) * MOE_BLOCK
    blk_e = jnp.minimum(jnp.searchsorted(pad_end, blk_start, side='right'), N_EXPERTS - 1)
    t_pad = jnp.concatenate([t, jnp.zeros((1, D), t.dtype)], axis=0)

    def block_step(acc, inp):
        tok, wt, e = inp
        xb = t_pad[tok]
        hid = jax.nn.silu(xb @ w_e1[e]) * (xb @ w_e3[e])
        return acc.at[tok].add((hid @ w_e2[e]) * wt[:, None]), None

    acc0 = jnp.zeros((N + 1, D), h.dtype)
    acc, _ = lax.scan(block_step, acc0, (slot_tok.reshape(n_blocks, MOE_BLOCK), slot_w.reshape(n_blocks, MOE_BLOCK), blk_e))
    shared = (jax.nn.silu(t @ w_s1) * (t @ w_s3)) @ w_s2
    return (acc[:N] + shared).reshape(B, S, D)


def setup_inputs(seed: int = 0) -> dict:
    key = jax.random.key(seed)
    ks = iter(jax.random.split(key, 40))
    L, D, F = DEPTH, D_MODEL, D_EXPERT

    def nrm(shape, fan_in, scale=1.0):
        return jax.random.normal(next(ks), shape, jnp.float32) * (scale * fan_in ** -0.5)

    def gain(shape):
        return 1.0 + 0.02 * jax.random.normal(next(ks), shape, jnp.float32)

    def small(shape, s):
        return s * jax.random.normal(next(ks), shape, jnp.float32)

    x = jax.random.normal(next(ks), (BATCH, SEQ, D), jnp.float32)
    c = jax.random.normal(next(ks), (BATCH, D), jnp.float32)
    offset = jax.random.randint(next(ks), (BATCH, 1), 0, 4096, dtype=jnp.int32)
    positions = offset + jnp.arange(SEQ, dtype=jnp.int32)[None, :]
    return {
        "x": x, "c": c, "positions": positions,
        "w_ada": nrm((L, D, 6 * D), D, 0.1), "b_ada": small((L, 6 * D), 0.02),
        "w_in": nrm((L, D, IN_TOTAL), D),
        "w_gla_a2": nrm((L, GLA_GATE_RANK, GLA_HEADS * GLA_DK), GLA_GATE_RANK),
        "b_gla_a": small((L, GLA_HEADS * GLA_DK), 0.1),
        "g_gla_norm": gain((L, GLA_DV)),
        "w_gla_o": nrm((L, GLA_HEADS * GLA_DV, D), GLA_HEADS * GLA_DV),
        "g_cq": gain((L, MLA_Q_RANK)),
        "w_uq": nrm((L, MLA_Q_RANK, MLA_HEADS * (MLA_NOPE + MLA_ROPE)), MLA_Q_RANK),
        "g_ckv": gain((L, MLA_KV_RANK)),
        "w_ukv": nrm((L, MLA_KV_RANK, MLA_HEADS * (MLA_NOPE + MLA_V)), MLA_KV_RANK),
        "w_mla_o": nrm((L, MLA_HEADS * MLA_V, D), MLA_HEADS * MLA_V),
        "w_out": nrm((L, D, D), D, DEEPNORM_BETA),
        "ln1_g": gain((L, D)), "ln1_b": small((L, D), 0.02),
        "w_router": nrm((L, D, N_EXPERTS), D), "b_router": small((L, N_EXPERTS), 0.01),
        "w_e1": nrm((L, N_EXPERTS, D, F), D), "w_e3": nrm((L, N_EXPERTS, D, F), D),
        "w_e2": nrm((L, N_EXPERTS, F, D), F, DEEPNORM_BETA),
        "w_s1": nrm((L, D, F), D), "w_s3": nrm((L, D, F), D),
        "w_s2": nrm((L, F, D), F, DEEPNORM_BETA),
        "ln2_g": gain((L, D)), "ln2_b": small((L, D), 0.02),
    }


def reference(x, c, positions, w_ada, b_ada, w_in, w_gla_a2, b_gla_a, g_gla_norm, w_gla_o, g_cq, w_uq, g_ckv, w_ukv, w_mla_o, w_out, ln1_g, ln1_b, w_router, b_router, w_e1, w_e3, w_e2, w_s1, w_s3, w_s2, ln2_g, ln2_b):
    cos, sin = rope_tables(positions)
    cond = jax.nn.silu(c)
    for l in range(DEPTH):
        mod = (cond @ w_ada[l] + b_ada[l])[:, None, :]
        sh1, sc1, gt1, sh2, sc2, gt2 = jnp.split(mod, 6, axis=-1)
        h = x * (1 + sc1) + sh1
        mix = hybrid_mixer(h, cos, sin, w_in[l], w_gla_a2[l], b_gla_a[l], g_gla_norm[l], w_gla_o[l], g_cq[l], w_uq[l], g_ckv[l], w_ukv[l], w_mla_o[l], w_out[l])
        x = layer_norm(DEEPNORM_ALPHA * x + (1 + gt1) * mix, ln1_g[l], ln1_b[l])
        h = x * (1 + sc2) + sh2
        ffn = moe_ffn(h, w_router[l], b_router[l], w_e1[l], w_e3[l], w_e2[l], w_s1[l], w_s3[l], w_s2[l])
        x = layer_norm(DEEPNORM_ALPHA * x + (1 + gt2) * ffn, ln2_g[l], ln2_b[l])
    return x
```

```cpp
#include <hip/hip_runtime.h>
#include <cstdio>
#include <cstdint>

#ifndef MK_ONE_LAUNCH
#define MK_ONE_LAUNCH 1
#endif

#define GAS __attribute__((address_space(1)))
#define LAS __attribute__((address_space(3)))
typedef unsigned short bf16_t;
typedef short bf16x8 __attribute__((ext_vector_type(8)));
typedef short bf16x4 __attribute__((ext_vector_type(4)));
typedef float f32x4 __attribute__((ext_vector_type(4)));
typedef float f32x2 __attribute__((ext_vector_type(2)));
typedef unsigned u32x4 __attribute__((ext_vector_type(4)));
typedef unsigned u32x2 __attribute__((ext_vector_type(2)));

constexpr int NTOK = 65536, DM = 1024, SEQ = 2048, NB = 32;
constexpr int NWG = 256, NTHR = 512;
constexpr float LN_EPS = 1e-5f, RMS_EPS = 1e-6f;
constexpr float ALPHA = 1.189207115002721f;
constexpr float QSCALE = 0.07216878364870322f * 1.4426950408889634f;
constexpr int NSLOT = 589824;

constexpr size_t MiB = 1u << 20;
constexpr size_t WS_CTL = 0, CTL_ZERO_BYTES = 3 * MiB;
constexpr size_t WS_BAR = 16384;
constexpr size_t WS_MOD = 1 * MiB;
constexpr size_t WS_CQSS = 2 * MiB, WS_CKVSS = 2 * MiB + 256 * 1024;
constexpr size_t WS_TAB = 3 * MiB;
constexpr size_t WS_CNTWG = 3 * MiB + 64 * 1024;
constexpr size_t WS_WIN = 4 * MiB;
constexpr size_t WS_WGLAO = WS_WIN + 6400 * 1024 * 2;
constexpr size_t WS_WUQ = WS_WGLAO + 2 * MiB;
constexpr size_t WS_WUKV = WS_WUQ + 1536 * 768 * 2;
constexpr size_t WS_WMLAO = WS_WUKV + 1 * MiB;
constexpr size_t WS_WOUT = WS_WMLAO + 2 * MiB;
constexpr size_t WS_WRT = WS_WOUT + 2 * MiB;
constexpr size_t WS_WS13 = WS_WRT + 512 * 1024;
constexpr size_t WS_WS2 = WS_WS13 + 1 * MiB;
static_assert(WS_WS2 + 512 * 1024 <= 28 * MiB, "small weights");
constexpr size_t WS_TIDX = 28 * MiB, WS_TW = 30 * MiB, WS_LRANK = 32 * MiB, WS_STOK = 34 * MiB, WS_SW = 37 * MiB;
constexpr size_t WS_WIN8 = 52 * MiB;
constexpr size_t WS_KR = 40 * MiB;
constexpr size_t WS_GA = 48 * MiB;
constexpr size_t WS_BIG0 = 56 * MiB, BIGU = 128 * MiB;
#define WS_BIG(i) (WS_BIG0 + (size_t)(i) * BIGU)
constexpr size_t WS_END = WS_BIG0 + 8 * BIGU;

typedef __bf16 bf16v2_t __attribute__((ext_vector_type(2)));
__device__ __forceinline__ unsigned pk2(float lo, float hi) { const f32x2 v = {lo, hi}; const bf16v2_t r = __builtin_convertvector(v, bf16v2_t); return __builtin_bit_cast(unsigned, r); }
__device__ __forceinline__ float bflo(unsigned w) { return __uint_as_float(w << 16); }
__device__ __forceinline__ float bfhi(unsigned w) { return __uint_as_float(w & 0xffff0000u); }
__device__ __forceinline__ float bf2f(bf16_t b) { return __uint_as_float(((unsigned)b) << 16); }
__device__ __forceinline__ bf16_t f2bf(float f) { return (bf16_t)(pk2(f, 0.f) & 0xffffu); }
__device__ __forceinline__ float sigm(float x) { return __builtin_amdgcn_rcpf(1.0f + __expf(-x)); }
__device__ __forceinline__ float silu(float x) { return x * __builtin_amdgcn_rcpf(1.0f + __expf(-x)); }
__device__ __forceinline__ float wave_sum(float v) {
#pragma unroll
    for (int o = 1; o < 64; o <<= 1) v += __shfl_xor(v, o);
    return v;
}
#define LDS_WAIT() asm volatile("s_waitcnt lgkmcnt(0)" ::: "memory")
#define VM_WAIT() asm volatile("s_waitcnt vmcnt(0)" ::: "memory")

#define XB_TMO      128
#define XB_XCNT(j)  (256  + 64 * (j))
#define XB_XSUB(j)  (1280 + 64 * (j))
#define XB_XGEN(j)  (2304 + 64 * (j))
#define XB_TOP      3328
#define XB_TOPGEN   3392
#define XCD_BAR_WORDS 3456
#define XB_SPIN_CAP (1u << 18)
__device__ __forceinline__ unsigned xb_ld(unsigned* p)              { return __hip_atomic_load(p, __ATOMIC_RELAXED, __HIP_MEMORY_SCOPE_AGENT); }
__device__ __forceinline__ unsigned xb_add(unsigned* p, unsigned v) { return __hip_atomic_fetch_add(p, v, __ATOMIC_RELAXED, __HIP_MEMORY_SCOPE_AGENT); }
__device__ __forceinline__ unsigned xb_xcc_id() { return (unsigned)__builtin_amdgcn_s_getreg((3 << 11) | 20) & 0xFu; }
#define XB_SPIN(cond, bar) do { unsigned _sp = 0; while (cond) { __builtin_amdgcn_s_sleep(1); \
    if ((++_sp & 255u) == 0u) { if (xb_ld(&(bar)[XB_TMO])) break; if (_sp > XB_SPIN_CAP) { atomicAdd(&(bar)[XB_TMO], 1u); break; } } } } while (0)
struct XcdBarrier { unsigned* bar; unsigned x; volatile LAS unsigned* st; };
__device__ __forceinline__ XcdBarrier xcd_barrier_post(unsigned* bar, volatile LAS unsigned* st) {
    XcdBarrier b; b.bar = bar; b.x = xb_xcc_id(); b.st = st;
    if (threadIdx.x == 0) (void)xb_add(&bar[XB_XCNT(b.x)], 1u);
    return b;
}
__device__ __forceinline__ void xcd_barrier_complete(unsigned* bar, unsigned x, unsigned& nloc, unsigned& nx) {
    const unsigned G = gridDim.x * gridDim.y * gridDim.z;
    unsigned sum, cnt, mine, sp = 0u;
    for (;;) {
        sum = 0u; cnt = 0u; mine = 0u;
#pragma unroll
        for (unsigned j = 0; j < 16; ++j) { const unsigned c = xb_ld(&bar[XB_XCNT(j)]); sum += c; cnt += (c > 0u) ? 1u : 0u; mine = (j == x) ? c : mine; }
        if (sum == G) break;
        __builtin_amdgcn_s_sleep(1);
        if ((++sp & 255u) == 0u) { if (xb_ld(&bar[XB_TMO])) break; if (sp > XB_SPIN_CAP) { atomicAdd(&bar[XB_TMO], 1u); break; } }
    }
    nloc = mine > 0u ? mine : 1u; nx = cnt > 0u ? cnt : 1u;
}
__device__ __forceinline__ void xcd_barrier(const XcdBarrier& b) {
    asm volatile("s_waitcnt vmcnt(0)" ::: "memory");
    __syncthreads();
    if (threadIdx.x == 0) {
        unsigned* bar = b.bar;
        __builtin_amdgcn_s_waitcnt(0);
        unsigned nloc = b.st[0], nx = b.st[1];
        if (nloc == 0u) { xcd_barrier_complete(bar, b.x, nloc, nx); b.st[0] = nloc; b.st[1] = nx; }
        const unsigned old = xb_add(&bar[XB_XSUB(b.x)], 1u);
        const unsigned gen = old / nloc;
        if (old + 1u == (gen + 1u) * nloc) {
            __builtin_amdgcn_fence(__ATOMIC_RELEASE, "agent");
            asm volatile("s_waitcnt vmcnt(0)" ::: "memory");
            const unsigned og = xb_add(&bar[XB_TOP], 1u);
            const unsigned tg = og / nx;
            if (og + 1u == (tg + 1u) * nx) xb_add(&bar[XB_TOPGEN], 1u);
            else XB_SPIN(xb_ld(&bar[XB_TOPGEN]) == tg, bar);
            __builtin_amdgcn_fence(__ATOMIC_ACQUIRE, "agent");
            xb_add(&bar[XB_XGEN(b.x)], 1u);
            asm volatile("s_waitcnt vmcnt(0)" ::: "memory");
        } else {
            XB_SPIN(xb_ld(&bar[XB_XGEN(b.x)]) == gen, bar);
            __builtin_amdgcn_fence(__ATOMIC_ACQUIRE, "agent");
            asm volatile("s_waitcnt vmcnt(0)" ::: "memory");
        }
    }
    __syncthreads();
}
__device__ __forceinline__ void wg_global_sync() {
    asm volatile("s_waitcnt vmcnt(0)" ::: "memory");
    __syncthreads();
    if (threadIdx.x < 64) {
        __builtin_amdgcn_fence(__ATOMIC_ACQUIRE, "agent");
        asm volatile("s_waitcnt vmcnt(0)" ::: "memory");
    }
    __syncthreads();
}

namespace pg8 {
constexpr int BM = 256, BK = 64, HALF = 128, HTB = HALF * BK * 2, STAGE_BYTES = 8 * HTB;
__host__ __device__ __forceinline__ int lds_byte(int r, int c) { const int st = (r >> 4) * 2 + (c >> 5), rr = r & 15, cc = c & 31, ob = rr * 64 + cc * 2; return st * 1024 + (ob ^ (((ob >> 9) & 1) << 5)); }
__host__ __device__ __forceinline__ void stage_rc(int b, int& R, int& C) { const int st = b / 1024, sb = b % 1024, swz = sb ^ (((sb >> 9) & 1) << 5); R = (st >> 1) * 16 + swz / 64; C = (st & 1) * 32 + (swz % 64) / 2; }
__host__ __device__ __forceinline__ int perm32(int rho) { const int n = rho >> 4, i = rho & 15; return 8 * (i >> 2) + 4 * n + (i & 3); }
struct Unit { int pm, pn; };
struct Gemm { const bf16_t* A; const bf16_t* Bt; int K; const int* rowidx; };
struct StaticOrder {
    int nM, nN, nwg, G, c, remap;
    __device__ void init(int M, int N, int G_, int c_) { nM = M / BM; nN = N / BM; nwg = nM * nN; G = G_; c = c_; remap = 0; }
    __device__ bool next(int i, Unit& u) const {
        const long L = (long)i * G + c; if (L >= nwg) return false;
        int wgid = (int)L; { const int q = nwg / 8, r = nwg % 8, xcd = wgid % 8, off = wgid / 8; wgid = (xcd < r ? xcd * (q + 1) : r * (q + 1) + (xcd - r) * q) + off; }
        const int nig = 8 * nN, gid = wgid / nig, fm = gid * 8, gsz = (nM - fm) < 8 ? (nM - fm) : 8;
        u.pm = fm + ((wgid % nig) % gsz); u.pn = (wgid % nig) / gsz; if (remap) u.pn = u.pn < 8 ? u.pn : u.pn < 12 ? u.pn + 4 : 24; return true;
    }
};
struct PanelOrder {
    int pm, nN, pn0;
    __device__ bool next(int i, Unit& u) const { int nq = nN; asm volatile("; opaque nN" : "+s"(nq)); if (i >= nq) return false; int a = pm, b = pn0 + i; asm volatile("; opaque unit" : "+s"(a), "+s"(b)); u.pm = a; u.pn = b; return true; }
};

typedef int i32x8 __attribute__((ext_vector_type(8)));
template <class Epi, class Sched, bool GATHER, bool FP8 = false>
__device__ __forceinline__ void gemm_phase(LAS unsigned char* lds, const Gemm g, const Sched& S, const Epi& E) {
    int tid_ = threadIdx.x; asm volatile("; pg8 ids" : "+v"(tid_));
    const int tid = tid_, wid = __builtin_amdgcn_readfirstlane(tid >> 6), lane = tid & 63, wr = wid >> 2, wc = wid & 3, fr = lane & 15, fq = lane >> 4;
    int Kq = g.K; asm volatile("; opaque K" : "+s"(Kq));
    const int K = Kq, nt = K / BK;
    Unit cur, nxt; int ui = 0;
    if (!S.next(0, cur)) return;
    unsigned aoff[2][2], voffB[2];
#pragma unroll
    for (int i = 0; i < 2; ++i) { int R, C; stage_rc(tid * 16 + i * 8192, R, C); const int Rb = Epi::PERM ? ((R & ~31) + perm32(R & 31)) : R;
        voffB[i] = (unsigned)(Rb * K + C) * 2u;
#pragma unroll
        for (int h = 0; h < 2; ++h) {
            if (GATHER) { int t = g.rowidx[cur.pm * BM + h * HALF + R]; t = t < 0 ? 0 : t; aoff[h][i] = (unsigned)(t * K + C) * 2u; }
            else aoff[h][i] = (unsigned)((h * HALF + R) * K + C) * 2u;
        } }
    const size_t kstep = (size_t)(BK * 2);
    const size_t hstep = (size_t)HALF * K * 2;
    const size_t tstep = 2 * hstep;
    const unsigned ldsw = (unsigned)wid * 1024u;
    const int aoffl0 = lds_byte(wr * 64 + fr, fq * 8), aoffl1 = aoffl0 + 1024;
    const int boffl0 = lds_byte(wc * 32 + fr, fq * 8), boffl1 = boffl0 + 1024;
#define PG8_SA(b, h) (((b) * 2 + (h)) * HTB)
#define PG8_SB(b, h) ((4 + (b) * 2 + (h)) * HTB)
#define PG8_STAGE(bufoff, gbase, voff) do { _Pragma("unroll") for (int _i = 0; _i < 2; ++_i) \
        __builtin_amdgcn_global_load_lds((const unsigned*)((const char*)(gbase) + (voff)[_i]), (LAS unsigned*)(lds + (bufoff) + ldsw + _i * 8192), 16, 0, 0); } while (0)
#define PG8_STAGE_A(bufoff, gbase, h) PG8_STAGE(bufoff, gbase, aoff[h])
#define PG8_LDA(dst, b, h) do { _Pragma("unroll") for (int m = 0; m < 4; ++m) _Pragma("unroll") for (int k = 0; k < 2; ++k) dst[m][k] = *(const LAS bf16x8*)(lds + PG8_SA(b, h) + aoffl0 + m * 2048 + k * 1024); } while (0)
#define PG8_LDA8(dst, b, h) do { _Pragma("unroll") for (int m = 0; m < 4; ++m) { const u32x4 x0_ = *(const LAS u32x4*)(lds + PG8_SA(b, h) + aoffl0 + m * 2048), x1_ = *(const LAS u32x4*)(lds + PG8_SA(b, h) + aoffl1 + m * 2048); dst[m] = __builtin_bit_cast(i32x8, __builtin_shufflevector(x0_, x1_, 0, 1, 2, 3, 4, 5, 6, 7)); } } while (0)
#define PG8_LDB(dst, b, h) do { _Pragma("unroll") for (int n = 0; n < 2; ++n) _Pragma("unroll") for (int k = 0; k < 2; ++k) dst[n][k] = *(const LAS bf16x8*)(lds + PG8_SB(b, h) + boffl0 + n * 2048 + k * 1024); } while (0)
#define PG8_LDB8(dst, b, h) do { _Pragma("unroll") for (int n = 0; n < 2; ++n) { const u32x4 x0_ = *(const LAS u32x4*)(lds + PG8_SB(b, h) + boffl0 + n * 2048), x1_ = *(const LAS u32x4*)(lds + PG8_SB(b, h) + boffl1 + n * 2048); dst[n] = __builtin_bit_cast(i32x8, __builtin_shufflevector(x0_, x1_, 0, 1, 2, 3, 4, 5, 6, 7)); } } while (0)
#define PG8_MMA(ai, bj, At, Bt) do { __builtin_amdgcn_s_setprio(1); _Pragma("unroll") for (int m = 0; m < 4; ++m) _Pragma("unroll") for (int n = 0; n < 2; ++n) _Pragma("unroll") for (int k = 0; k < 2; ++k) \
        acc[ai][bj][m][n] = __builtin_amdgcn_mfma_f32_16x16x32_bf16(Bt[n][k], At[m][k], acc[ai][bj][m][n], 0, 0, 0); __builtin_amdgcn_s_setprio(0); } while (0)
#define PG8_MMA8(ai, bj, At, Bt) do { __builtin_amdgcn_s_setprio(1); _Pragma("unroll") for (int m = 0; m < 4; ++m) _Pragma("unroll") for (int n = 0; n < 2; ++n) \
        asm volatile("v_mfma_f32_16x16x128_f8f6f4 %0, %1, %2, %0" : "+v"(acc[ai][bj][m][n]) : "v"(Bt[n]), "v"(At[m])); __builtin_amdgcn_s_setprio(0); } while (0)
#define PG8_WAIT_V(n) asm volatile("s_waitcnt vmcnt(" #n ")" ::: "memory")
#define PG8_WAIT_L(n) asm volatile("s_waitcnt lgkmcnt(" #n ")" ::: "memory")
#define PG8_BAR __builtin_amdgcn_s_barrier()
#define PG8_SCHED __builtin_amdgcn_sched_barrier(0)
    f32x4 acc[2][2][4][2];
#pragma unroll
    for (int a = 0; a < 2; ++a)
#pragma unroll
        for (int b = 0; b < 2; ++b)
#pragma unroll
            for (int m = 0; m < 4; ++m)
#pragma unroll
                for (int n = 0; n < 2; ++n) acc[a][b][m][n] = (f32x4){0.f, 0.f, 0.f, 0.f};
    bf16x8 At[4][2], B0[2][2], B1[2][2]; i32x8 At8[4], B08[2], B18[2];
    const char* cA = (const char*)g.A + (GATHER ? (size_t)0 : (size_t)cur.pm * tstep); const char* cB = (const char*)g.Bt + (size_t)cur.pn * tstep;
    if (GATHER) PG8_WAIT_V(0);
    PG8_STAGE(PG8_SB(0, 0), cB, voffB); PG8_STAGE_A(PG8_SA(0, 0), cA, 0); PG8_STAGE(PG8_SB(0, 1), cB + hstep, voffB); PG8_STAGE_A(PG8_SA(0, 1), cA, 1);
    if (wr == 1) PG8_BAR;
    PG8_WAIT_V(4); PG8_BAR;
    PG8_STAGE(PG8_SB(1, 0), cB + kstep, voffB); PG8_STAGE_A(PG8_SA(1, 0), cA + kstep, 0); PG8_STAGE(PG8_SB(1, 1), cB + hstep + kstep, voffB);
    PG8_WAIT_V(6); PG8_BAR;
    for (;;) {
        const bool has_next = S.next(ui + 1, nxt);
        const char* nA = has_next ? (const char*)g.A + (GATHER ? (size_t)0 : (size_t)nxt.pm * tstep) : cA; const char* nB = has_next ? (const char*)g.Bt + (size_t)nxt.pn * tstep : cB;
        for (int t = 0; t < nt; t += 2) {
            const bool last = (t == nt - 2);
            const char* a1 = cA + (size_t)(t + 1) * kstep;
            const char* a2 = last ? nA : cA + (size_t)(t + 2) * kstep; const char* b2 = last ? nB : cB + (size_t)(t + 2) * kstep;
            const char* a3 = a2 + kstep; const char* b3 = b2 + kstep;
            if constexpr (FP8) {
            PG8_LDB8(B08, 0, 0); PG8_SCHED; PG8_LDA8(At8, 0, 0); PG8_STAGE_A(PG8_SA(1, 1), a1, 1);
            PG8_WAIT_L(8); PG8_BAR; PG8_WAIT_L(0); PG8_MMA8(0, 0, At8, B08); PG8_BAR; PG8_SCHED;
            PG8_LDB8(B18, 0, 1); PG8_STAGE(PG8_SB(0, 0), b2, voffB);
            PG8_BAR; PG8_WAIT_L(0); PG8_MMA8(0, 1, At8, B18); PG8_BAR;
            PG8_LDA8(At8, 0, 1); PG8_STAGE_A(PG8_SA(0, 0), a2, 0);
            PG8_BAR; PG8_WAIT_L(0); PG8_MMA8(1, 0, At8, B08); PG8_BAR; PG8_SCHED;
            PG8_STAGE(PG8_SB(0, 1), b2 + hstep, voffB);
            PG8_WAIT_V(6); PG8_BAR; PG8_MMA8(1, 1, At8, B18); PG8_BAR;
            PG8_LDB8(B08, 1, 0); PG8_SCHED; PG8_LDA8(At8, 1, 0); PG8_STAGE_A(PG8_SA(0, 1), a2, 1);
            PG8_WAIT_L(8); PG8_BAR; PG8_WAIT_L(0); PG8_MMA8(0, 0, At8, B08); PG8_BAR; PG8_SCHED;
            PG8_LDB8(B18, 1, 1); PG8_STAGE(PG8_SB(1, 0), b3, voffB);
            PG8_BAR; PG8_WAIT_L(0); PG8_MMA8(0, 1, At8, B18); PG8_BAR;
            PG8_LDA8(At8, 1, 1); PG8_STAGE_A(PG8_SA(1, 0), a3, 0);
            PG8_BAR; PG8_WAIT_L(0); PG8_MMA8(1, 0, At8, B08); PG8_BAR; PG8_SCHED;
            PG8_STAGE(PG8_SB(1, 1), b3 + hstep, voffB);
            PG8_WAIT_V(6); PG8_BAR; PG8_MMA8(1, 1, At8, B18); PG8_BAR;
            } else {
            PG8_LDB(B0, 0, 0); PG8_SCHED; PG8_LDA(At, 0, 0); PG8_STAGE_A(PG8_SA(1, 1), a1, 1);
            PG8_WAIT_L(8); PG8_BAR; PG8_WAIT_L(0); PG8_MMA(0, 0, At, B0); PG8_BAR; PG8_SCHED;
            PG8_LDB(B1, 0, 1); PG8_STAGE(PG8_SB(0, 0), b2, voffB);
            PG8_BAR; PG8_WAIT_L(0); PG8_MMA(0, 1, At, B1); PG8_BAR;
            PG8_LDA(At, 0, 1); PG8_STAGE_A(PG8_SA(0, 0), a2, 0);
            PG8_BAR; PG8_WAIT_L(0); PG8_MMA(1, 0, At, B0); PG8_BAR; PG8_SCHED;
            PG8_STAGE(PG8_SB(0, 1), b2 + hstep, voffB);
            PG8_WAIT_V(6); PG8_BAR; PG8_MMA(1, 1, At, B1); PG8_BAR;
            PG8_LDB(B0, 1, 0); PG8_SCHED; PG8_LDA(At, 1, 0); PG8_STAGE_A(PG8_SA(0, 1), a2, 1);
            PG8_WAIT_L(8); PG8_BAR; PG8_WAIT_L(0); PG8_MMA(0, 0, At, B0); PG8_BAR; PG8_SCHED;
            PG8_LDB(B1, 1, 1); PG8_STAGE(PG8_SB(1, 0), b3, voffB);
            PG8_BAR; PG8_WAIT_L(0); PG8_MMA(0, 1, At, B1); PG8_BAR;
            PG8_LDA(At, 1, 1); PG8_STAGE_A(PG8_SA(1, 0), a3, 0);
            PG8_BAR; PG8_WAIT_L(0); PG8_MMA(1, 0, At, B0); PG8_BAR; PG8_SCHED;
            PG8_STAGE(PG8_SB(1, 1), b3 + hstep, voffB);
            PG8_WAIT_V(6); PG8_BAR; PG8_MMA(1, 1, At, B1); PG8_BAR;
            }
        }
        if constexpr (FP8) asm volatile("s_nop 15\n\ts_nop 15\n\ts_nop 15\n\ts_nop 15" ::: "memory");
        E(acc, cur, wr, wc, fr, fq);
        if (!has_next) break;
#pragma unroll
        for (int a = 0; a < 2; ++a)
#pragma unroll
            for (int b = 0; b < 2; ++b)
#pragma unroll
                for (int m = 0; m < 4; ++m)
#pragma unroll
                    for (int n = 0; n < 2; ++n) acc[a][b][m][n] = (f32x4){0.f, 0.f, 0.f, 0.f};
        cur = nxt; cA = nA; cB = nB; ++ui;
    }
    PG8_WAIT_V(0);
    if (wr == 0) PG8_BAR;
    PG8_BAR;
#undef PG8_SA
#undef PG8_SB
#undef PG8_STAGE
#undef PG8_STAGE_A
#undef PG8_LDA
#undef PG8_LDB
#undef PG8_MMA
#undef PG8_MMA8
#undef PG8_LDA8
#undef PG8_LDB8
#undef PG8_WAIT_V
#undef PG8_WAIT_L
#undef PG8_BAR
#undef PG8_SCHED
}
}
using pg8::Unit;
typedef f32x4 AccT[2][2][4][2];

typedef float f32x16 __attribute__((ext_vector_type(16)));
#ifndef K256_DIST
#define K256_DIST 2
#endif
constexpr int K256_BUF = 32768, K256_NB = 3, K256_SCR_OFF = K256_NB * K256_BUF, K256_SCR_WAVE = 4608;
struct K256Store {
    bf16_t* O; int ld; const float* rs; float rs_mul; bf16_t* O2; int split; int fp8;
};
constexpr float F8_SCALE = 16.0f;
__device__ __forceinline__ void gemm_k256(LAS unsigned char* lds, const bf16_t* A, const bf16_t* Bt, int nchunks, int row0, const K256Store& E) {
    int tid_ = threadIdx.x; asm volatile("; k256 ids" : "+v"(tid_));
    const int tid = tid_, lane = tid & 63, wave = __builtin_amdgcn_readfirstlane(tid >> 6), r = lane & 31, h = lane >> 5;
    bf16x8 af[16];
    { const bf16_t* arow = A + (size_t)(32 * wave + r) * 256 + 8 * h;
#pragma unroll
      for (int s = 0; s < 16; ++s) af[s] = *(const bf16x8*)(arow + 16 * s); }
    float rscale = 1.0f;
    if (E.rs) rscale = rsqrtf(E.rs[row0 + 32 * wave + r] * E.rs_mul + RMS_EPS);
    unsigned foff[4];
#pragma unroll
    for (int q = 0; q < 4; ++q) { const int n = 2 * (4 * wave + q) + (lane >> 5); foff[q] = (unsigned)(n * 256 + (((lane & 31) ^ (n & 15)) << 3)) * 2u; }
#define K256_FILL(chunk, buf) do { const char* _src = (const char*)Bt + (size_t)(chunk) * (64 * 256 * 2); _Pragma("unroll") for (int q = 0; q < 4; ++q) \
        __builtin_amdgcn_global_load_lds((const unsigned*)(_src + foff[q]), (LAS unsigned*)(lds + (buf) * K256_BUF + (4 * wave + q) * 1024), 16, 0, 0); } while (0)
    K256_FILL(0, 0);
    if (K256_DIST == 2 && nchunks > 1) K256_FILL(1, 1);
    const int boff = (r * 32) * 16;
    LAS unsigned char* scr = lds + K256_SCR_OFF + wave * K256_SCR_WAVE;
    for (int i = 0; i < nchunks; ++i) {
        {
            const int ns = E.fp8 ? 2 : 4;
            const int yo = K256_DIST == 2 ? ns * ((i >= 2 ? 1 : 0) + (i >= 1 ? 1 : 0)) + (i + 1 < nchunks ? 4 : 0) : ns * (i >= 1 ? 1 : 0);
            if (yo >= 12) asm volatile("s_waitcnt vmcnt(12)" ::: "memory"); else if (yo >= 8) asm volatile("s_waitcnt vmcnt(8)" ::: "memory");
            else if (yo >= 6) asm volatile("s_waitcnt vmcnt(6)" ::: "memory"); else if (yo >= 4) asm volatile("s_waitcnt vmcnt(4)" ::: "memory");
            else if (yo >= 2) asm volatile("s_waitcnt vmcnt(2)" ::: "memory"); else asm volatile("s_waitcnt vmcnt(0)" ::: "memory");
        }
        __builtin_amdgcn_s_barrier(); asm volatile("" ::: "memory");
        if (i + K256_DIST < nchunks) K256_FILL(i + K256_DIST, (i + K256_DIST) % K256_NB);
        const LAS unsigned char* bb = lds + (i % K256_NB) * K256_BUF + boff;
        f32x16 acc0, acc1;
#pragma unroll
        for (int j = 0; j < 16; ++j) { acc0[j] = 0.f; acc1[j] = 0.f; }
        {
            bf16x8 bq[3][2];
#define K256_LDB(s_) do { const int co_ = (((2 * (s_) + h) ^ (r & 15)) << 4); bq[(s_) % 3][0] = *(const LAS bf16x8*)(bb + co_); bq[(s_) % 3][1] = *(const LAS bf16x8*)(bb + 32 * 512 + co_); } while (0)
            K256_LDB(0); K256_LDB(1);
#pragma unroll
            for (int s = 0; s < 16; ++s) {
                if (s + 2 < 16) K256_LDB(s + 2);
                acc0 = __builtin_amdgcn_mfma_f32_32x32x16_bf16(bq[s % 3][0], af[s], acc0, 0, 0, 0);
                acc1 = __builtin_amdgcn_mfma_f32_32x32x16_bf16(bq[s % 3][1], af[s], acc1, 0, 0, 0);
            }
            __builtin_amdgcn_sched_group_barrier(0x100, 4, 0);
#pragma unroll
            for (int s = 0; s < 16; ++s) { if (s + 2 < 16) __builtin_amdgcn_sched_group_barrier(0x100, 2, 0); __builtin_amdgcn_sched_group_barrier(0x008, 2, 0); }
#undef K256_LDB
        }
        if (E.fp8) {
#pragma unroll
            for (int g = 0; g < 4; ++g) {
                unsigned d0 = 0u, d1 = 0u;
                d0 = __builtin_amdgcn_cvt_pk_fp8_f32(acc0[4 * g] * F8_SCALE, acc0[4 * g + 1] * F8_SCALE, d0, false); d0 = __builtin_amdgcn_cvt_pk_fp8_f32(acc0[4 * g + 2] * F8_SCALE, acc0[4 * g + 3] * F8_SCALE, d0, true);
                d1 = __builtin_amdgcn_cvt_pk_fp8_f32(acc1[4 * g] * F8_SCALE, acc1[4 * g + 1] * F8_SCALE, d1, false); d1 = __builtin_amdgcn_cvt_pk_fp8_f32(acc1[4 * g + 2] * F8_SCALE, acc1[4 * g + 3] * F8_SCALE, d1, true);
                *(LAS unsigned*)(scr + r * 80 + 8 * g + 4 * h) = d0; *(LAS unsigned*)(scr + r * 80 + 32 + 8 * g + 4 * h) = d1;
            }
            asm volatile("s_waitcnt lgkmcnt(0)" ::: "memory");
            unsigned char* ob8 = (unsigned char*)E.O;
#pragma unroll
            for (int pq = 0; pq < 2; ++pq) { const int rr = (lane >> 2) + 16 * pq;
                const u32x4 v = *(const LAS u32x4*)(scr + rr * 80 + (lane & 3) * 16);
                __builtin_nontemporal_store(v, (u32x4*)(ob8 + (size_t)(row0 + 32 * wave + rr) * E.ld + i * 64 + (lane & 3) * 16)); }
        } else {
#pragma unroll
        for (int g = 0; g < 4; ++g) {
            u32x2 w0, w1;
            w0.x = pk2(acc0[4 * g] * rscale, acc0[4 * g + 1] * rscale); w0.y = pk2(acc0[4 * g + 2] * rscale, acc0[4 * g + 3] * rscale);
            w1.x = pk2(acc1[4 * g] * rscale, acc1[4 * g + 1] * rscale); w1.y = pk2(acc1[4 * g + 2] * rscale, acc1[4 * g + 3] * rscale);
            *(LAS u32x2*)(scr + r * 144 + (8 * g + 4 * h) * 2) = w0; *(LAS u32x2*)(scr + r * 144 + 64 + (8 * g + 4 * h) * 2) = w1;
        }
        asm volatile("s_waitcnt lgkmcnt(0)" ::: "memory");
        int col = i * 64 + (lane & 7) * 8; bf16_t* ob = E.O;
        if (E.O2 && col >= E.split) { col -= E.split; ob = E.O2; }
#pragma unroll
        for (int pq = 0; pq < 4; ++pq) { const int rr = (lane >> 3) + 8 * pq;
            const u32x4 v = *(const LAS u32x4*)(scr + rr * 144 + (lane & 7) * 16);
            *(u32x4*)(ob + (size_t)(row0 + 32 * wave + rr) * E.ld + col) = v; }
        }
    }
#undef K256_FILL
    asm volatile("s_waitcnt vmcnt(0) lgkmcnt(0)" ::: "memory");
    __builtin_amdgcn_s_barrier(); asm volatile("" ::: "memory");
}


typedef int i32x8k __attribute__((ext_vector_type(8)));
constexpr int K8_BUF = 16384, K8_SCR_OFF = 3 * K8_BUF;
__device__ __forceinline__ void gemm_k256_f8(LAS unsigned char* lds, const unsigned char* A8, const unsigned char* Bt8, int nchunks, int row0, unsigned char* O8, int ld, float oscale) {
    int tid_ = threadIdx.x; asm volatile("; k256f8 ids" : "+v"(tid_));
    const int tid = tid_, lane = tid & 63, wave = __builtin_amdgcn_readfirstlane(tid >> 6), r = lane & 31, h = lane >> 5;
    i32x8k af[4];
    { const unsigned char* arow = A8 + (size_t)(32 * wave + r) * 256 + 32 * h;
#pragma unroll
      for (int s = 0; s < 4; ++s) { const u32x4 x0 = *(const u32x4*)(arow + 64 * s), x1 = *(const u32x4*)(arow + 64 * s + 16); af[s] = __builtin_bit_cast(i32x8k, __builtin_shufflevector(x0, x1, 0, 1, 2, 3, 4, 5, 6, 7)); } }
    unsigned foff[2];
#pragma unroll
    for (int q = 0; q < 2; ++q) { const int n = 4 * (2 * wave + q) + (lane >> 4); foff[q] = (unsigned)(n * 256 + (((lane & 15) ^ (n & 15)) << 4)); }
#define K8_FILL(chunk, buf) do { const unsigned char* _src = Bt8 + (size_t)(chunk) * (64 * 256); _Pragma("unroll") for (int q = 0; q < 2; ++q) \
        __builtin_amdgcn_global_load_lds((const unsigned*)(_src + foff[q]), (LAS unsigned*)(lds + (buf) * K8_BUF + (2 * wave + q) * 1024), 16, 0, 0); } while (0)
    K8_FILL(0, 0);
    if (nchunks > 1) K8_FILL(1, 1);
    LAS unsigned char* scr = lds + K8_SCR_OFF + wave * 2560;
    const float osc = F8_SCALE * oscale;
    for (int i = 0; i < nchunks; ++i) {
        {
            const int yo = 2 * ((i >= 2 ? 1 : 0) + (i >= 1 ? 1 : 0) + (i + 1 < nchunks ? 1 : 0));
            if (yo >= 6) asm volatile("s_waitcnt vmcnt(6)" ::: "memory"); else if (yo >= 4) asm volatile("s_waitcnt vmcnt(4)" ::: "memory");
            else if (yo >= 2) asm volatile("s_waitcnt vmcnt(2)" ::: "memory"); else asm volatile("s_waitcnt vmcnt(0)" ::: "memory");
        }
        __builtin_amdgcn_s_barrier(); asm volatile("" ::: "memory");
        if (i + 2 < nchunks) K8_FILL(i + 2, (i + 2) % 3);
        const LAS unsigned char* bb = lds + (i % 3) * K8_BUF + r * 256;
        f32x16 acc0, acc1;
#pragma unroll
        for (int j = 0; j < 16; ++j) { acc0[j] = 0.f; acc1[j] = 0.f; }
        i32x8k b0[4], b1[4];
#pragma unroll
        for (int s = 0; s < 4; ++s) {
            const int c0 = ((4 * s + 2 * h) ^ (r & 15)) << 4, c1 = ((4 * s + 2 * h + 1) ^ (r & 15)) << 4;
            const u32x4 p0 = *(const LAS u32x4*)(bb + c0), p1 = *(const LAS u32x4*)(bb + c1), q0 = *(const LAS u32x4*)(bb + 32 * 256 + c0), q1 = *(const LAS u32x4*)(bb + 32 * 256 + c1);
            b0[s] = __builtin_bit_cast(i32x8k, __builtin_shufflevector(p0, p1, 0, 1, 2, 3, 4, 5, 6, 7)); b1[s] = __builtin_bit_cast(i32x8k, __builtin_shufflevector(q0, q1, 0, 1, 2, 3, 4, 5, 6, 7));
        }
#pragma unroll
        for (int s = 0; s < 4; ++s) {
            acc0 = __builtin_amdgcn_mfma_scale_f32_32x32x64_f8f6f4(b0[s], af[s], acc0, 0, 0, 0, 0, 0, 0);
            acc1 = __builtin_amdgcn_mfma_scale_f32_32x32x64_f8f6f4(b1[s], af[s], acc1, 0, 0, 0, 0, 0, 0);
        }
#pragma unroll
        for (int g = 0; g < 4; ++g) {
            unsigned d0 = 0u, d1 = 0u;
            d0 = __builtin_amdgcn_cvt_pk_fp8_f32(acc0[4 * g] * osc, acc0[4 * g + 1] * osc, d0, false); d0 = __builtin_amdgcn_cvt_pk_fp8_f32(acc0[4 * g + 2] * osc, acc0[4 * g + 3] * osc, d0, true);
            d1 = __builtin_amdgcn_cvt_pk_fp8_f32(acc1[4 * g] * osc, acc1[4 * g + 1] * osc, d1, false); d1 = __builtin_amdgcn_cvt_pk_fp8_f32(acc1[4 * g + 2] * osc, acc1[4 * g + 3] * osc, d1, true);
            *(LAS unsigned*)(scr + r * 80 + 8 * g + 4 * h) = d0; *(LAS unsigned*)(scr + r * 80 + 32 + 8 * g + 4 * h) = d1;
        }
        asm volatile("s_waitcnt lgkmcnt(0)" ::: "memory");
#pragma unroll
        for (int pq = 0; pq < 2; ++pq) { const int rr = (lane >> 2) + 16 * pq;
            const u32x4 v = *(const LAS u32x4*)(scr + rr * 80 + (lane & 3) * 16);
            __builtin_nontemporal_store(v, (u32x4*)(O8 + (size_t)(row0 + 32 * wave + rr) * ld + i * 64 + (lane & 3) * 16)); }
    }
#undef K8_FILL
    asm volatile("s_waitcnt vmcnt(0) lgkmcnt(0)" ::: "memory");
    __builtin_amdgcn_s_barrier(); asm volatile("" ::: "memory");
}

__device__ __forceinline__ u32x4 pack8(const f32x4 a, const f32x4 b) { u32x4 w; w.x = pk2(a[0], a[1]); w.y = pk2(a[2], a[3]); w.z = pk2(b[0], b[1]); w.w = pk2(b[2], b[3]); return w; }
__device__ __forceinline__ void unpack8(const u32x4 w, f32x4& a, f32x4& b) { a = (f32x4){bflo(w.x), bfhi(w.x), bflo(w.y), bfhi(w.y)}; b = (f32x4){bflo(w.z), bfhi(w.z), bflo(w.w), bfhi(w.w)}; }

struct EpiWin {
    static constexpr bool PERM = true;
    bf16_t *q, *k, *v, *gr, *cq, *ckv, *sa, *sb, *kr; float* ga; const float* rope; int f8; float ascale;
    __device__ __forceinline__ void operator()(const AccT& acc, const Unit& u, int wr, int wc, int fr, int fq) const {
        const int pn = f8 ? (u.pn < 4 ? 8 + u.pn : 12 + u.pn) : u.pn, row0 = u.pm * 256 + wr * 64 + fr, lc0 = wc * 32 + 8 * fq;
        if (pn < 24) {
            bf16_t* dst; int ld, cb, mode = 0;
            if (pn < 2) { dst = q; ld = 512; cb = pn * 256; mode = 1; }
            else if (pn < 4) { dst = k; ld = 512; cb = (pn - 2) * 256; }
            else if (pn < 8) { dst = v; ld = 1024; cb = (pn - 4) * 256; }
            else if (pn < 12) { dst = gr; ld = 1024; cb = (pn - 8) * 256; mode = 2; }
            else if (pn < 15) { dst = cq; ld = 768; cb = (pn - 12) * 256; }
            else if (pn < 16) { dst = ckv; ld = 256; cb = 0; }
            else if (pn < 20) { dst = sa; ld = 512; cb = (pn - 16) * 128; mode = 3; }
            else { dst = sb; ld = 512; cb = (pn - 20) * 128; mode = 3; }
#pragma unroll
            for (int ai = 0; ai < 2; ++ai)
#pragma unroll
                for (int m = 0; m < 4; ++m) {
                    const int row = row0 + ai * 128 + m * 16;
#pragma unroll
                    for (int bj = 0; bj < 2; ++bj) {
                        f32x4 v0 = acc[ai][bj][m][0] * ascale, v1 = acc[ai][bj][m][1] * ascale;
                        if (mode == 1) { v0 *= 0.08838834764831845f; v1 *= 0.08838834764831845f; }
                        else if (mode == 2) {
#pragma unroll
                            for (int j = 0; j < 4; ++j) { v0[j] = silu(v0[j]); v1[j] = silu(v1[j]); } }
                        else if (mode == 3) {
#pragma unroll
                            for (int j = 0; j < 4; ++j) { v0[j] = sigm(v0[j]); v1[j] = sigm(v1[j]); } }
                        if (mode == 3) {
                            unsigned d0 = 0u, d1 = 0u;
#pragma unroll
                            for (int j = 0; j < 4; ++j) { d0 = __builtin_amdgcn_cvt_pk_u8_f32(v0[j] * 255.0f, j, d0); d1 = __builtin_amdgcn_cvt_pk_u8_f32(v1[j] * 255.0f, j, d1); }
                            *(u32x2*)((unsigned char*)dst + (size_t)row * 1024 + (size_t)cb * 2 + bj * 128 + lc0) = (u32x2){d0, d1};
                        } else
                        *(u32x4*)(dst + (size_t)row * ld + cb + bj * 128 + lc0) = pack8(v0, v1);
                    }
                }
        } else {
#pragma unroll
            for (int ai = 0; ai < 2; ++ai)
#pragma unroll
                for (int m = 0; m < 4; ++m) {
                    const int row = row0 + ai * 128 + m * 16;
#pragma unroll
                    for (int bj = 0; bj < 2; ++bj) {
                        const int col = bj * 128 + lc0; const f32x4 v0 = acc[ai][bj][m][0], v1 = acc[ai][bj][m][1];
                        if (col < 64) {
                            const int j = col >> 3;
                            const f32x4 cs = *(const f32x4*)(rope + (size_t)row * 64 + 4 * j), sn = *(const f32x4*)(rope + (size_t)row * 64 + 32 + 4 * j);
                            const f32x4 o1 = v0 * cs - v1 * sn, o2 = v1 * cs + v0 * sn;
                            u32x2 w1, w2; w1.x = pk2(o1[0], o1[1]); w1.y = pk2(o1[2], o1[3]); w2.x = pk2(o2[0], o2[1]); w2.y = pk2(o2[2], o2[3]);
                            *(u32x2*)(kr + (size_t)row * 64 + 4 * j) = w1; *(u32x2*)(kr + (size_t)row * 64 + 32 + 4 * j) = w2;
                        } else if (col < 80) {
                            *(f32x4*)(ga + (size_t)row * 16 + (col - 64)) = v0; *(f32x4*)(ga + (size_t)row * 16 + (col - 64) + 4) = v1;
                        }
                    }
                }
        }
    }
};
struct EpiQF {
    static constexpr bool PERM = true;
    bf16_t* qm; const float* cq_ss; const float* rope;
    __device__ __forceinline__ void operator()(const AccT& acc, const Unit& u, int wr, int wc, int fr, int fq) const {
        const int row0 = u.pm * 256 + wr * 64 + fr, lc0 = wc * 32 + 8 * fq;
        int colb[2], headb[2], jb[2]; bool ropeb[2];
#pragma unroll
        for (int bj = 0; bj < 2; ++bj) { colb[bj] = u.pn * 256 + bj * 128 + lc0; headb[bj] = colb[bj] / 192; const int within = colb[bj] - headb[bj] * 192; ropeb[bj] = within >= 128; jb[bj] = ropeb[bj] ? (within - 128) >> 3 : 0; }
#pragma unroll
        for (int ai = 0; ai < 2; ++ai) {
            float rsv[4]; f32x4 cs[4][2], sn[4][2];
#pragma unroll
            for (int m = 0; m < 4; ++m) { const int row = row0 + ai * 128 + m * 16; rsv[m] = cq_ss[row];
#pragma unroll
                for (int bj = 0; bj < 2; ++bj) if (ropeb[bj]) { cs[m][bj] = *(const f32x4*)(rope + (size_t)row * 64 + 4 * jb[bj]); sn[m][bj] = *(const f32x4*)(rope + (size_t)row * 64 + 32 + 4 * jb[bj]); } }
#pragma unroll
            for (int m = 0; m < 4; ++m) {
                const int row = row0 + ai * 128 + m * 16;
                const float rs = rsqrtf(rsv[m] * (1.0f / 768.0f) + RMS_EPS) * QSCALE;
#pragma unroll
                for (int bj = 0; bj < 2; ++bj) {
                    const f32x4 v0 = acc[ai][bj][m][0] * rs, v1 = acc[ai][bj][m][1] * rs;
                    if (!ropeb[bj]) *(u32x4*)(qm + (size_t)row * 1536 + colb[bj]) = pack8(v0, v1);
                    else {
                        const f32x4 o1 = v0 * cs[m][bj] - v1 * sn[m][bj], o2 = v1 * cs[m][bj] + v0 * sn[m][bj];
                        u32x2 w1, w2; w1.x = pk2(o1[0], o1[1]); w1.y = pk2(o1[2], o1[3]); w2.x = pk2(o2[0], o2[1]); w2.y = pk2(o2[2], o2[3]);
                        bf16_t* p = qm + (size_t)row * 1536 + headb[bj] * 192 + 128 + 4 * jb[bj];
                        *(u32x2*)p = w1; *(u32x2*)(p + 32) = w2;
                    }
                }
            }
        }
    }
};
struct EpiKV {
    static constexpr bool PERM = true;
    bf16_t *kn, *vm; const float* ckv_ss;
    __device__ __forceinline__ void operator()(const AccT& acc, const Unit& u, int wr, int wc, int fr, int fq) const {
        const int row0 = u.pm * 256 + wr * 64 + fr, lc0 = wc * 32 + 8 * fq;
        bf16_t* dst = u.pn < 4 ? kn : vm; const int cb = (u.pn & 3) * 256;
#pragma unroll
        for (int ai = 0; ai < 2; ++ai)
#pragma unroll
            for (int m = 0; m < 4; ++m) {
                const int row = row0 + ai * 128 + m * 16;
                const float rs = rsqrtf(ckv_ss[row] * (1.0f / 256.0f) + RMS_EPS);
#pragma unroll
                for (int bj = 0; bj < 2; ++bj)
                    *(u32x4*)(dst + (size_t)row * 1024 + cb + bj * 128 + lc0) = pack8(acc[ai][bj][m][0] * rs, acc[ai][bj][m][1] * rs);
            }
    }
};
template <bool ADD> struct EpiGate {
    static constexpr bool PERM = true;
    bf16_t* Y; const unsigned char* gate;
    __device__ __forceinline__ void operator()(const AccT& acc, const Unit& u, int wr, int wc, int fr, int fq) const {
        const int row0 = u.pm * 256 + wr * 64 + fr, lc0 = u.pn * 256 + wc * 32 + 8 * fq;
#pragma unroll
        for (int ai = 0; ai < 2; ++ai) {
            u32x2 gq[4][2]; u32x4 yq[4][2];
#pragma unroll
            for (int m = 0; m < 4; ++m)
#pragma unroll
                for (int bj = 0; bj < 2; ++bj) { const size_t o = (size_t)(row0 + ai * 128 + m * 16) * 1024 + lc0 + bj * 128; gq[m][bj] = *(const u32x2*)(gate + o); if (ADD) yq[m][bj] = *(const u32x4*)(Y + o); }
#pragma unroll
            for (int m = 0; m < 4; ++m)
#pragma unroll
                for (int bj = 0; bj < 2; ++bj) {
                    const size_t o = (size_t)(row0 + ai * 128 + m * 16) * 1024 + lc0 + bj * 128;
                    const unsigned ga_ = gq[m][bj].x, gb_ = gq[m][bj].y; const float k255 = 1.0f / 255.0f;
                    const f32x4 g0 = (f32x4){(float)(ga_ & 255u), (float)((ga_ >> 8) & 255u), (float)((ga_ >> 16) & 255u), (float)(ga_ >> 24)} * k255;
                    const f32x4 g1 = (f32x4){(float)(gb_ & 255u), (float)((gb_ >> 8) & 255u), (float)((gb_ >> 16) & 255u), (float)(gb_ >> 24)} * k255;
                    f32x4 v0 = acc[ai][bj][m][0] * g0, v1 = acc[ai][bj][m][1] * g1;
                    if (ADD) { f32x4 y0, y1; unpack8(yq[m][bj], y0, y1); v0 += y0; v1 += y1; }
                    *(u32x4*)(Y + o) = pack8(v0, v1);
                }
        }
    }
};
struct EpiZ {
    static constexpr bool PERM = false;
    float* z; const float* x; const float* mod;
    __device__ __forceinline__ void operator()(const AccT& acc, const Unit& u, int wr, int wc, int fr, int fq) const {
        const int row0 = u.pm * 256 + wr * 64 + fr, col0 = u.pn * 256 + wc * 32 + 4 * fq;
        const float* g = mod + (size_t)(u.pm >> 3) * 6144 + 2048;
        f32x4 gv[2][2];
#pragma unroll
        for (int bj = 0; bj < 2; ++bj)
#pragma unroll
            for (int n = 0; n < 2; ++n) gv[bj][n] = *(const f32x4*)(g + col0 + bj * 128 + n * 16) + 1.0f;
#pragma unroll
        for (int ai = 0; ai < 2; ++ai)
#pragma unroll
            for (int m = 0; m < 4; ++m) {
                const size_t ro = (size_t)(row0 + ai * 128 + m * 16) * 1024 + col0;
#pragma unroll
                for (int bj = 0; bj < 2; ++bj)
#pragma unroll
                    for (int n = 0; n < 2; ++n) { const size_t o = ro + bj * 128 + n * 16; *(f32x4*)(z + o) = *(const f32x4*)(x + o) * ALPHA + gv[bj][n] * acc[ai][bj][m][n]; }
            }
    }
};
struct EpiF32 {
    static constexpr bool PERM = false;
    float* C; int ldc;
    __device__ __forceinline__ void operator()(const AccT& acc, const Unit& u, int wr, int wc, int fr, int fq) const {
        const int row0 = u.pm * 256 + wr * 64 + fr, col0 = u.pn * 256 + wc * 32 + 4 * fq;
#pragma unroll
        for (int ai = 0; ai < 2; ++ai)
#pragma unroll
            for (int m = 0; m < 4; ++m) { float* rowp = C + (size_t)(row0 + ai * 128 + m * 16) * ldc + col0;
#pragma unroll
                for (int bj = 0; bj < 2; ++bj)
#pragma unroll
                    for (int n = 0; n < 2; ++n) *(f32x4*)(rowp + bj * 128 + n * 16) = acc[ai][bj][m][n]; }
    }
};
struct EpiGLU {
    static constexpr bool PERM = true;
    bf16_t* hid; float scale; int f8;
    __device__ __forceinline__ void operator()(const AccT& acc, const Unit& u, int wr, int wc, int fr, int fq) const {
        const int row0 = u.pm * 256 + wr * 64 + fr, lc0 = u.pn * 256 + wc * 32 + 8 * fq;
#pragma unroll
        for (int ai = 0; ai < 2; ++ai)
#pragma unroll
            for (int m = 0; m < 4; ++m) {
                const int row = row0 + ai * 128 + m * 16;
#pragma unroll
                for (int bj = 0; bj < 2; ++bj) {
                    const f32x4 gg = acc[ai][bj][m][0] * scale, uu = acc[ai][bj][m][1] * scale;
                    const float h0 = silu(gg[0]) * uu[0], h1 = silu(gg[1]) * uu[1], h2_ = silu(gg[2]) * uu[2], h3 = silu(gg[3]) * uu[3];
                    if (f8) { unsigned d = 0u; d = __builtin_amdgcn_cvt_pk_fp8_f32(h0, h1, d, false); d = __builtin_amdgcn_cvt_pk_fp8_f32(h2_, h3, d, true);
                        *(unsigned*)((unsigned char*)hid + (size_t)row * 256 + ((lc0 + bj * 128) >> 1)) = d; }
                    else { u32x2 w; w.x = pk2(h0, h1); w.y = pk2(h2_, h3); *(u32x2*)(hid + (size_t)row * 256 + ((lc0 + bj * 128) >> 1)) = w; }
                }
            }
    }
};
struct EpiBf16 {
    static constexpr bool PERM = true;
    bf16_t* O; int ld;
    __device__ __forceinline__ void operator()(const AccT& acc, const Unit& u, int wr, int wc, int fr, int fq) const {
        const int row0 = u.pm * 256 + wr * 64 + fr, lc0 = u.pn * 256 + wc * 32 + 8 * fq;
#pragma unroll
        for (int ai = 0; ai < 2; ++ai)
#pragma unroll
            for (int m = 0; m < 4; ++m) {
                const int row = row0 + ai * 128 + m * 16;
#pragma unroll
                for (int bj = 0; bj < 2; ++bj) *(u32x4*)(O + (size_t)row * ld + lc0 + bj * 128) = pack8(acc[ai][bj][m][0], acc[ai][bj][m][1]);
            }
    }
};
typedef __bf16 bf16v2 __attribute__((ext_vector_type(2)));
__device__ __forceinline__ void atom_pk_bf16(bf16_t* p, unsigned w) {
    asm volatile("global_atomic_pk_add_bf16 %0, %1, off" :: "v"(p), "v"(w) : "memory");
}
struct EpiAtom {
    static constexpr bool PERM = true;
    bf16_t* accb; const int* slot_tok; const float* slot_w;
    __device__ __forceinline__ void operator()(const AccT& acc, const Unit& u, int wr, int wc, int fr, int fq) const {
        const int row0 = u.pm * 256 + wr * 64 + fr, lc0 = u.pn * 256 + wc * 32 + 8 * fq;
#pragma unroll
        for (int ai = 0; ai < 2; ++ai)
#pragma unroll
            for (int m = 0; m < 4; ++m) {
                const int slot = row0 + ai * 128 + m * 16;
                const int tok = slot_tok[slot];
                if (tok >= 0) {
                    const float w = slot_w[slot];
#pragma unroll
                    for (int bj = 0; bj < 2; ++bj) {
                        const u32x4 pw = pack8(acc[ai][bj][m][0] * w, acc[ai][bj][m][1] * w);
                        bf16_t* p = accb + (size_t)tok * 1024 + lc0 + bj * 128;
                        atom_pk_bf16(p, pw.x); atom_pk_bf16(p + 2, pw.y); atom_pk_bf16(p + 4, pw.z); atom_pk_bf16(p + 6, pw.w);
                    }
                }
            }
    }
};

struct Params { const float* in[28]; float* out; unsigned char* ws; int ph_lo, ph_hi, flags, pad; };
enum { I_X = 0, I_C, I_POS, I_WADA, I_BADA, I_WIN, I_WGA2, I_BGA, I_GGN, I_WGLAO, I_GCQ, I_WUQ, I_GCKV, I_WUKV, I_WMLAO, I_WOUT, I_LN1G, I_LN1B, I_WRT, I_BRT, I_WE1, I_WE3, I_WE2, I_WS1, I_WS3, I_WS2, I_LN2G, I_LN2B };
constexpr int LDS_STAGE = 131072, LDS_BYTES = 147456, LDS_MISC = LDS_BYTES - 2048;

template <class Map>
__device__ __forceinline__ void tr_item(const float* W, int K, int Nsrc, bf16_t* WT, const Map& map, const float* kscale, LAS unsigned* scr, int kb, int nb, int lane) {
    const int k0 = 64 * kb, n0 = 64 * nb;
    const int sc = map(n0 + lane);
#pragma unroll 8
    for (int kp = 0; kp < 32; ++kp) {
        float a = 0.f, b = 0.f;
        if (sc >= 0) { a = W[(size_t)(k0 + 2 * kp) * Nsrc + sc]; b = W[(size_t)(k0 + 2 * kp + 1) * Nsrc + sc]; }
        if (kscale) { a *= kscale[k0 + 2 * kp]; b *= kscale[k0 + 2 * kp + 1]; }
        scr[kp * 65 + lane] = pk2(a, b);
    }
    LDS_WAIT(); asm volatile("" ::: "memory");
#pragma unroll
    for (int j = 0; j < 8; ++j) { const int id = lane + 64 * j, n = id >> 3, c = id & 7;
        u32x4 o; o.x = scr[(4 * c + 0) * 65 + n]; o.y = scr[(4 * c + 1) * 65 + n]; o.z = scr[(4 * c + 2) * 65 + n]; o.w = scr[(4 * c + 3) * 65 + n];
        *(u32x4*)(WT + (size_t)(n0 + n) * K + k0 + 8 * c) = o; }
    LDS_WAIT(); asm volatile("" ::: "memory");
}
struct MapId { int off; __device__ __forceinline__ int operator()(int n) const { return off + n; } };
struct MapWin {
    __device__ __forceinline__ int operator()(int n) const {
        if (n < 3072) return n;
        if (n < 3840) return 3088 + (n - 3072);
        if (n < 4096) return 3856 + (n - 3840);
        if (n < 6144) return 4176 + (n - 4096);
        const int t = n - 6144;
        if (t < 64) { const int j = t >> 3, i = t & 7; return 4112 + (i < 4 ? 4 * j + i : 32 + 4 * j + (i - 4)); }
        if (t < 80) return 3072 + (t - 64);
        return -1;
    }
};
struct MapUq { __device__ __forceinline__ int operator()(int n) const { const int h = n / 192, w = n - h * 192; if (w < 128) return n; const int t = w - 128, j = t >> 3, i = t & 7; return h * 192 + 128 + (i < 4 ? 4 * j + i : 32 + 4 * j + (i - 4)); } };
struct MapUkv { __device__ __forceinline__ int operator()(int n) const { const int part = n >> 10, r = n & 1023, h = r >> 7, d = r & 127; return h * 256 + part * 128 + d; } };
struct MapGlu { int coff; __device__ __forceinline__ int operator()(int n) const { return coff + ((n >> 3) << 2) + (n & 3); } };
__device__ __forceinline__ void tr_glu_item(const float* W1, const float* W3, int K, int Nsrc, bf16_t* WT, LAS unsigned* scr, int kb, int nb, int lane) {
    const int k0 = 64 * kb, n0 = 64 * nb, n = n0 + lane;
    const float* W = (n & 4) ? W3 : W1; const int sc = ((n >> 3) << 2) + (n & 3);
#pragma unroll 8
    for (int kp = 0; kp < 32; ++kp) scr[kp * 65 + lane] = pk2(W[(size_t)(k0 + 2 * kp) * Nsrc + sc], W[(size_t)(k0 + 2 * kp + 1) * Nsrc + sc]);
    LDS_WAIT(); asm volatile("" ::: "memory");
#pragma unroll
    for (int j = 0; j < 8; ++j) { const int id = lane + 64 * j, nn = id >> 3, c = id & 7;
        u32x4 o; o.x = scr[(4 * c + 0) * 65 + nn]; o.y = scr[(4 * c + 1) * 65 + nn]; o.z = scr[(4 * c + 2) * 65 + nn]; o.w = scr[(4 * c + 3) * 65 + nn];
        *(u32x4*)(WT + (size_t)(n0 + nn) * K + k0 + 8 * c) = o; }
    LDS_WAIT(); asm volatile("" ::: "memory");
}


__device__ __forceinline__ void tr_glu8_item(const float* W1, const float* W3, int K, int Nsrc, unsigned char* WT, LAS unsigned* scr, int kb, int nb, int lane) {
    const int k0 = 128 * kb, n0 = 64 * nb, n = n0 + lane;
    const float* W = (n & 4) ? W3 : W1; const int sc = ((n >> 3) << 2) + (n & 3);
#pragma unroll 4
    for (int kq = 0; kq < 32; ++kq) { const float* wp = W + (size_t)(k0 + 4 * kq) * Nsrc + sc;
        unsigned d = 0u; d = __builtin_amdgcn_cvt_pk_fp8_f32(wp[0] * 32.0f, wp[Nsrc] * 32.0f, d, false); d = __builtin_amdgcn_cvt_pk_fp8_f32(wp[2 * (size_t)Nsrc] * 32.0f, wp[3 * (size_t)Nsrc] * 32.0f, d, true);
        scr[kq * 65 + lane] = d; }
    LDS_WAIT(); asm volatile("" ::: "memory");
#pragma unroll
    for (int j = 0; j < 8; ++j) { const int id = lane + 64 * j, nn = id >> 3, c = id & 7;
        u32x4 o; o.x = scr[(4 * c + 0) * 65 + nn]; o.y = scr[(4 * c + 1) * 65 + nn]; o.z = scr[(4 * c + 2) * 65 + nn]; o.w = scr[(4 * c + 3) * 65 + nn];
        *(u32x4*)(WT + (size_t)(n0 + nn) * K + k0 + 16 * c) = o; }
    LDS_WAIT(); asm volatile("" ::: "memory");
}

template <class Map>
__device__ __forceinline__ void tr8_item(const float* W, int K, int Nsrc, unsigned char* WT, const Map& map, LAS unsigned* scr, int kb, int nb, int lane) {
    const int k0 = 128 * kb, n0 = 64 * nb; const int sc = map(n0 + lane);
#pragma unroll 4
    for (int kq = 0; kq < 32; ++kq) { const float* wp = W + (size_t)(k0 + 4 * kq) * Nsrc + sc;
        unsigned d = 0u; d = __builtin_amdgcn_cvt_pk_fp8_f32(wp[0] * 32.0f, wp[Nsrc] * 32.0f, d, false); d = __builtin_amdgcn_cvt_pk_fp8_f32(wp[2 * (size_t)Nsrc] * 32.0f, wp[3 * (size_t)Nsrc] * 32.0f, d, true);
        scr[kq * 65 + lane] = d; }
    LDS_WAIT(); asm volatile("" ::: "memory");
#pragma unroll
    for (int j = 0; j < 8; ++j) { const int id = lane + 64 * j, nn = id >> 3, c = id & 7;
        u32x4 o; o.x = scr[(4 * c + 0) * 65 + nn]; o.y = scr[(4 * c + 1) * 65 + nn]; o.z = scr[(4 * c + 2) * 65 + nn]; o.w = scr[(4 * c + 3) * 65 + nn];
        *(u32x4*)(WT + (size_t)(n0 + nn) * K + k0 + 16 * c) = o; }
    LDS_WAIT(); asm volatile("" ::: "memory");
}

struct MapWin8 { __device__ __forceinline__ int operator()(int n) const { return n < 1024 ? 2048 + n : 4176 + (n - 1024); } };
__device__ __forceinline__ void phase0(const Params& p, LAS unsigned char* lds, int gw, int ngw, int lane, int wave) {
    unsigned char* ws = p.ws;
    {
        const int cb = blockIdx.x, tid = threadIdx.x;
        if (cb < 96) {
            const float* c = p.in[I_C]; const float* wada = p.in[I_WADA]; const float* bada = p.in[I_BADA]; float* mod = (float*)(ws + WS_MOD);
            LAS float* tab = (LAS float*)lds;
            for (int i = tid; i < 32 * 1024 / 4; i += NTHR) { const f32x4 v = ((const f32x4*)c)[i]; f32x4 o; o[0] = silu(v[0]); o[1] = silu(v[1]); o[2] = silu(v[2]); o[3] = silu(v[3]); ((LAS f32x4*)tab)[i] = o; }
            __syncthreads();
            float acc[32];
#pragma unroll
            for (int b = 0; b < 32; ++b) acc[b] = 0.f;
            const int col = cb * 64 + lane;
            for (int k4 = 0; k4 < 32; ++k4) {
                const int k = wave * 128 + k4 * 4;
                float w[4];
#pragma unroll
                for (int q = 0; q < 4; ++q) w[q] = wada[(size_t)(k + q) * 6144 + col];
#pragma unroll
                for (int b = 0; b < 32; ++b) { const f32x4 t = *(const LAS f32x4*)(tab + b * 1024 + k); acc[b] += t[0] * w[0] + t[1] * w[1] + t[2] * w[2] + t[3] * w[3]; }
            }
            __syncthreads();
            LAS float* part = (LAS float*)lds;
#pragma unroll
            for (int b = 0; b < 32; ++b) part[(wave * 32 + b) * 64 + lane] = acc[b];
            __syncthreads();
#pragma unroll
            for (int i = 0; i < 4; ++i) { const int o = tid + 512 * i, b = o >> 6, l = o & 63; float sum = 0.f;
#pragma unroll
                for (int w8 = 0; w8 < 8; ++w8) sum += part[(w8 * 32 + b) * 64 + l];
                mod[b * 6144 + cb * 64 + l] = sum + bada[cb * 64 + l]; }
            __syncthreads();
        }
    }
    LAS unsigned* scr = (LAS unsigned*)(lds + wave * 8448);
    constexpr int T_WIN = 16 * 100, T_GLAO = 16 * 16, T_UQ = 12 * 24, T_UKV = 4 * 32, T_MLAO = 256, T_OUT = 256, T_RT = 16 * 4, T_S13 = 16 * 8, T_S2 = 4 * 16, T_WIN8 = 8 * 48;
    constexpr int T_ALL = T_WIN + T_GLAO + T_UQ + T_UKV + T_MLAO + T_OUT + T_RT + T_S13 + T_S2 + T_WIN8;
    for (int it = gw; it < T_ALL; it += ngw) {
        int r = it;
        if (r < T_WIN) { tr_item(p.in[I_WIN], 1024, 6224, (bf16_t*)(ws + WS_WIN), MapWin{}, nullptr, scr, r / 100, r % 100, lane); continue; } r -= T_WIN;
        if (r < T_GLAO) { tr_item(p.in[I_WGLAO], 1024, 1024, (bf16_t*)(ws + WS_WGLAO), MapId{0}, nullptr, scr, r / 16, r % 16, lane); continue; } r -= T_GLAO;
        if (r < T_UQ) { tr_item(p.in[I_WUQ], 768, 1536, (bf16_t*)(ws + WS_WUQ), MapUq{}, p.in[I_GCQ], scr, r / 24, r % 24, lane); continue; } r -= T_UQ;
        if (r < T_UKV) { tr_item(p.in[I_WUKV], 256, 2048, (bf16_t*)(ws + WS_WUKV), MapUkv{}, p.in[I_GCKV], scr, r / 32, r % 32, lane); continue; } r -= T_UKV;
        if (r < T_MLAO) { tr_item(p.in[I_WMLAO], 1024, 1024, (bf16_t*)(ws + WS_WMLAO), MapId{0}, nullptr, scr, r / 16, r % 16, lane); continue; } r -= T_MLAO;
        if (r < T_OUT) { tr_item(p.in[I_WOUT], 1024, 1024, (bf16_t*)(ws + WS_WOUT), MapId{0}, nullptr, scr, r / 16, r % 16, lane); continue; } r -= T_OUT;
        if (r < T_RT) { tr_item(p.in[I_WRT], 1024, 256, (bf16_t*)(ws + WS_WRT), MapId{0}, nullptr, scr, r / 4, r % 4, lane); continue; } r -= T_RT;
        if (r < T_S13) { tr_glu_item(p.in[I_WS1], p.in[I_WS3], 1024, 256, (bf16_t*)(ws + WS_WS13), scr, r / 8, r % 8, lane); continue; } r -= T_S13;
        if (r < T_S2) { tr_item(p.in[I_WS2], 256, 1024, (bf16_t*)(ws + WS_WS2), MapId{0}, nullptr, scr, r / 16, r % 16, lane); continue; } r -= T_S2;
        tr8_item(p.in[I_WIN], 1024, 6224, ws + WS_WIN8, MapWin8{}, scr, r / 48, r % 48, lane);
    }
    { int* st = (int*)(ws + WS_STOK); for (int i = gw * 64 + lane; i < NSLOT; i += ngw * 64) st[i] = -1; }
}

__device__ __forceinline__ void phase1(const Params& p, int gw, int ngw, int lane) {
    const float* x = p.in[I_X]; const float* mod = (const float*)(p.ws + WS_MOD); bf16_t* h = (bf16_t*)(p.ws + WS_BIG(0));
    const int* pos = (const int*)p.in[I_POS]; float* rope = (float*)((unsigned char*)p.out + 192 * MiB);
    const float invf = exp2f(-(float)(lane & 31) * (13.287712379549449f / 32.0f));
    for (int m = gw; m < NTOK; m += ngw) {
        const int b = m >> 11; const float* sh = mod + b * 6144; const float* sc = sh + 1024;
        const f32x4* xr = (const f32x4*)(x + (size_t)m * 1024) + lane;
        u32x2* o = (u32x2*)(h + (size_t)m * 1024) + lane;
#pragma unroll
        for (int j = 0; j < 4; ++j) { const f32x4 v = xr[64 * j], s = *((const f32x4*)sc + lane + 64 * j) + 1.0f, t = *((const f32x4*)sh + lane + 64 * j);
            const f32x4 r = v * s + t; u32x2 w; w.x = pk2(r[0], r[1]); w.y = pk2(r[2], r[3]); o[64 * j] = w;
            unsigned w8 = 0u; w8 = __builtin_amdgcn_cvt_pk_fp8_f32(r[0], r[1], w8, false); w8 = __builtin_amdgcn_cvt_pk_fp8_f32(r[2], r[3], w8, true);
            ((unsigned*)(p.ws + WS_BIG(7) + (size_t)m * 1024))[lane + 64 * j] = w8; }
        const float ang = (float)pos[m] * invf;
        rope[(size_t)m * 64 + lane] = lane < 32 ? cosf(ang) : sinf(ang);
    }
}

__device__ __forceinline__ void ln1_row(float* zrow, bf16_t* h2row, const float* g, const float* bta, const float* sh2, const float* sc2, int lane) {
    f32x4* zr = (f32x4*)zrow + lane; f32x4 v[4]; float s = 0.f;
#pragma unroll
    for (int j = 0; j < 4; ++j) { v[j] = zr[64 * j]; s += (v[j][0] + v[j][1]) + (v[j][2] + v[j][3]); }
    const float mean = wave_sum(s) * (1.f / 1024.f); float s2 = 0.f;
#pragma unroll
    for (int j = 0; j < 4; ++j) { v[j] = v[j] - mean; s2 += (v[j][0] * v[j][0] + v[j][1] * v[j][1]) + (v[j][2] * v[j][2] + v[j][3] * v[j][3]); }
    const float rstd = rsqrtf(wave_sum(s2) * (1.f / 1024.f) + LN_EPS);
    u32x2* o = (u32x2*)h2row + lane;
#pragma unroll
    for (int j = 0; j < 4; ++j) {
        const int ci = lane + 64 * j;
        const f32x4 x1 = v[j] * rstd * ((const f32x4*)g)[ci] + ((const f32x4*)bta)[ci];
        zr[64 * j] = x1;
        const f32x4 hh = x1 * (((const f32x4*)sc2)[ci] + 1.0f) + ((const f32x4*)sh2)[ci];
        u32x2 w; w.x = pk2(hh[0], hh[1]); w.y = pk2(hh[2], hh[3]); o[64 * j] = w;
    }
}
__device__ __forceinline__ void ln2_row(float* orow, const bf16_t* frow, const float* g, const float* bta, const float* gt2, int lane) {
    f32x4* zr = (f32x4*)orow + lane; const u32x2* fr = (const u32x2*)frow + lane; f32x4 v[4]; float s = 0.f;
#pragma unroll
    for (int j = 0; j < 4; ++j) { const u32x2 w = fr[64 * j]; const f32x4 f = (f32x4){bflo(w.x), bfhi(w.x), bflo(w.y), bfhi(w.y)};
        v[j] = zr[64 * j] * ALPHA + (((const f32x4*)gt2)[lane + 64 * j] + 1.0f) * f; s += (v[j][0] + v[j][1]) + (v[j][2] + v[j][3]); }
    const float mean = wave_sum(s) * (1.f / 1024.f); float s2 = 0.f;
#pragma unroll
    for (int j = 0; j < 4; ++j) { v[j] = v[j] - mean; s2 += (v[j][0] * v[j][0] + v[j][1] * v[j][1]) + (v[j][2] * v[j][2] + v[j][3] * v[j][3]); }
    const float rstd = rsqrtf(wave_sum(s2) * (1.f / 1024.f) + LN_EPS);
#pragma unroll
    for (int j = 0; j < 4; ++j) { const int ci = lane + 64 * j; zr[64 * j] = v[j] * rstd * ((const f32x4*)g)[ci] + ((const f32x4*)bta)[ci]; }
}

__device__ __forceinline__ void gla_phase(const Params& p, LAS unsigned char* lds, int bh, bool nostore) {
    const int tid = threadIdx.x, lane = tid & 63, wave = __builtin_amdgcn_readfirstlane(tid >> 6), fr = lane & 15, g = lane >> 4;
    const int b = bh >> 2, h = bh & 3;
    const bf16_t* qg = (const bf16_t*)(p.ws + WS_BIG(1)); const bf16_t* kg = qg + (size_t)NTOK * 512; const bf16_t* vg = (const bf16_t*)(p.ws + WS_BIG(2));
    bf16_t* gr = (bf16_t*)(p.ws + WS_BIG(3)); const float* gag = (const float*)(p.ws + WS_GA);
    LAS bf16_t* KdT = (LAS bf16_t*)lds;
    LAS bf16_t* VT = (LAS bf16_t*)(lds + 18432);
    LAS bf16_t* ST = (LAS bf16_t*)lds;
    LAS bf16_t* QS = (LAS bf16_t*)(lds + 69632);
    LAS float* DEC = (LAS float*)(lds + 87040);
    LAS float* PART = (LAS float*)(lds + 87552);
    LAS float* GAC = (LAS float*)(lds + 89600);
    LAS float* SS = (LAS float*)(lds + 93696);
    const int dk = tid & 127, tq = tid >> 7;
    float w2[16];
#pragma unroll
    for (int r = 0; r < 16; ++r) w2[r] = p.in[I_WGA2][r * 512 + h * 128 + dk];
    const float bias = p.in[I_BGA][h * 128 + dk];
    const int rg = wave & 3, ch = wave >> 2;
    float gnv[8];
#pragma unroll
    for (int nt = 0; nt < 8; ++nt) gnv[nt] = p.in[I_GGN][128 * ch + 16 * nt + fr];
    f32x4 st[8][2];
#pragma unroll
    for (int mt = 0; mt < 8; ++mt) { st[mt][0] = (f32x4){0.f, 0.f, 0.f, 0.f}; st[mt][1] = (f32x4){0.f, 0.f, 0.f, 0.f}; }
    const int dvp = tid & 127, tq4 = tid >> 7;
    bf16_t kraw[16]; unsigned vraw[16]; u32x4 qraw[2]; f32x4 garaw = (f32x4){0.f, 0.f, 0.f, 0.f};
#define GLA_LOAD(n_) do { const int tk_ = b * 2048 + (n_) * 64; \
        if (tid < 256) garaw = *(const f32x4*)(gag + (size_t)(tk_ + (tid >> 2)) * 16 + (tid & 3) * 4); \
        _Pragma("unroll") for (int j = 0; j < 16; ++j) kraw[j] = kg[(size_t)(tk_ + 16 * tq + j) * 512 + h * 128 + dk]; \
        _Pragma("unroll") for (int j = 0; j < 16; ++j) vraw[j] = *(const unsigned*)(vg + (size_t)(tk_ + 16 * tq4 + j) * 1024 + h * 256 + 2 * dvp); \
        _Pragma("unroll") for (int i = 0; i < 2; ++i) { const int id = tid + 512 * i; qraw[i] = *(const u32x4*)(qg + (size_t)(tk_ + (id >> 4)) * 512 + h * 128 + (id & 15) * 8); } } while (0)
    GLA_LOAD(0);
    for (int n = 0; n < 32; ++n) {
        const int tok0 = b * 2048 + n * 64;
        if (tid < 256) *(LAS f32x4*)(GAC + tid * 4) = garaw;
        __syncthreads();
        float cs[16]; float run = 0.f;
#pragma unroll
        for (int j = 0; j < 16; ++j) {
            const LAS f32x4* gp = (const LAS f32x4*)(GAC + (16 * tq + j) * 16);
            float d = bias;
#pragma unroll
            for (int r4 = 0; r4 < 4; ++r4) { const f32x4 gv = gp[r4]; d += gv[0] * w2[4 * r4] + gv[1] * w2[4 * r4 + 1] + gv[2] * w2[4 * r4 + 2] + gv[3] * w2[4 * r4 + 3]; }
            const float ls = fminf(d, 0.f) - __logf(1.0f + __expf(-fabsf(d)));
            run += ls * (1.0f / 16.0f); cs[j] = run;
        }
        PART[tq * 128 + dk] = run;
        __syncthreads();
        {
            const float p0 = PART[dk], p1 = PART[128 + dk], p2 = PART[256 + dk], p3 = PART[384 + dk];
            const float total = (p0 + p1) + (p2 + p3);
            const float off = tq == 0 ? 0.f : tq == 1 ? p0 : tq == 2 ? (p0 + p1) : (p0 + p1) + p2;
            if (tq == 0) DEC[dk] = __expf(total);
            unsigned kd[8];
#pragma unroll
            for (int j = 0; j < 8; ++j) kd[j] = pk2(bf2f(kraw[2 * j]) * __expf(total - (off + cs[2 * j])), bf2f(kraw[2 * j + 1]) * __expf(total - (off + cs[2 * j + 1])));
            LAS u32x4* kdst = (LAS u32x4*)(KdT + dk * 72 + 16 * tq);
            kdst[0] = (u32x4){kd[0], kd[1], kd[2], kd[3]}; kdst[1] = (u32x4){kd[4], kd[5], kd[6], kd[7]};
            unsigned v0[8], v1[8];
#pragma unroll
            for (int j = 0; j < 8; ++j) { v0[j] = (vraw[2 * j] & 0xffffu) | (vraw[2 * j + 1] << 16); v1[j] = (vraw[2 * j] >> 16) | (vraw[2 * j + 1] & 0xffff0000u); }
            LAS u32x4* vd0 = (LAS u32x4*)(VT + (2 * dvp) * 72 + 16 * tq4); LAS u32x4* vd1 = (LAS u32x4*)(VT + (2 * dvp + 1) * 72 + 16 * tq4);
            vd0[0] = (u32x4){v0[0], v0[1], v0[2], v0[3]}; vd0[1] = (u32x4){v0[4], v0[5], v0[6], v0[7]};
            vd1[0] = (u32x4){v1[0], v1[1], v1[2], v1[3]}; vd1[1] = (u32x4){v1[4], v1[5], v1[6], v1[7]};
#pragma unroll
            for (int i = 0; i < 2; ++i) { const int id = tid + 512 * i; *(LAS u32x4*)(QS + (id >> 4) * 136 + (id & 15) * 8) = qraw[i]; }
        }
        if (n + 1 < 32) GLA_LOAD(n + 1);
        __syncthreads();
#pragma unroll
        for (int mt = 0; mt < 8; ++mt) { const f32x4 d4 = *(const LAS f32x4*)(DEC + 16 * mt + 4 * g); st[mt][0] *= d4; st[mt][1] *= d4; }
#pragma unroll
        for (int ks = 0; ks < 2; ++ks) {
            bf16x8 bfr[2];
#pragma unroll
            for (int nt = 0; nt < 2; ++nt) bfr[nt] = *(const LAS bf16x8*)(VT + (32 * wave + 16 * nt + fr) * 72 + 32 * ks + 8 * g);
#pragma unroll
            for (int mt = 0; mt < 8; ++mt) {
                const bf16x8 a = *(const LAS bf16x8*)(KdT + (16 * mt + fr) * 72 + 32 * ks + 8 * g);
                st[mt][0] = __builtin_amdgcn_mfma_f32_16x16x32_bf16(a, bfr[0], st[mt][0], 0, 0, 0);
                st[mt][1] = __builtin_amdgcn_mfma_f32_16x16x32_bf16(a, bfr[1], st[mt][1], 0, 0, 0);
            }
        }
        __syncthreads();
#pragma unroll
        for (int mt = 0; mt < 8; ++mt)
#pragma unroll
            for (int nt = 0; nt < 2; ++nt) { u32x2 w; w.x = pk2(st[mt][nt][0], st[mt][nt][1]); w.y = pk2(st[mt][nt][2], st[mt][nt][3]);
                *(LAS u32x2*)(ST + (32 * wave + 16 * nt + fr) * 136 + 16 * mt + 4 * g) = w; }
        __syncthreads();
        f32x4 o[8];
#pragma unroll
        for (int nt = 0; nt < 8; ++nt) o[nt] = (f32x4){0.f, 0.f, 0.f, 0.f};
#pragma unroll
        for (int ks = 0; ks < 4; ++ks) {
            const bf16x8 a = *(const LAS bf16x8*)(QS + (16 * rg + fr) * 136 + 32 * ks + 8 * g);
#pragma unroll
            for (int nt = 0; nt < 8; ++nt) { const bf16x8 bb = *(const LAS bf16x8*)(ST + (128 * ch + 16 * nt + fr) * 136 + 32 * ks + 8 * g);
                o[nt] = __builtin_amdgcn_mfma_f32_16x16x32_bf16(a, bb, o[nt], 0, 0, 0); }
        }
        {
            f32x4 s2 = (f32x4){0.f, 0.f, 0.f, 0.f};
#pragma unroll
            for (int nt = 0; nt < 8; ++nt) s2 += o[nt] * o[nt];
#pragma unroll
            for (int r = 0; r < 4; ++r) { float s = s2[r]; s += __shfl_xor(s, 1); s += __shfl_xor(s, 2); s += __shfl_xor(s, 4); s += __shfl_xor(s, 8); if (fr == 0) SS[(16 * rg + 4 * g + r) * 2 + ch] = s; }
        }
        __syncthreads();
#pragma unroll
        for (int r = 0; r < 4; ++r) {
            const int t = 16 * rg + 4 * g + r;
            const float rstd = rsqrtf((SS[t * 2] + SS[t * 2 + 1]) * (1.0f / 256.0f) + RMS_EPS);
            bf16_t* grow = gr + (size_t)(tok0 + t) * 1024 + h * 256 + 128 * ch + fr;
#pragma unroll
#if defined(GLA_DBG) && GLA_DBG == 1
            for (int nt = 0; nt < 8; ++nt) grow[16 * nt] = f2bf(o[nt][r]);
#elif defined(GLA_DBG) && GLA_DBG == 2
            for (int nt = 0; nt < 8; ++nt) grow[16 * nt] = f2bf(rstd);
#else
            for (int nt = 0; nt < 8; ++nt) { const bf16_t y = f2bf(o[nt][r] * rstd * gnv[nt] * bf2f(grow[16 * nt])); if (!nostore) grow[16 * nt] = y; }
#endif
        }
    }
#undef GLA_LOAD
    __syncthreads();
}

__device__ __forceinline__ float xor16_max(float v) { const auto r = __builtin_amdgcn_permlane16_swap(__float_as_uint(v), __float_as_uint(v), false, false); return fmaxf(__uint_as_float(r[0]), __uint_as_float(r[1])); }
__device__ __forceinline__ float xor32_max(float v) { const auto r = __builtin_amdgcn_permlane32_swap(__float_as_uint(v), __float_as_uint(v), false, false); return fmaxf(__uint_as_float(r[0]), __uint_as_float(r[1])); }
__device__ __forceinline__ float xor16_sum(float v) { const auto r = __builtin_amdgcn_permlane16_swap(__float_as_uint(v), __float_as_uint(v), false, false); return __uint_as_float(r[0]) + __uint_as_float(r[1]); }
__device__ __forceinline__ float xor32_sum(float v) { const auto r = __builtin_amdgcn_permlane32_swap(__float_as_uint(v), __float_as_uint(v), false, false); return __uint_as_float(r[0]) + __uint_as_float(r[1]); }
constexpr int ATT_BUF = 43008, ATT_VOFF = 24576;
__device__ __forceinline__ void attn_phase(const Params& p, LAS unsigned char* lds, int bh) {
    const int tid = threadIdx.x, lane = tid & 63, wave = __builtin_amdgcn_readfirstlane(tid >> 6), fr = lane & 15, g = lane >> 4;
    const int b = bh >> 3, h = bh & 7;
    const bf16_t* qm = (const bf16_t*)p.out; const bf16_t* kn = (const bf16_t*)(p.ws + WS_BIG(0)); const bf16_t* vm = (const bf16_t*)(p.ws + WS_BIG(7));
    const bf16_t* kr = (const bf16_t*)(p.ws + WS_KR); bf16_t* ob = (bf16_t*)(p.ws + WS_BIG(1));
    const int kp = tid & 31, dvc = tid >> 5;
    unsigned koff[3]; bool krope[3];
#pragma unroll
    for (int j = 0; j < 3; ++j) { const int L = (8 * j + wave) * 64 + lane, key = L / 24, sl = L % 24, c = (sl & ~7) | ((sl & 7) ^ (key & 7));
        krope[j] = c >= 16; koff[j] = krope[j] ? (unsigned)(key * 128 + 16 * (c - 16)) : (unsigned)(key * 2048 + h * 256 + 16 * c); }
    for (int qb = 0; qb < 8; ++qb) {
        const int q0 = b * 2048 + 256 * qb + 32 * wave;
        bf16x8 qf[2][6];
#pragma unroll
        for (int nt = 0; nt < 2; ++nt)
#pragma unroll
            for (int ks = 0; ks < 6; ++ks) qf[nt][ks] = *(const bf16x8*)(qm + (size_t)(q0 + 16 * nt + fr) * 1536 + h * 192 + 32 * ks + 8 * g);
        f32x4 O[8][2];
#pragma unroll
        for (int mt = 0; mt < 8; ++mt) { O[mt][0] = (f32x4){0.f, 0.f, 0.f, 0.f}; O[mt][1] = (f32x4){0.f, 0.f, 0.f, 0.f}; }
        float m_run[2] = {-1e30f, -1e30f}, l_part[2] = {0.f, 0.f};
        const int ntile = 4 * qb + 4, my_last = 4 * qb + (wave >> 1);
        u32x4 vreg[2];
#define ATT_PREFETCH(kt, buf) do { const int tk0 = b * 2048 + 64 * (kt); const char* knb = (const char*)(kn + (size_t)tk0 * 1024); const char* krb = (const char*)(kr + (size_t)tk0 * 64); \
            _Pragma("unroll") for (int j = 0; j < 3; ++j) __builtin_amdgcn_global_load_lds((const unsigned*)((krope[j] ? krb : knb) + koff[j]), (LAS unsigned*)(lds + (buf) * ATT_BUF + (8 * j + wave) * 1024), 16, 0, 0); \
            vreg[0] = *(const u32x4*)(vm + (size_t)(tk0 + 2 * kp) * 1024 + h * 128 + 8 * dvc); vreg[1] = *(const u32x4*)(vm + (size_t)(tk0 + 2 * kp + 1) * 1024 + h * 128 + 8 * dvc); } while (0)
#define ATT_WRITE(buf) do { LAS unsigned* VTw = (LAS unsigned*)(lds + (buf) * ATT_BUF + ATT_VOFF); \
            _Pragma("unroll") for (int i = 0; i < 4; ++i) { const unsigned a_ = vreg[0][i], b_ = vreg[1][i]; \
                VTw[(8 * dvc + 2 * i) * 36 + kp] = (a_ & 0xffffu) | (b_ << 16); VTw[(8 * dvc + 2 * i + 1) * 36 + kp] = (a_ >> 16) | (b_ & 0xffff0000u); } \
            asm volatile("s_waitcnt vmcnt(0)" ::: "memory"); } while (0)
        __syncthreads();
        ATT_PREFETCH(0, 0);
        ATT_WRITE(0);
        __syncthreads();
        for (int kt = 0; kt < ntile; ++kt) {
            if (kt + 1 < ntile) ATT_PREFETCH(kt + 1, (kt + 1) & 1);
            if (kt <= my_last) {
                const LAS unsigned char* KS = lds + (kt & 1) * ATT_BUF; const LAS unsigned* VT = (const LAS unsigned*)(lds + (kt & 1) * ATT_BUF + ATT_VOFF);
                f32x4 s[4][2];
#pragma unroll
                for (int mt = 0; mt < 4; ++mt) { s[mt][0] = (f32x4){0.f, 0.f, 0.f, 0.f}; s[mt][1] = (f32x4){0.f, 0.f, 0.f, 0.f}; }
                {
                    bf16x8 ka[2][4];
                    const LAS unsigned char* kb0 = KS + fr * 384 + 16 * (g ^ (fr & 7));
                    const LAS unsigned char* kb1 = KS + fr * 384 + 16 * ((4 + g) ^ (fr & 7));
#pragma unroll
                    for (int mt = 0; mt < 4; ++mt) ka[0][mt] = *(const LAS bf16x8*)(kb0 + mt * 6144);
#pragma unroll
                    for (int ks = 0; ks < 6; ++ks) {
                        if (ks < 5) {
#pragma unroll
                            for (int mt = 0; mt < 4; ++mt) ka[(ks + 1) & 1][mt] = *(const LAS bf16x8*)((((ks + 1) & 1) ? kb1 : kb0) + mt * 6144 + 128 * ((ks + 1) >> 1));
                            asm volatile("s_waitcnt lgkmcnt(4)" ::: "memory");
                        } else asm volatile("s_waitcnt lgkmcnt(0)" ::: "memory");
                        __builtin_amdgcn_sched_barrier(0);
#pragma unroll
                        for (int mt = 0; mt < 4; ++mt) {
                            s[mt][0] = __builtin_amdgcn_mfma_f32_16x16x32_bf16(ka[ks & 1][mt], qf[0][ks], s[mt][0], 0, 0, 0);
                            s[mt][1] = __builtin_amdgcn_mfma_f32_16x16x32_bf16(ka[ks & 1][mt], qf[1][ks], s[mt][1], 0, 0, 0);
                        }
                        __builtin_amdgcn_sched_barrier(0);
                    }
                }
                bf16x8 pf[2][2]; float al[2];
#pragma unroll
                for (int nt = 0; nt < 2; ++nt) {
                    float mx = fmaxf(fmaxf(s[0][nt][0], s[0][nt][1]), fmaxf(s[0][nt][2], s[0][nt][3]));
#pragma unroll
                    for (int mt = 1; mt < 4; ++mt) mx = fmaxf(mx, fmaxf(fmaxf(s[mt][nt][0], s[mt][nt][1]), fmaxf(s[mt][nt][2], s[mt][nt][3])));
                    mx = xor16_max(mx); mx = xor32_max(mx);
                    const float mn = fmaxf(m_run[nt], mx); al[nt] = __builtin_amdgcn_exp2f(m_run[nt] - mn); m_run[nt] = mn;
                    float rs = 0.f;
#pragma unroll
                    for (int mt = 0; mt < 4; ++mt)
#pragma unroll
                        for (int r = 0; r < 4; ++r) { const float e = __builtin_amdgcn_exp2f(s[mt][nt][r] - mn); s[mt][nt][r] = e; rs += e; }
                    l_part[nt] = l_part[nt] * al[nt] + rs;
#pragma unroll
                    for (int k2 = 0; k2 < 2; ++k2) {
                        u32x4 w; w.x = pk2(s[2 * k2][nt][0], s[2 * k2][nt][1]); w.y = pk2(s[2 * k2][nt][2], s[2 * k2][nt][3]);
                        w.z = pk2(s[2 * k2 + 1][nt][0], s[2 * k2 + 1][nt][1]); w.w = pk2(s[2 * k2 + 1][nt][2], s[2 * k2 + 1][nt][3]);
                        pf[nt][k2] = __builtin_bit_cast(bf16x8, w);
                    }
                }
                if (__any(al[0] != 1.0f || al[1] != 1.0f)) {
#pragma unroll
                    for (int mt = 0; mt < 8; ++mt) { O[mt][0] *= al[0]; O[mt][1] *= al[1]; }
                }
                {
                    u32x2 vf[2][2][2];
                    const LAS unsigned* vbase = VT + fr * 36 + 2 * g;
#pragma unroll
                    for (int k2 = 0; k2 < 2; ++k2) { vf[0][k2][0] = *(const LAS u32x2*)(vbase + 16 * k2); vf[0][k2][1] = *(const LAS u32x2*)(vbase + 16 * k2 + 8); }
#pragma unroll
                    for (int mt = 0; mt < 8; ++mt) {
                        if (mt < 7) {
#pragma unroll
                            for (int k2 = 0; k2 < 2; ++k2) { vf[(mt + 1) & 1][k2][0] = *(const LAS u32x2*)(vbase + 16 * (mt + 1) * 36 + 16 * k2); vf[(mt + 1) & 1][k2][1] = *(const LAS u32x2*)(vbase + 16 * (mt + 1) * 36 + 16 * k2 + 8); }
                            asm volatile("s_waitcnt lgkmcnt(4)" ::: "memory");
                        } else asm volatile("s_waitcnt lgkmcnt(0)" ::: "memory");
                        __builtin_amdgcn_sched_barrier(0);
#pragma unroll
                        for (int k2 = 0; k2 < 2; ++k2) {
                            const u32x2 lo = vf[mt & 1][k2][0], hi = vf[mt & 1][k2][1];
                            const bf16x8 a = __builtin_bit_cast(bf16x8, ((u32x4){lo.x, lo.y, hi.x, hi.y}));
                            O[mt][0] = __builtin_amdgcn_mfma_f32_16x16x32_bf16(a, pf[0][k2], O[mt][0], 0, 0, 0);
                            O[mt][1] = __builtin_amdgcn_mfma_f32_16x16x32_bf16(a, pf[1][k2], O[mt][1], 0, 0, 0);
                        }
                        __builtin_amdgcn_sched_barrier(0);
                    }
                }
            }
            if (kt + 1 < ntile) ATT_WRITE((kt + 1) & 1);
            __syncthreads();
        }
#undef ATT_PREFETCH
#undef ATT_WRITE
#pragma unroll
        for (int nt = 0; nt < 2; ++nt) {
            float l = l_part[nt]; l = xor16_sum(l); l = xor32_sum(l);
            const float inv = 1.0f / l;
            bf16_t* orow = ob + (size_t)(q0 + 16 * nt + fr) * 1024 + h * 128 + 4 * g;
#pragma unroll
            for (int mt = 0; mt < 8; ++mt) { u32x2 w; w.x = pk2(O[mt][nt][0] * inv, O[mt][nt][1] * inv); w.y = pk2(O[mt][nt][2] * inv, O[mt][nt][3] * inv); *(u32x2*)(orow + 16 * mt) = w; }
        }
    }
    __syncthreads();
}

__device__ __forceinline__ unsigned dpp_umax_step_shr(unsigned v, int) { return v; }
__device__ __forceinline__ unsigned wave_umax(unsigned v) {
    unsigned t;
    t = (unsigned)__builtin_amdgcn_update_dpp(0, (int)v, 0x111, 0xf, 0xf, true); v = v > t ? v : t;
    t = (unsigned)__builtin_amdgcn_update_dpp(0, (int)v, 0x112, 0xf, 0xf, true); v = v > t ? v : t;
    t = (unsigned)__builtin_amdgcn_update_dpp(0, (int)v, 0x114, 0xf, 0xf, true); v = v > t ? v : t;
    t = (unsigned)__builtin_amdgcn_update_dpp(0, (int)v, 0x118, 0xf, 0xf, true); v = v > t ? v : t;
    t = (unsigned)__builtin_amdgcn_update_dpp(0, (int)v, 0x142, 0xa, 0xf, false); v = v > t ? v : t;
    t = (unsigned)__builtin_amdgcn_update_dpp(0, (int)v, 0x143, 0xc, 0xf, false); v = v > t ? v : t;
    return (unsigned)__builtin_amdgcn_readlane((int)v, 63);
}
template <int CTRL> __device__ __forceinline__ float dpp_f(float v) { return __builtin_bit_cast(float, __builtin_amdgcn_update_dpp(0, __builtin_bit_cast(int, v), CTRL, 0xf, 0xf, false)); }
template <int CTRL> __device__ __forceinline__ void top2_merge(float& t1, float& t2) { const float p1 = dpp_f<CTRL>(t1), p2 = dpp_f<CTRL>(t2); const float n1 = fmaxf(t1, p1), n2 = fmaxf(fminf(t1, p1), fmaxf(t2, p2)); t1 = n1; t2 = n2; }
__device__ __forceinline__ void route_row2(const float* lrow, const float* brt, int* tidx, float* tw, LAS int* etab, int lane) {
    const f32x4 bb = *(const f32x4*)(brt + 4 * lane);
    float sc[2][4], mv[2][4], t1[2], t2[2];
#pragma unroll
    for (int q = 0; q < 2; ++q) {
        const f32x4 lg = *(const f32x4*)(lrow + q * 256 + 4 * lane);
#pragma unroll
        for (int i = 0; i < 4; ++i) { sc[q][i] = sigm(lg[i]); mv[q][i] = sc[q][i] + bb[i]; }
        t1[q] = fmaxf(fmaxf(mv[q][0], mv[q][1]), fmaxf(mv[q][2], mv[q][3]));
        const float a = fmaxf(mv[q][0], mv[q][1]), bq = fminf(mv[q][0], mv[q][1]), c = fmaxf(mv[q][2], mv[q][3]), d = fminf(mv[q][2], mv[q][3]); t2[q] = fmaxf(fminf(a, c), fmaxf(bq, d));
    }
    top2_merge<0xB1>(t1[0], t2[0]); top2_merge<0xB1>(t1[1], t2[1]);
    top2_merge<0x4E>(t1[0], t2[0]); top2_merge<0x4E>(t1[1], t2[1]);
    top2_merge<0x141>(t1[0], t2[0]); top2_merge<0x141>(t1[1], t2[1]);
    const int mygrp = lane >> 3;
#pragma unroll
    for (int q = 0; q < 2; ++q) {
        const float gs = t1[q] + t2[q]; int rank = 0;
#pragma unroll
        for (int j = 0; j < 8; ++j) { const float o = __builtin_bit_cast(float, __builtin_amdgcn_readlane(__builtin_bit_cast(int, gs), 8 * j)); rank += (o > gs || (o == gs && j < mygrp)) ? 1 : 0; }
        if (rank >= 4) {
#pragma unroll
            for (int i = 0; i < 4; ++i) mv[q][i] = -3.0e38f;
        }
    }
    float wsel[2] = {0.f, 0.f}, wsum[2] = {0.f, 0.f}; int esel[2] = {0, 0};
#pragma unroll
    for (int r = 0; r < 8; ++r) {
        unsigned key[2];
#pragma unroll
        for (int q = 0; q < 2; ++q) {
            float bv = mv[q][0]; int bi = 0;
#pragma unroll
            for (int i = 1; i < 4; ++i) if (mv[q][i] > bv) { bv = mv[q][i]; bi = i; }
            unsigned u = __builtin_bit_cast(unsigned, bv); u = (u & 0x80000000u) ? ~u : (u | 0x80000000u);
            key[q] = (u & 0xFFFFFF00u) | (unsigned)(255 - (4 * lane + bi));
        }
        unsigned v0 = key[0], v1 = key[1], t0, t1_;
#define RSTEP(ctrl, rm, bc) t0 = (unsigned)__builtin_amdgcn_update_dpp(0, (int)v0, ctrl, rm, 0xf, bc); t1_ = (unsigned)__builtin_amdgcn_update_dpp(0, (int)v1, ctrl, rm, 0xf, bc); v0 = v0 > t0 ? v0 : t0; v1 = v1 > t1_ ? v1 : t1_;
        RSTEP(0x111, 0xf, true) RSTEP(0x112, 0xf, true) RSTEP(0x114, 0xf, true) RSTEP(0x118, 0xf, true) RSTEP(0x142, 0xa, false) RSTEP(0x143, 0xc, false)
#undef RSTEP
        const unsigned km[2] = {(unsigned)__builtin_amdgcn_readlane((int)v0, 63), (unsigned)__builtin_amdgcn_readlane((int)v1, 63)};
#pragma unroll
        for (int q = 0; q < 2; ++q) {
            const int e = 255 - (int)(km[q] & 255u), ii = e & 3;
            const float cand = ii == 0 ? sc[q][0] : ii == 1 ? sc[q][1] : ii == 2 ? sc[q][2] : sc[q][3];
            const float sv = __builtin_bit_cast(float, __builtin_amdgcn_readlane(__builtin_bit_cast(int, cand), e >> 2));
#pragma unroll
            for (int i = 0; i < 4; ++i) mv[q][i] = (4 * lane + i == e) ? -3.0e38f : mv[q][i];
            wsum[q] += sv;
            if (lane == r) { wsel[q] = sv; esel[q] = e; }
        }
    }
    if (lane < 8) {
#pragma unroll
        for (int q = 0; q < 2; ++q) { tidx[q * 8 + lane] = esel[q]; tw[q * 8 + lane] = wsel[q] / wsum[q] * 2.5f; etab[q * 8 + lane] = esel[q]; }
    }
}

__global__ void __launch_bounds__(NTHR, 2) mk_fwd(Params p) {
    extern __shared__ __attribute__((aligned(16))) unsigned char lds_raw[];
    LAS unsigned char* lds = (LAS unsigned char*)lds_raw;
    int tid = threadIdx.x, lane = tid & 63; const int wave = __builtin_amdgcn_readfirstlane(tid >> 6);
#define FRESH_IDS() do { int _t = threadIdx.x; asm volatile("; fresh ids" : "+v"(_t)); tid = _t; lane = _t & 63; } while (0)
    const int c = blockIdx.x, G = gridDim.x;
    const int gw = c * 8 + wave, ngw = G * 8;
    unsigned char* ws = p.ws;
    volatile LAS unsigned* MISC = (volatile LAS unsigned*)(lds + LDS_MISC);
    for (int u = tid; u < (LDS_BYTES - LDS_MISC) / 4; u += NTHR) ((LAS unsigned*)(lds + LDS_MISC))[u] = 0u;
    __syncthreads();
    XcdBarrier bar; bar.bar = (unsigned*)(ws + WS_BAR); bar.x = 0; bar.st = nullptr;
#if MK_ONE_LAUNCH
    bar = xcd_barrier_post((unsigned*)(ws + WS_BAR), MISC + 8);
#endif
    const int lo = p.ph_lo, hi = p.ph_hi;
#ifndef PH_MASK
#define PH_MASK 0x1ffff
#endif
#define IN(k) (((PH_MASK >> (k)) & 1) && lo <= (k) && (k) < hi)
#define SEAM(k) do { if (IN(k) && IN((k) + 1)) xcd_barrier(bar); } while (0)

    if (IN(0)) { FRESH_IDS(); phase0(p, lds, gw, ngw, lane, wave); }
    SEAM(0);
    if (IN(1)) { FRESH_IDS(); phase1(p, gw, ngw, lane); }
    SEAM(1);
    if (IN(2)) { FRESH_IDS();
        pg8::Gemm g{(const bf16_t*)(ws + WS_BIG(0)), (const bf16_t*)(ws + WS_WIN), 1024, nullptr};
        pg8::StaticOrder S; S.init(NTOK, 13 * 256, G, c); S.remap = 1;
        EpiWin E; E.q = (bf16_t*)(ws + WS_BIG(1)); E.k = E.q + (size_t)NTOK * 512; E.v = (bf16_t*)(ws + WS_BIG(2)); E.gr = (bf16_t*)(ws + WS_BIG(3));
        E.cq = (bf16_t*)(ws + WS_BIG(4)); E.ckv = E.cq + (size_t)NTOK * 768; E.sa = (bf16_t*)(ws + WS_BIG(5)); E.sb = (bf16_t*)(ws + WS_BIG(6));
        E.kr = (bf16_t*)(ws + WS_KR); E.ga = (float*)(ws + WS_GA);
        E.rope = (const float*)((unsigned char*)p.out + 192 * MiB); E.f8 = 0; E.ascale = 1.0f;
        pg8::gemm_phase<EpiWin, pg8::StaticOrder, false>(lds, g, S, E);
        pg8::Gemm g8{(const bf16_t*)(ws + WS_BIG(7)), (const bf16_t*)(ws + WS_WIN8), 512, nullptr};
        pg8::StaticOrder S8; S8.init(NTOK, 12 * 256, G, c);
        E.f8 = 1; E.ascale = 1.0f / 32.0f;
        pg8::gemm_phase<EpiWin, pg8::StaticOrder, false, true>(lds, g8, S8, E);
    }
    SEAM(2);
    if (IN(3)) { FRESH_IDS();
#ifndef NO_GLA
        if (c < 128 && !(p.flags & 1)) gla_phase(p, lds, c, (p.flags & 2) != 0);
#endif
#ifndef NO_P3GEMM
        if (!(p.flags & 2)) { const int pm = c;
            {
                const bf16_t* cqb = (const bf16_t*)(ws + WS_BIG(4)); const bf16_t* ckvb = cqb + (size_t)NTOK * 768;
                float* cqss = (float*)(ws + WS_CQSS); float* ckvss = (float*)(ws + WS_CKVSS);
                for (int r = 0; r < 32; ++r) { const int row = pm * 256 + wave * 32 + r;
                    float s = 0.f;
#pragma unroll
                    for (int j = 0; j < 3; ++j) { const u32x2 w = *((const u32x2*)(cqb + (size_t)row * 768) + lane + 64 * j); const float a0 = bflo(w.x), a1 = bfhi(w.x), a2 = bflo(w.y), a3 = bfhi(w.y); s += (a0 * a0 + a1 * a1) + (a2 * a2 + a3 * a3); }
                    const u32x2 w = *((const u32x2*)(ckvb + (size_t)row * 256) + lane); const float a0 = bflo(w.x), a1 = bfhi(w.x), a2 = bflo(w.y), a3 = bfhi(w.y);
                    const float s1 = wave_sum(s), s2 = wave_sum((a0 * a0 + a1 * a1) + (a2 * a2 + a3 * a3));
                    if (lane == 0) { cqss[row] = s1; ckvss[row] = s2; } }
                if (c >= 128 && G == 256) {
                    for (int r = 0; r < 32; ++r) { const int row = (pm - 128) * 256 + wave * 32 + r;
                        float s = 0.f;
#pragma unroll
                        for (int j = 0; j < 3; ++j) { const u32x2 w = *((const u32x2*)(cqb + (size_t)row * 768) + lane + 64 * j); const float a0 = bflo(w.x), a1 = bfhi(w.x), a2 = bflo(w.y), a3 = bfhi(w.y); s += (a0 * a0 + a1 * a1) + (a2 * a2 + a3 * a3); }
                        const float s1 = wave_sum(s);
                        if (lane == 0) cqss[row] = s1; }
                }
                wg_global_sync();
            }
#ifndef NO_QF
            {
                constexpr int QSPLIT = 2;
                const bool glawg = (c < 128) && G == 256;
                EpiQF E{(bf16_t*)p.out, (const float*)(ws + WS_CQSS), (const float*)((unsigned char*)p.out + 192 * MiB)};
                pg8::Gemm g{(const bf16_t*)(ws + WS_BIG(4)), (const bf16_t*)(ws + WS_WUQ), 768, nullptr};
                if (!glawg && G == 256) { pg8::PanelOrder S{pm - 128, 6 - QSPLIT, QSPLIT}; pg8::gemm_phase<EpiQF, pg8::PanelOrder, false>(lds, g, S, E); }
                { pg8::PanelOrder S{pm, glawg ? QSPLIT : 6, 0}; pg8::gemm_phase<EpiQF, pg8::PanelOrder, false>(lds, g, S, E); }
            }
#endif
#ifndef NO_KV
            { const K256Store E{(bf16_t*)(ws + WS_BIG(0)), 1024, (const float*)(ws + WS_CKVSS), 1.0f / 256.0f, (bf16_t*)(ws + WS_BIG(7)), 1024, 0};
              gemm_k256(lds, (const bf16_t*)(ws + WS_BIG(4)) + (size_t)NTOK * 768 + (size_t)pm * 65536, (const bf16_t*)(ws + WS_WUKV), 32, pm * 256, E); }
#endif
        }
#endif
    }
    SEAM(3);
    if (IN(4)) { FRESH_IDS(); attn_phase(p, lds, c); }
    SEAM(4);
    if (IN(5)) { FRESH_IDS();
        LAS int* hist = (LAS int*)lds;
        { const int pm = c;
            bf16_t* Y = (bf16_t*)(ws + WS_BIG(2));
            { pg8::Gemm g{(const bf16_t*)(ws + WS_BIG(3)), (const bf16_t*)(ws + WS_WGLAO), 1024, nullptr}; pg8::PanelOrder S{pm, 4, 0};
              EpiGate<false> E{Y, (const unsigned char*)(ws + WS_BIG(5))}; pg8::gemm_phase<EpiGate<false>, pg8::PanelOrder, false>(lds, g, S, E); }
            { pg8::Gemm g{(const bf16_t*)(ws + WS_BIG(1)), (const bf16_t*)(ws + WS_WMLAO), 1024, nullptr}; pg8::PanelOrder S{pm, 4, 0};
              EpiGate<true> E{Y, (const unsigned char*)(ws + WS_BIG(6))}; pg8::gemm_phase<EpiGate<true>, pg8::PanelOrder, false>(lds, g, S, E); }
            wg_global_sync();
            { pg8::Gemm g{Y, (const bf16_t*)(ws + WS_WOUT), 1024, nullptr}; pg8::PanelOrder S{pm, 4, 0};
              EpiBf16 E{(bf16_t*)(ws + ((p.flags & 4096) ? WS_BIG(7) : WS_BIG(1))), 1024}; pg8::gemm_phase<EpiBf16, pg8::PanelOrder, false>(lds, g, S, E); }
            wg_global_sync();
            if (!(p.flags & 4)) {
                const int b = pm >> 3; const float* mod = (const float*)(ws + WS_MOD) + b * 6144;
                const bf16_t* mix = (const bf16_t*)(ws + ((p.flags & 4096) ? WS_BIG(7) : WS_BIG(1))); bf16_t* h2 = (bf16_t*)(ws + WS_BIG(4));
                f32x4 g1[4], gg[4], gb[4], s2v[4], h2v[4];
#pragma unroll
                for (int j = 0; j < 4; ++j) { const int ci = lane + 64 * j; g1[j] = ((const f32x4*)(mod + 2048))[ci] + 1.0f; gg[j] = ((const f32x4*)p.in[I_LN1G])[ci]; gb[j] = ((const f32x4*)p.in[I_LN1B])[ci];
                    s2v[j] = ((const f32x4*)(mod + 4096))[ci] + 1.0f; h2v[j] = ((const f32x4*)(mod + 3072))[ci]; }
                for (int r0 = 0; r0 < 32; r0 += 4) {
                    const int row0 = pm * 256 + wave * 32 + r0;
                    f32x4 v[4][4]; u32x2 mw[4][4];
#pragma unroll
                    for (int t = 0; t < 4; ++t)
#pragma unroll
                        for (int j = 0; j < 4; ++j) { v[t][j] = ((const f32x4*)(p.in[I_X] + (size_t)(row0 + t) * 1024))[lane + 64 * j]; mw[t][j] = ((const u32x2*)(mix + (size_t)(row0 + t) * 1024))[lane + 64 * j]; }
#pragma unroll
                    for (int t = 0; t < 4; ++t) {
                        float s = 0.f;
#pragma unroll
                        for (int j = 0; j < 4; ++j) { const u32x2 w = mw[t][j]; v[t][j] = v[t][j] * ALPHA + g1[j] * (f32x4){bflo(w.x), bfhi(w.x), bflo(w.y), bfhi(w.y)}; s += (v[t][j][0] + v[t][j][1]) + (v[t][j][2] + v[t][j][3]); }
                        const float mean = wave_sum(s) * (1.f / 1024.f); float q = 0.f;
#pragma unroll
                        for (int j = 0; j < 4; ++j) { v[t][j] = v[t][j] - mean; q += (v[t][j][0] * v[t][j][0] + v[t][j][1] * v[t][j][1]) + (v[t][j][2] * v[t][j][2] + v[t][j][3] * v[t][j][3]); }
                        const float rstd = rsqrtf(wave_sum(q) * (1.f / 1024.f) + LN_EPS);
#pragma unroll
                        for (int j = 0; j < 4; ++j) { const f32x4 x1 = v[t][j] * rstd * gg[j] + gb[j];
                            { u32x2 xw; xw.x = pk2(x1[0], x1[1]); xw.y = pk2(x1[2], x1[3]); ((u32x2*)(p.out + (size_t)(row0 + t) * 1024))[lane + 64 * j] = xw; }
                            const f32x4 hh = x1 * s2v[j] + h2v[j]; u32x2 w; w.x = pk2(hh[0], hh[1]); w.y = pk2(hh[2], hh[3]);
                            ((u32x2*)(h2 + (size_t)(row0 + t) * 1024))[lane + 64 * j] = w;
                            unsigned w8 = 0u; w8 = __builtin_amdgcn_cvt_pk_fp8_f32(hh[0], hh[1], w8, false); w8 = __builtin_amdgcn_cvt_pk_fp8_f32(hh[2], hh[3], w8, true);
                            ((unsigned*)(ws + WS_BIG(6) + 64 * MiB + (size_t)(row0 + t) * 1024))[lane + 64 * j] = w8; }
                    }
                }
            }
            wg_global_sync();
            { pg8::Gemm g{(const bf16_t*)(ws + WS_BIG(4)), (const bf16_t*)(ws + WS_WRT), 1024, nullptr}; pg8::PanelOrder S{pm, 1, 0};
              EpiF32 E{(float*)(ws + WS_BIG(0)), 256}; pg8::gemm_phase<EpiF32, pg8::PanelOrder, false>(lds, g, S, E); }
            { pg8::Gemm g{(const bf16_t*)(ws + WS_BIG(4)), (const bf16_t*)(ws + WS_WS13), 1024, nullptr}; pg8::PanelOrder S{pm, 2, 0};
              EpiGLU E{(bf16_t*)(ws + WS_BIG(0) + 64 * MiB), 1.0f, 0}; pg8::gemm_phase<EpiGLU, pg8::PanelOrder, false>(lds, g, S, E); }
            wg_global_sync();
            { const K256Store E{(bf16_t*)(ws + WS_BIG(7)), 1024, nullptr, 0.f, nullptr, 0, 0};
              gemm_k256(lds, (const bf16_t*)(ws + WS_BIG(0) + 64 * MiB) + (size_t)pm * 65536, (const bf16_t*)(ws + WS_WS2), 16, pm * 256, E); }
            if (!(p.flags & 8)) {
            LAS int* etab = (LAS int*)(lds + 1024);
            LAS int* lrk = (LAS int*)(lds + 1024 + 8192);
            __syncthreads();
            for (int r = 0; r < 32; r += 2) { const int rl = wave * 32 + r, row = pm * 256 + rl;
                route_row2((const float*)(ws + WS_BIG(0)) + (size_t)row * 256, p.in[I_BRT], (int*)(ws + WS_TIDX) + row * 8, (float*)(ws + WS_TW) + row * 8, etab + rl * 8, lane); }
            __syncthreads();
            if (tid < 256) { int cnt = 0;
#pragma unroll 8
                for (int a2 = 0; a2 < 2048; ++a2) if (etab[a2] == tid) { lrk[a2] = cnt; ++cnt; }
                hist[tid] = cnt; }
            __syncthreads();
            if (tid < 256) ((int*)(ws + WS_CNTWG))[pm * 256 + tid] = hist[tid];
#pragma unroll
            for (int i = 0; i < 4; ++i) ((int*)(ws + WS_LRANK))[pm * 2048 + tid + 512 * i] = lrk[tid + 512 * i];
            __syncthreads();
            }
        }
    }
    SEAM(5);
    if (IN(6)) { FRESH_IDS();
        LAS int* pstart = (LAS int*)lds;
        LAS int* wbase = (LAS int*)(lds + 2048);
        LAS int* tot = (LAS int*)(lds + 4096);
        const int* cntwg = (const int*)(ws + WS_CNTWG);
        { const int pm = c;
            if (tid < 256) { int t = 0, bs = 0; for (int w = 0; w < 256; ++w) { const int v = cntwg[w * 256 + tid]; t += v; bs += (w < pm) ? v : 0; } tot[tid] = t; wbase[tid] = bs; }
            __syncthreads();
            if (tid == 0) { int run = 0; for (int e = 0; e < 256; ++e) { pstart[e] = run; run += (tot[e] + 255) & ~255; } pstart[256] = run; }
            __syncthreads();
            if (pm == 0 && tid <= 256) ((int*)(ws + WS_TAB))[tid] = pstart[tid];
            const int* tidx = (const int*)(ws + WS_TIDX); int* lrank = (int*)(ws + WS_LRANK);
            int* stok = (int*)(ws + WS_STOK);
#pragma unroll
            for (int i = 0; i < 4; ++i) { const int a = pm * 2048 + tid * 4 + i; const int e = tidx[a]; const int slot = pstart[e] + wbase[e] + lrank[a]; stok[slot] = a >> 3; ((int*)(ws + WS_SW))[a] = slot; }
            __syncthreads();
        }
        LAS unsigned* scr = (LAS unsigned*)(lds + 8192 + wave * 8448);
        bf16_t* e13 = (bf16_t*)(ws + WS_BIG(5)); bf16_t* e2 = (bf16_t*)(ws + WS_BIG(0));
        for (int it = gw; it < 256 * 96; it += ngw) {
            const int e = it / 96, r = it % 96;
            if (r < 64) tr_glu8_item(p.in[I_WE1] + (size_t)e * 262144, p.in[I_WE3] + (size_t)e * 262144, 1024, 256, (unsigned char*)e13 + (size_t)e * 524288, scr, r >> 3, r & 7, lane);
            else { const int r2 = r - 64; tr8_item(p.in[I_WE2] + (size_t)e * 262144, 256, 1024, (unsigned char*)e2 + (size_t)e * 262144, MapId{0}, scr, r2 >> 4, r2 & 15, lane); }
        }
    }
    SEAM(6);
    constexpr int GT = 1536, NGRP = 2;
    bf16_t* ffn = (bf16_t*)(ws + WS_BIG(7));
    unsigned char* out8 = ws + WS_BIG(1);
    bf16_t* hidscr = c < 192 ? (bf16_t*)(ws + WS_WIN) + (size_t)c * 65536 : (bf16_t*)(ws + WS_KR) + (size_t)(c - 192) * 65536;
    for (int grp = 0; grp < NGRP; ++grp) {
        const int phg = 7 + 2 * grp;
        if (IN(phg)) { FRESH_IDS();
            LAS int* pstart = (LAS int*)(lds + LDS_MISC + 256);
            for (int i = tid; i <= 256; i += NTHR) pstart[i] = ((const int*)(ws + WS_TAB))[i];
            __syncthreads();
            const int ntiles = pstart[256] >> 8;
            const int t1 = (grp + 1) * GT < ntiles ? (grp + 1) * GT : ntiles;
            for (int T = grp * GT + (c & 7) * 32 + (c >> 3); T < t1; T += G) {
                int e = 0; { int lo_ = 0, hi_ = 256; while (hi_ - lo_ > 1) { const int mid = (lo_ + hi_) >> 1; if ((pstart[mid] >> 8) <= T) lo_ = mid; else hi_ = mid; } e = lo_; }
                e = __builtin_amdgcn_readfirstlane(e);
                if (!(p.flags & 32)) { pg8::Gemm g{(const bf16_t*)(ws + WS_BIG(6) + 64 * MiB), (const bf16_t*)(ws + WS_BIG(5)) + (size_t)e * 262144, 512, (const int*)(ws + WS_STOK)}; pg8::PanelOrder S{T, 2, 0};
                  EpiGLU E{(bf16_t*)((unsigned char*)hidscr - (ptrdiff_t)T * 65536), 1.0f / 32.0f, 1}; pg8::gemm_phase<EpiGLU, pg8::PanelOrder, true, true>(lds, g, S, E); }
                wg_global_sync();
                if (!(p.flags & 64)) gemm_k256_f8(lds, (const unsigned char*)hidscr, ws + WS_BIG(0) + (size_t)e * 262144, 16, T * 256, out8 - (ptrdiff_t)grp * GT * 262144, 1024, 1.0f / 32.0f);
            }
        }
        SEAM(phg);
        if (IN(phg + 1)) { FRESH_IDS();
            const int s0 = grp * GT * 256, s1 = s0 + GT * 256;
            const int* slot_of = (const int*)(ws + WS_SW); const float* tw = (const float*)(ws + WS_TW);
            const bool fin = (grp == NGRP - 1);
#define F8_ACC(dst, w16, wk) do { const u32x4 w_ = (w16); const float k_ = (wk); _Pragma("unroll") for (int j_ = 0; j_ < 4; ++j_) { \
                const f32x2 lo_ = __builtin_amdgcn_cvt_pk_f32_fp8(w_[j_], false), hi_ = __builtin_amdgcn_cvt_pk_f32_fp8(w_[j_], true); \
                dst[j_] += (f32x4){lo_[0], lo_[1], hi_[0], hi_[1]} * k_; } } while (0)
            for (int m0 = gw * 4; m0 < NTOK; m0 += ngw * 4) {
                int sl = -1; float wv = 0.f;
                if (lane < 32) { sl = slot_of[m0 * 8 + lane]; wv = tw[m0 * 8 + lane] * (1.0f / F8_SCALE); }
                const bool hit = sl >= s0 && sl < s1;
                const unsigned long long bal = __ballot(hit);
                f32x4 a[4][4];
#pragma unroll
                for (int t = 0; t < 4; ++t) { const u32x4* fr4 = (const u32x4*)(ffn + (size_t)(m0 + t) * 1024) + 2 * lane; const u32x4 f0 = fr4[0], f1 = fr4[1];
                    unpack8(f0, a[t][0], a[t][1]); unpack8(f1, a[t][2], a[t][3]); }
                u32x4 rw[4][3]; float rwt[4][3];
#pragma unroll
                for (int t = 0; t < 4; ++t) {
                    unsigned mk = (unsigned)(bal >> (8 * t)) & 0xffu;
#pragma unroll
                    for (int q = 0; q < 3; ++q) {
                        const int k = mk ? __builtin_ctz(mk) : 0; const bool ok = mk != 0u; mk &= mk - 1u;
                        const int sk = __shfl(sl, 8 * t + k); rwt[t][q] = ok ? __shfl(wv, 8 * t + k) : 0.f;
                        u32x4 w = __builtin_nontemporal_load((const u32x4*)(out8 + (size_t)(ok ? sk - s0 : 0) * 1024) + lane); if (!ok) w = (u32x4){0u, 0u, 0u, 0u};
                        rw[t][q] = w;
                    }
                }
#pragma unroll
                for (int t = 0; t < 4; ++t) {
#pragma unroll
                    for (int q = 0; q < 3; ++q) F8_ACC(a[t], rw[t][q], rwt[t][q]);
                    unsigned mk = (unsigned)(bal >> (8 * t)) & 0xffu; mk &= mk - 1u; mk &= mk - 1u; mk &= mk - 1u;
                    while (mk) { const int k = __builtin_ctz(mk); mk &= mk - 1u; const int sk = __shfl(sl, 8 * t + k); const float wk = __shfl(wv, 8 * t + k);
                        const u32x4 w = __builtin_nontemporal_load((const u32x4*)(out8 + (size_t)(sk - s0) * 1024) + lane); F8_ACC(a[t], w, wk); }
                }
                if (!fin) {
#pragma unroll
                    for (int t = 0; t < 4; ++t) if (((bal >> (8 * t)) & 0xffull) != 0ull && !(p.flags & 16)) {
                        u32x4* fw4 = (u32x4*)(ffn + (size_t)(m0 + t) * 1024) + 2 * lane; fw4[0] = pack8(a[t][0], a[t][1]); fw4[1] = pack8(a[t][2], a[t][3]); }
                } else {
                    const int b = m0 >> 11; const float* gt2 = (const float*)(ws + WS_MOD) + b * 6144 + 5 * 1024;
                    f32x4 gv[4], lg[4], lb[4];
#pragma unroll
                    for (int j = 0; j < 4; ++j) { gv[j] = ((const f32x4*)gt2)[4 * lane + j] + 1.0f; lg[j] = ((const f32x4*)p.in[I_LN2G])[4 * lane + j]; lb[j] = ((const f32x4*)p.in[I_LN2B])[4 * lane + j]; }
                    f32x4 v[4][4];
#pragma unroll
                    for (int t = 0; t < 4; ++t)
#pragma unroll
                        for (int j = 0; j < 4; j += 2) { const u32x4 xw = ((const u32x4*)(p.out + (size_t)(m0 + t) * 1024))[2 * lane + (j >> 1)]; unpack8(xw, v[t][j], v[t][j + 1]); }
#pragma unroll
                    for (int t = 0; t < 4; ++t) {
                        float sacc = 0.f;
#pragma unroll
                        for (int j = 0; j < 4; ++j) { v[t][j] = v[t][j] * ALPHA + gv[j] * a[t][j]; sacc += (v[t][j][0] + v[t][j][1]) + (v[t][j][2] + v[t][j][3]); }
                        const float mean = wave_sum(sacc) * (1.f / 1024.f); float s2 = 0.f;
#pragma unroll
                        for (int j = 0; j < 4; ++j) { v[t][j] = v[t][j] - mean; s2 += (v[t][j][0] * v[t][j][0] + v[t][j][1] * v[t][j][1]) + (v[t][j][2] * v[t][j][2] + v[t][j][3] * v[t][j][3]); }
                        const float rstd = rsqrtf(wave_sum(s2) * (1.f / 1024.f) + LN_EPS);
#pragma unroll
                        for (int j = 0; j < 4; ++j) ((f32x4*)(p.out + (size_t)(m0 + t) * 1024))[4 * lane + j] = v[t][j] * rstd * lg[j] + lb[j];
                    }
                }
            }
#undef F8_ACC
        }
        if (grp < NGRP - 1) SEAM(phg + 1);
    }
}


__global__ void dump_bf16(const bf16_t* src, float* dst, size_t n) { for (size_t i = (size_t)blockIdx.x * blockDim.x + threadIdx.x; i < n; i += (size_t)gridDim.x * blockDim.x) dst[i] = bf2f(src[i]); }
extern "C" void kernel_launch(void* const* d_in, const int* in_sizes, int n_in, void* d_out, int out_size, void* d_ws, size_t ws_size, hipStream_t stream) {
    static int ready = 0;
    if (!ready) {
        if (n_in != 28 || out_size != NTOK * DM || ws_size < WS_END) { fprintf(stderr, "kernel_launch: unexpected problem (n_in %d out %d ws %zu need %zu)\n", n_in, out_size, ws_size, (size_t)WS_END); return; }
        if (hipFuncSetAttribute((const void*)mk_fwd, hipFuncAttributeMaxDynamicSharedMemorySize, LDS_BYTES) != hipSuccess) { fprintf(stderr, "kernel_launch: hipFuncSetAttribute failed\n"); return; }
        ready = 1;
    }
    (void)hipMemsetAsync((char*)d_ws + WS_CTL, 0, CTL_ZERO_BYTES, stream);
    Params p{};
    for (int i = 0; i < 28; ++i) p.in[i] = (const float*)d_in[i];
    p.out = (float*)d_out; p.ws = (unsigned char*)d_ws;
#if MK_ONE_LAUNCH
    p.ph_lo = 0; p.ph_hi = 11;
    hipLaunchKernelGGL(mk_fwd, dim3(NWG), dim3(NTHR), LDS_BYTES, stream, p);
#else
#ifndef DIAG_NPH
#define DIAG_NPH 11
#endif
#ifndef DIAG_REP_MASK
#define DIAG_REP_MASK 0
#endif
#ifndef DIAG_REP_FLAGS
#define DIAG_REP_FLAGS 1
#endif
    for (int k = 0; k < DIAG_NPH; ++k) { p.ph_lo = k; p.ph_hi = k + 1;
        if (((DIAG_REP_MASK >> k) & 1) && (DIAG_REP_FLAGS & ~31)) { p.flags = DIAG_REP_FLAGS; hipLaunchKernelGGL(mk_fwd, dim3(NWG), dim3(NTHR), LDS_BYTES, stream, p); }
        p.flags = 0; hipLaunchKernelGGL(mk_fwd, dim3(NWG), dim3(NTHR), LDS_BYTES, stream, p);
        if (((DIAG_REP_MASK >> k) & 1) && !(DIAG_REP_FLAGS & ~31)) { p.flags = DIAG_REP_FLAGS; hipLaunchKernelGGL(mk_fwd, dim3(NWG), dim3(NTHR), LDS_BYTES, stream, p); } }
#ifdef DIAG_DUMP
    hipLaunchKernelGGL(dump_bf16, dim3(2048), dim3(256), 0, stream, (const bf16_t*)((unsigned char*)d_ws + DIAG_DUMP), (float*)d_out, (size_t)NTOK * 1024);
#endif
#endif
}
```

```cpp
#include <hip/hip_runtime.h>
#include <cstdio>
#include <cstdint>

#ifndef MK_ONE_LAUNCH
#define MK_ONE_LAUNCH 1
#endif

#define GAS __attribute__((address_space(1)))
#define LAS __attribute__((address_space(3)))
typedef unsigned short bf16_t;
typedef short bf16x8 __attribute__((ext_vector_type(8)));
typedef short bf16x4 __attribute__((ext_vector_type(4)));
typedef float f32x4 __attribute__((ext_vector_type(4)));
typedef float f32x2 __attribute__((ext_vector_type(2)));
typedef unsigned u32x4 __attribute__((ext_vector_type(4)));
typedef unsigned u32x2 __attribute__((ext_vector_type(2)));

constexpr int NTOK = 65536, DM = 1024, SEQ = 2048, NB = 32;
constexpr int NWG = 256, NTHR = 512;
constexpr float LN_EPS = 1e-5f, RMS_EPS = 1e-6f;
constexpr float ALPHA = 1.189207115002721f;
constexpr float QSCALE = 0.07216878364870322f * 1.4426950408889634f;
constexpr int NSLOT = 589824;

constexpr size_t MiB = 1u << 20;
constexpr size_t WS_CTL = 0, CTL_ZERO_BYTES = 3 * MiB;
constexpr size_t WS_BAR = 16384;
constexpr size_t WS_MOD = 1 * MiB;
constexpr size_t WS_CQSS = 2 * MiB, WS_CKVSS = 2 * MiB + 256 * 1024;
constexpr size_t WS_TAB = 3 * MiB;
constexpr size_t WS_CNTWG = 3 * MiB + 64 * 1024;
constexpr size_t WS_WIN = 4 * MiB;
constexpr size_t WS_WGLAO = WS_WIN + 6400 * 1024 * 2;
constexpr size_t WS_WUQ = WS_WGLAO + 2 * MiB;
constexpr size_t WS_WUKV = WS_WUQ + 1536 * 768 * 2;
constexpr size_t WS_WMLAO = WS_WUKV + 1 * MiB;
constexpr size_t WS_WOUT = WS_WMLAO + 2 * MiB;
constexpr size_t WS_WRT = WS_WOUT + 2 * MiB;
constexpr size_t WS_WS13 = WS_WRT + 512 * 1024;
constexpr size_t WS_WS2 = WS_WS13 + 1 * MiB;
static_assert(WS_WS2 + 512 * 1024 <= 28 * MiB, "small weights");
constexpr size_t WS_TIDX = 28 * MiB, WS_TW = 30 * MiB, WS_LRANK = 32 * MiB, WS_STOK = 34 * MiB, WS_SW = 37 * MiB;
constexpr size_t WS_WIN8 = 52 * MiB;
constexpr size_t WS_KR = 40 * MiB;
constexpr size_t WS_GA = 48 * MiB;
constexpr size_t WS_BIG0 = 56 * MiB, BIGU = 128 * MiB;
#define WS_BIG(i) (WS_BIG0 + (size_t)(i) * BIGU)
constexpr size_t WS_END = WS_BIG0 + 8 * BIGU;

typedef __bf16 bf16v2_t __attribute__((ext_vector_type(2)));
__device__ __forceinline__ unsigned pk2(float lo, float hi) { const f32x2 v = {lo, hi}; const bf16v2_t r = __builtin_convertvector(v, bf16v2_t); return __builtin_bit_cast(unsigned, r); }
__device__ __forceinline__ float bflo(unsigned w) { return __uint_as_float(w << 16); }
__device__ __forceinline__ float bfhi(unsigned w) { return __uint_as_float(w & 0xffff0000u); }
__device__ __forceinline__ float bf2f(bf16_t b) { return __uint_as_float(((unsigned)b) << 16); }
__device__ __forceinline__ bf16_t f2bf(float f) { return (bf16_t)(pk2(f, 0.f) & 0xffffu); }
__device__ __forceinline__ float sigm(float x) { return __builtin_amdgcn_rcpf(1.0f + __expf(-x)); }
__device__ __forceinline__ float silu(float x) { return x * __builtin_amdgcn_rcpf(1.0f + __expf(-x)); }
__device__ __forceinline__ float wave_sum(float v) {
#pragma unroll
    for (int o = 1; o < 64; o <<= 1) v += __shfl_xor(v, o);
    return v;
}
#define LDS_WAIT() asm volatile("s_waitcnt lgkmcnt(0)" ::: "memory")
#define VM_WAIT() asm volatile("s_waitcnt vmcnt(0)" ::: "memory")

#define XB_TMO      128
#define XB_XCNT(j)  (256  + 64 * (j))
#define XB_XSUB(j)  (1280 + 64 * (j))
#define XB_XGEN(j)  (2304 + 64 * (j))
#define XB_TOP      3328
#define XB_TOPGEN   3392
#define XCD_BAR_WORDS 3456
#define XB_SPIN_CAP (1u << 18)
__device__ __forceinline__ unsigned xb_ld(unsigned* p)              { return __hip_atomic_load(p, __ATOMIC_RELAXED, __HIP_MEMORY_SCOPE_AGENT); }
__device__ __forceinline__ unsigned xb_add(unsigned* p, unsigned v) { return __hip_atomic_fetch_add(p, v, __ATOMIC_RELAXED, __HIP_MEMORY_SCOPE_AGENT); }
__device__ __forceinline__ unsigned xb_xcc_id() { return (unsigned)__builtin_amdgcn_s_getreg((3 << 11) | 20) & 0xFu; }
#define XB_SPIN(cond, bar) do { unsigned _sp = 0; while (cond) { __builtin_amdgcn_s_sleep(1); \
    if ((++_sp & 255u) == 0u) { if (xb_ld(&(bar)[XB_TMO])) break; if (_sp > XB_SPIN_CAP) { atomicAdd(&(bar)[XB_TMO], 1u); break; } } } } while (0)
struct XcdBarrier { unsigned* bar; unsigned x; volatile LAS unsigned* st; };
__device__ __forceinline__ XcdBarrier xcd_barrier_post(unsigned* bar, volatile LAS unsigned* st) {
    XcdBarrier b; b.bar = bar; b.x = xb_xcc_id(); b.st = st;
    if (threadIdx.x == 0) (void)xb_add(&bar[XB_XCNT(b.x)], 1u);
    return b;
}
__device__ __forceinline__ void xcd_barrier_complete(unsigned* bar, unsigned x, unsigned& nloc, unsigned& nx) {
    const unsigned G = gridDim.x * gridDim.y * gridDim.z;
    unsigned sum, cnt, mine, sp = 0u;
    for (;;) {
        sum = 0u; cnt = 0u; mine = 0u;
#pragma unroll
        for (unsigned j = 0; j < 16; ++j) { const unsigned c = xb_ld(&bar[XB_XCNT(j)]); sum += c; cnt += (c > 0u) ? 1u : 0u; mine = (j == x) ? c : mine; }
        if (sum == G) break;
        __builtin_amdgcn_s_sleep(1);
        if ((++sp & 255u) == 0u) { if (xb_ld(&bar[XB_TMO])) break; if (sp > XB_SPIN_CAP) { atomicAdd(&bar[XB_TMO], 1u); break; } }
    }
    nloc = mine > 0u ? mine : 1u; nx = cnt > 0u ? cnt : 1u;
}
__device__ __forceinline__ void xcd_barrier(const XcdBarrier& b) {
    asm volatile("s_waitcnt vmcnt(0)" ::: "memory");
    __syncthreads();
    if (threadIdx.x == 0) {
        unsigned* bar = b.bar;
        __builtin_amdgcn_s_waitcnt(0);
        unsigned nloc = b.st[0], nx = b.st[1];
        if (nloc == 0u) { xcd_barrier_complete(bar, b.x, nloc, nx); b.st[0] = nloc; b.st[1] = nx; }
        const unsigned old = xb_add(&bar[XB_XSUB(b.x)], 1u);
        const unsigned gen = old / nloc;
        if (old + 1u == (gen + 1u) * nloc) {
            __builtin_amdgcn_fence(__ATOMIC_RELEASE, "agent");
            asm volatile("s_waitcnt vmcnt(0)" ::: "memory");
            const unsigned og = xb_add(&bar[XB_TOP], 1u);
            const unsigned tg = og / nx;
            if (og + 1u == (tg + 1u) * nx) xb_add(&bar[XB_TOPGEN], 1u);
            else XB_SPIN(xb_ld(&bar[XB_TOPGEN]) == tg, bar);
            __builtin_amdgcn_fence(__ATOMIC_ACQUIRE, "agent");
            xb_add(&bar[XB_XGEN(b.x)], 1u);
            asm volatile("s_waitcnt vmcnt(0)" ::: "memory");
        } else {
            XB_SPIN(xb_ld(&bar[XB_XGEN(b.x)]) == gen, bar);
            __builtin_amdgcn_fence(__ATOMIC_ACQUIRE, "agent");
            asm volatile("s_waitcnt vmcnt(0)" ::: "memory");
        }
    }
    __syncthreads();
}
__device__ __forceinline__ void wg_global_sync() {
    asm volatile("s_waitcnt vmcnt(0)" ::: "memory");
    __syncthreads();
    if (threadIdx.x < 64) {
        __builtin_amdgcn_fence(__ATOMIC_ACQUIRE, "agent");
        asm volatile("s_waitcnt vmcnt(0)" ::: "memory");
    }
    __syncthreads();
}

namespace pg8 {
constexpr int BM = 256, BK = 64, HALF = 128, HTB = HALF * BK * 2, STAGE_BYTES = 8 * HTB;
__host__ __device__ __forceinline__ int lds_byte(int r, int c) { const int st = (r >> 4) * 2 + (c >> 5), rr = r & 15, cc = c & 31, ob = rr * 64 + cc * 2; return st * 1024 + (ob ^ (((ob >> 9) & 1) << 5)); }
__host__ __device__ __forceinline__ void stage_rc(int b, int& R, int& C) { const int st = b / 1024, sb = b % 1024, swz = sb ^ (((sb >> 9) & 1) << 5); R = (st >> 1) * 16 + swz / 64; C = (st & 1) * 32 + (swz % 64) / 2; }
__host__ __device__ __forceinline__ int perm32(int rho) { const int n = rho >> 4, i = rho & 15; return 8 * (i >> 2) + 4 * n + (i & 3); }
struct Unit { int pm, pn; };
struct Gemm { const bf16_t* A; const bf16_t* Bt; int K; const LAS int* ridx; int rt0, rtstep; };
struct StaticOrder {
    int nM, nN, nwg, G, c, remap;
    __device__ void init(int M, int N, int G_, int c_) { nM = M / BM; nN = N / BM; nwg = nM * nN; G = G_; c = c_; remap = 0; }
    __device__ bool next(int i, Unit& u) const {
        const long L = (long)i * G + c; if (L >= nwg) return false;
        int wgid = (int)L; { const int q = nwg / 8, r = nwg % 8, xcd = wgid % 8, off = wgid / 8; wgid = (xcd < r ? xcd * (q + 1) : r * (q + 1) + (xcd - r) * q) + off; }
        const int nig = 8 * nN, gid = wgid / nig, fm = gid * 8, gsz = (nM - fm) < 8 ? (nM - fm) : 8;
        u.pm = fm + ((wgid % nig) % gsz); u.pn = (wgid % nig) / gsz; if (remap) u.pn = u.pn < 8 ? u.pn : u.pn < 12 ? u.pn + 4 : 24; return true;
    }
};
struct PanelOrder {
    int pm, nN, pn0;
    __device__ bool next(int i, Unit& u) const { int nq = nN; asm volatile("; opaque nN" : "+s"(nq)); if (i >= nq) return false; int a = pm, b = pn0 + i; asm volatile("; opaque unit" : "+s"(a), "+s"(b)); u.pm = a; u.pn = b; return true; }
};

typedef int i32x8 __attribute__((ext_vector_type(8)));
struct MoeUpOrder {
    int t0, tstep, t1; const LAS int* pstart;
    __device__ __forceinline__ bool next(int i, Unit& u) const {
        int T = t0 + (i >> 1) * tstep; asm volatile("; opaque T" : "+s"(T)); if (T >= t1) return false;
        int lo_ = 0, hi_ = 256; while (hi_ - lo_ > 1) { const int mid = (lo_ + hi_) >> 1; if ((pstart[mid] >> 8) <= T) lo_ = mid; else hi_ = mid; }
        int a = T, b = 2 * __builtin_amdgcn_readfirstlane(lo_) + (i & 1); asm volatile("; opaque unit" : "+s"(a), "+s"(b)); u.pm = a; u.pn = b; return true;
    }
};
template <class Epi, class Sched, bool GATHER, bool FP8 = false>
__device__ __forceinline__ void gemm_phase(LAS unsigned char* lds, const Gemm g, const Sched& S, const Epi& E) {
    int tid_ = threadIdx.x; asm volatile("; pg8 ids" : "+v"(tid_));
    const int tid = tid_, wid = __builtin_amdgcn_readfirstlane(tid >> 6), lane = tid & 63, wr = wid >> 2, wc = wid & 3, fr = lane & 15, fq = lane >> 4;
    int Kq = g.K; asm volatile("; opaque K" : "+s"(Kq));
    const int K = Kq, nt = K / BK;
    Unit cur, nxt; int ui = 0;
    if (!S.next(0, cur)) return;
    unsigned aoff[2][2], voffB[2];
#pragma unroll
    for (int i = 0; i < 2; ++i) { int R, C; stage_rc(tid * 16 + i * 8192, R, C); const int Rb = Epi::PERM ? ((R & ~31) + perm32(R & 31)) : R;
        voffB[i] = (unsigned)(Rb * K + C) * 2u;
#pragma unroll
        for (int h = 0; h < 2; ++h) {
            if (GATHER) { int t = g.ridx[((cur.pm - g.rt0) >> g.rtstep) * BM + h * HALF + R]; t = t < 0 ? 0 : t; aoff[h][i] = (unsigned)(t * K + C) * 2u; }
            else aoff[h][i] = (unsigned)((h * HALF + R) * K + C) * 2u;
        } }
    const size_t kstep = (size_t)(BK * 2);
    const size_t hstep = (size_t)HALF * K * 2;
    const size_t tstep = 2 * hstep;
    const unsigned ldsw = (unsigned)wid * 1024u;
    const int aoffl0 = lds_byte(wr * 64 + fr, fq * 8), aoffl1 = aoffl0 + 1024;
    const int boffl0 = lds_byte(wc * 32 + fr, fq * 8), boffl1 = boffl0 + 1024;
#define PG8_SA(b, h) (((b) * 2 + (h)) * HTB)
#define PG8_SB(b, h) ((4 + (b) * 2 + (h)) * HTB)
#define PG8_STAGE(bufoff, gbase, voff) do { _Pragma("unroll") for (int _i = 0; _i < 2; ++_i) \
        __builtin_amdgcn_global_load_lds((const unsigned*)((const char*)(gbase) + (voff)[_i]), (LAS unsigned*)(lds + (bufoff) + ldsw + _i * 8192), 16, 0, 0); } while (0)
#define PG8_STAGE_A(bufoff, gbase, h) PG8_STAGE(bufoff, gbase, aoff[h])
#define PG8_STAGE_AN(bufoff, gbase, h) PG8_STAGE(bufoff, gbase, aoff[h])
#define PG8_SWAPH(_h) do { if (GATHER && last && has_next) { int tq_ = threadIdx.x; asm volatile("; swap ids" : "+v"(tq_)); int R_, C_; stage_rc(tq_ * 16, R_, C_); const LAS int* rp_ = g.ridx + ((nxt.pm - g.rt0) >> g.rtstep) * BM + (_h) * HALF + R_;   \
        int t0_ = rp_[0], t1_ = rp_[64]; t0_ = t0_ < 0 ? 0 : t0_; t1_ = t1_ < 0 ? 0 : t1_; aoff[_h][0] = (unsigned)(t0_ * K + C_) * 2u; aoff[_h][1] = (unsigned)(t1_ * K + C_) * 2u; } } while (0)
#define PG8_SWAPN PG8_SWAPH(1)
#define PG8_LDA(dst, b, h) do { _Pragma("unroll") for (int m = 0; m < 4; ++m) _Pragma("unroll") for (int k = 0; k < 2; ++k) dst[m][k] = *(const LAS bf16x8*)(lds + PG8_SA(b, h) + aoffl0 + m * 2048 + k * 1024); } while (0)
#define PG8_LDA8(dst, b, h) do { _Pragma("unroll") for (int m = 0; m < 4; ++m) { const u32x4 x0_ = *(const LAS u32x4*)(lds + PG8_SA(b, h) + aoffl0 + m * 2048), x1_ = *(const LAS u32x4*)(lds + PG8_SA(b, h) + aoffl1 + m * 2048); dst[m] = __builtin_bit_cast(i32x8, __builtin_shufflevector(x0_, x1_, 0, 1, 2, 3, 4, 5, 6, 7)); } } while (0)
#define PG8_LDB(dst, b, h) do { _Pragma("unroll") for (int n = 0; n < 2; ++n) _Pragma("unroll") for (int k = 0; k < 2; ++k) dst[n][k] = *(const LAS bf16x8*)(lds + PG8_SB(b, h) + boffl0 + n * 2048 + k * 1024); } while (0)
#define PG8_LDB8(dst, b, h) do { _Pragma("unroll") for (int n = 0; n < 2; ++n) { const u32x4 x0_ = *(const LAS u32x4*)(lds + PG8_SB(b, h) + boffl0 + n * 2048), x1_ = *(const LAS u32x4*)(lds + PG8_SB(b, h) + boffl1 + n * 2048); dst[n] = __builtin_bit_cast(i32x8, __builtin_shufflevector(x0_, x1_, 0, 1, 2, 3, 4, 5, 6, 7)); } } while (0)
#define PG8_MMA(ai, bj, At, Bt) do { __builtin_amdgcn_s_setprio(1); _Pragma("unroll") for (int m = 0; m < 4; ++m) _Pragma("unroll") for (int n = 0; n < 2; ++n) _Pragma("unroll") for (int k = 0; k < 2; ++k) \
        acc[ai][bj][m][n] = __builtin_amdgcn_mfma_f32_16x16x32_bf16(Bt[n][k], At[m][k], acc[ai][bj][m][n], 0, 0, 0); __builtin_amdgcn_s_setprio(0); } while (0)
#define PG8_MMA8(ai, bj, At, Bt) do { __builtin_amdgcn_s_setprio(1); _Pragma("unroll") for (int m = 0; m < 4; ++m) _Pragma("unroll") for (int n = 0; n < 2; ++n) \
        asm volatile("v_mfma_f32_16x16x128_f8f6f4 %0, %1, %2, %0" : "+v"(acc[ai][bj][m][n]) : "v"(Bt[n]), "v"(At[m])); __builtin_amdgcn_s_setprio(0); } while (0)
#define PG8_WAIT_V(n) asm volatile("s_waitcnt vmcnt(" #n ")" ::: "memory")
#define PG8_WAIT_L(n) asm volatile("s_waitcnt lgkmcnt(" #n ")" ::: "memory")
#define PG8_BAR __builtin_amdgcn_s_barrier()
#define PG8_SCHED __builtin_amdgcn_sched_barrier(0)
    f32x4 acc[2][2][4][2];
#pragma unroll
    for (int a = 0; a < 2; ++a)
#pragma unroll
        for (int b = 0; b < 2; ++b)
#pragma unroll
            for (int m = 0; m < 4; ++m)
#pragma unroll
                for (int n = 0; n < 2; ++n) acc[a][b][m][n] = (f32x4){0.f, 0.f, 0.f, 0.f};
    bf16x8 At[4][2], B0[2][2], B1[2][2]; i32x8 At8[4], B08[2], B18[2];
    const char* cA = (const char*)g.A + (GATHER ? (size_t)0 : (size_t)cur.pm * tstep); const char* cB = (const char*)g.Bt + (size_t)cur.pn * tstep;
    PG8_STAGE(PG8_SB(0, 0), cB, voffB); PG8_STAGE_A(PG8_SA(0, 0), cA, 0); PG8_STAGE(PG8_SB(0, 1), cB + hstep, voffB); PG8_STAGE_A(PG8_SA(0, 1), cA, 1);
    if (wr == 1) PG8_BAR;
    PG8_WAIT_V(4); PG8_BAR;
    PG8_STAGE(PG8_SB(1, 0), cB + kstep, voffB); PG8_STAGE_A(PG8_SA(1, 0), cA + kstep, 0); PG8_STAGE(PG8_SB(1, 1), cB + hstep + kstep, voffB);
    PG8_WAIT_V(6); PG8_BAR;
    for (;;) {
        const bool has_next = S.next(ui + 1, nxt);
        const char* nA = has_next ? (const char*)g.A + (GATHER ? (size_t)0 : (size_t)nxt.pm * tstep) : cA; const char* nB = has_next ? (const char*)g.Bt + (size_t)nxt.pn * tstep : cB;
        for (int t = 0; t < nt; t += 2) {
            const bool last = (t == nt - 2);
            const char* a1 = cA + (size_t)(t + 1) * kstep;
            const char* a2 = last ? nA : cA + (size_t)(t + 2) * kstep; const char* b2 = last ? nB : cB + (size_t)(t + 2) * kstep;
            const char* a3 = a2 + kstep; const char* b3 = b2 + kstep;
            if constexpr (FP8) {
            PG8_SWAPH(0);
            PG8_LDB8(B08, 0, 0); PG8_SCHED; PG8_LDA8(At8, 0, 0); PG8_STAGE_A(PG8_SA(1, 1), a1, 1); PG8_SWAPN;
            PG8_WAIT_L(8); PG8_BAR; PG8_WAIT_L(0); PG8_MMA8(0, 0, At8, B08); PG8_BAR; PG8_SCHED;
            PG8_LDB8(B18, 0, 1); PG8_STAGE(PG8_SB(0, 0), b2, voffB);
            PG8_BAR; PG8_WAIT_L(0); PG8_MMA8(0, 1, At8, B18); PG8_BAR;
            PG8_LDA8(At8, 0, 1); PG8_STAGE_AN(PG8_SA(0, 0), a2, 0);
            PG8_BAR; PG8_WAIT_L(0); PG8_MMA8(1, 0, At8, B08); PG8_BAR; PG8_SCHED;
            PG8_STAGE(PG8_SB(0, 1), b2 + hstep, voffB);
            PG8_WAIT_V(6); PG8_BAR; PG8_MMA8(1, 1, At8, B18); PG8_BAR;
            PG8_LDB8(B08, 1, 0); PG8_SCHED; PG8_LDA8(At8, 1, 0); PG8_STAGE_AN(PG8_SA(0, 1), a2, 1);
            PG8_WAIT_L(8); PG8_BAR; PG8_WAIT_L(0); PG8_MMA8(0, 0, At8, B08); PG8_BAR; PG8_SCHED;
            PG8_LDB8(B18, 1, 1); PG8_STAGE(PG8_SB(1, 0), b3, voffB);
            PG8_BAR; PG8_WAIT_L(0); PG8_MMA8(0, 1, At8, B18); PG8_BAR;
            PG8_LDA8(At8, 1, 1); PG8_STAGE_AN(PG8_SA(1, 0), a3, 0);
            PG8_BAR; PG8_WAIT_L(0); PG8_MMA8(1, 0, At8, B08); PG8_BAR; PG8_SCHED;
            PG8_STAGE(PG8_SB(1, 1), b3 + hstep, voffB);
            PG8_WAIT_V(6); PG8_BAR; PG8_MMA8(1, 1, At8, B18); PG8_BAR;
            } else {
            PG8_SWAPH(0);
            PG8_LDB(B0, 0, 0); PG8_SCHED; PG8_LDA(At, 0, 0); PG8_STAGE_A(PG8_SA(1, 1), a1, 1); PG8_SWAPN;
            PG8_WAIT_L(8); PG8_BAR; PG8_WAIT_L(0); PG8_MMA(0, 0, At, B0); PG8_BAR; PG8_SCHED;
            PG8_LDB(B1, 0, 1); PG8_STAGE(PG8_SB(0, 0), b2, voffB);
            PG8_BAR; PG8_WAIT_L(0); PG8_MMA(0, 1, At, B1); PG8_BAR;
            PG8_LDA(At, 0, 1); PG8_STAGE_AN(PG8_SA(0, 0), a2, 0);
            PG8_BAR; PG8_WAIT_L(0); PG8_MMA(1, 0, At, B0); PG8_BAR; PG8_SCHED;
            PG8_STAGE(PG8_SB(0, 1), b2 + hstep, voffB);
            PG8_WAIT_V(6); PG8_BAR; PG8_MMA(1, 1, At, B1); PG8_BAR;
            PG8_LDB(B0, 1, 0); PG8_SCHED; PG8_LDA(At, 1, 0); PG8_STAGE_AN(PG8_SA(0, 1), a2, 1);
            PG8_WAIT_L(8); PG8_BAR; PG8_WAIT_L(0); PG8_MMA(0, 0, At, B0); PG8_BAR; PG8_SCHED;
            PG8_LDB(B1, 1, 1); PG8_STAGE(PG8_SB(1, 0), b3, voffB);
            PG8_BAR; PG8_WAIT_L(0); PG8_MMA(0, 1, At, B1); PG8_BAR;
            PG8_LDA(At, 1, 1); PG8_STAGE_AN(PG8_SA(1, 0), a3, 0);
            PG8_BAR; PG8_WAIT_L(0); PG8_MMA(1, 0, At, B0); PG8_BAR; PG8_SCHED;
            PG8_STAGE(PG8_SB(1, 1), b3 + hstep, voffB);
            PG8_WAIT_V(6); PG8_BAR; PG8_MMA(1, 1, At, B1); PG8_BAR;
            }
        }
        if constexpr (FP8) asm volatile("s_nop 15\n\ts_nop 15\n\ts_nop 15\n\ts_nop 15" ::: "memory");
        E(acc, cur, wr, wc, fr, fq);
        if (!has_next) break;
#pragma unroll
        for (int a = 0; a < 2; ++a)
#pragma unroll
            for (int b = 0; b < 2; ++b)
#pragma unroll
                for (int m = 0; m < 4; ++m)
#pragma unroll
                    for (int n = 0; n < 2; ++n) acc[a][b][m][n] = (f32x4){0.f, 0.f, 0.f, 0.f};
        cur = nxt; cA = nA; cB = nB; ++ui;
    }
    PG8_WAIT_V(0);
    if (wr == 0) PG8_BAR;
    PG8_BAR;
#undef PG8_SA
#undef PG8_SB
#undef PG8_STAGE
#undef PG8_STAGE_A
#undef PG8_STAGE_AN
#undef PG8_SWAPN
#undef PG8_SWAPH
#undef PG8_LDA
#undef PG8_LDB
#undef PG8_MMA
#undef PG8_MMA8
#undef PG8_LDA8
#undef PG8_LDB8
#undef PG8_WAIT_V
#undef PG8_WAIT_L
#undef PG8_BAR
#undef PG8_SCHED
}
}
using pg8::Unit;
typedef f32x4 AccT[2][2][4][2];

typedef float f32x16 __attribute__((ext_vector_type(16)));
#ifndef K256_DIST
#define K256_DIST 2
#endif
constexpr int K256_BUF = 32768, K256_NB = 3, K256_SCR_OFF = K256_NB * K256_BUF, K256_SCR_WAVE = 4608;
struct K256Store {
    bf16_t* O; int ld; const float* rs; float rs_mul; bf16_t* O2; int split; int fp8;
};
constexpr float F8_SCALE = 16.0f;
__device__ __forceinline__ void gemm_k256(LAS unsigned char* lds, const bf16_t* A, const bf16_t* Bt, int nchunks, int row0, const K256Store& E) {
    int tid_ = threadIdx.x; asm volatile("; k256 ids" : "+v"(tid_));
    const int tid = tid_, lane = tid & 63, wave = __builtin_amdgcn_readfirstlane(tid >> 6), r = lane & 31, h = lane >> 5;
    bf16x8 af[16];
    { const bf16_t* arow = A + (size_t)(32 * wave + r) * 256 + 8 * h;
#pragma unroll
      for (int s = 0; s < 16; ++s) af[s] = *(const bf16x8*)(arow + 16 * s); }
    float rscale = 1.0f;
    if (E.rs) rscale = rsqrtf(E.rs[row0 + 32 * wave + r] * E.rs_mul + RMS_EPS);
    unsigned foff[4];
#pragma unroll
    for (int q = 0; q < 4; ++q) { const int n = 2 * (4 * wave + q) + (lane >> 5); foff[q] = (unsigned)(n * 256 + (((lane & 31) ^ (n & 15)) << 3)) * 2u; }
#define K256_FILL(chunk, buf) do { const char* _src = (const char*)Bt + (size_t)(chunk) * (64 * 256 * 2); _Pragma("unroll") for (int q = 0; q < 4; ++q) \
        __builtin_amdgcn_global_load_lds((const unsigned*)(_src + foff[q]), (LAS unsigned*)(lds + (buf) * K256_BUF + (4 * wave + q) * 1024), 16, 0, 0); } while (0)
    K256_FILL(0, 0);
    if (K256_DIST == 2 && nchunks > 1) K256_FILL(1, 1);
    const int boff = (r * 32) * 16;
    LAS unsigned char* scr = lds + K256_SCR_OFF + wave * K256_SCR_WAVE;
    for (int i = 0; i < nchunks; ++i) {
        {
            const int ns = E.fp8 ? 2 : 4;
            const int yo = K256_DIST == 2 ? ns * ((i >= 2 ? 1 : 0) + (i >= 1 ? 1 : 0)) + (i + 1 < nchunks ? 4 : 0) : ns * (i >= 1 ? 1 : 0);
            if (yo >= 12) asm volatile("s_waitcnt vmcnt(12)" ::: "memory"); else if (yo >= 8) asm volatile("s_waitcnt vmcnt(8)" ::: "memory");
            else if (yo >= 6) asm volatile("s_waitcnt vmcnt(6)" ::: "memory"); else if (yo >= 4) asm volatile("s_waitcnt vmcnt(4)" ::: "memory");
            else if (yo >= 2) asm volatile("s_waitcnt vmcnt(2)" ::: "memory"); else asm volatile("s_waitcnt vmcnt(0)" ::: "memory");
        }
        __builtin_amdgcn_s_barrier(); asm volatile("" ::: "memory");
        if (i + K256_DIST < nchunks) K256_FILL(i + K256_DIST, (i + K256_DIST) % K256_NB);
        const LAS unsigned char* bb = lds + (i % K256_NB) * K256_BUF + boff;
        f32x16 acc0, acc1;
#pragma unroll
        for (int j = 0; j < 16; ++j) { acc0[j] = 0.f; acc1[j] = 0.f; }
        {
            bf16x8 bq[3][2];
#define K256_LDB(s_) do { const int co_ = (((2 * (s_) + h) ^ (r & 15)) << 4); bq[(s_) % 3][0] = *(const LAS bf16x8*)(bb + co_); bq[(s_) % 3][1] = *(const LAS bf16x8*)(bb + 32 * 512 + co_); } while (0)
            K256_LDB(0); K256_LDB(1);
#pragma unroll
            for (int s = 0; s < 16; ++s) {
                if (s + 2 < 16) K256_LDB(s + 2);
                acc0 = __builtin_amdgcn_mfma_f32_32x32x16_bf16(bq[s % 3][0], af[s], acc0, 0, 0, 0);
                acc1 = __builtin_amdgcn_mfma_f32_32x32x16_bf16(bq[s % 3][1], af[s], acc1, 0, 0, 0);
            }
            __builtin_amdgcn_sched_group_barrier(0x100, 4, 0);
#pragma unroll
            for (int s = 0; s < 16; ++s) { if (s + 2 < 16) __builtin_amdgcn_sched_group_barrier(0x100, 2, 0); __builtin_amdgcn_sched_group_barrier(0x008, 2, 0); }
#undef K256_LDB
        }
        if (E.fp8) {
#pragma unroll
            for (int g = 0; g < 4; ++g) {
                unsigned d0 = 0u, d1 = 0u;
                d0 = __builtin_amdgcn_cvt_pk_fp8_f32(acc0[4 * g] * F8_SCALE, acc0[4 * g + 1] * F8_SCALE, d0, false); d0 = __builtin_amdgcn_cvt_pk_fp8_f32(acc0[4 * g + 2] * F8_SCALE, acc0[4 * g + 3] * F8_SCALE, d0, true);
                d1 = __builtin_amdgcn_cvt_pk_fp8_f32(acc1[4 * g] * F8_SCALE, acc1[4 * g + 1] * F8_SCALE, d1, false); d1 = __builtin_amdgcn_cvt_pk_fp8_f32(acc1[4 * g + 2] * F8_SCALE, acc1[4 * g + 3] * F8_SCALE, d1, true);
                *(LAS unsigned*)(scr + r * 80 + 8 * g + 4 * h) = d0; *(LAS unsigned*)(scr + r * 80 + 32 + 8 * g + 4 * h) = d1;
            }
            asm volatile("s_waitcnt lgkmcnt(0)" ::: "memory");
            unsigned char* ob8 = (unsigned char*)E.O;
#pragma unroll
            for (int pq = 0; pq < 2; ++pq) { const int rr = (lane >> 2) + 16 * pq;
                const u32x4 v = *(const LAS u32x4*)(scr + rr * 80 + (lane & 3) * 16);
                __builtin_nontemporal_store(v, (u32x4*)(ob8 + (size_t)(row0 + 32 * wave + rr) * E.ld + i * 64 + (lane & 3) * 16)); }
        } else {
#pragma unroll
        for (int g = 0; g < 4; ++g) {
            u32x2 w0, w1;
            w0.x = pk2(acc0[4 * g] * rscale, acc0[4 * g + 1] * rscale); w0.y = pk2(acc0[4 * g + 2] * rscale, acc0[4 * g + 3] * rscale);
            w1.x = pk2(acc1[4 * g] * rscale, acc1[4 * g + 1] * rscale); w1.y = pk2(acc1[4 * g + 2] * rscale, acc1[4 * g + 3] * rscale);
            *(LAS u32x2*)(scr + r * 144 + (8 * g + 4 * h) * 2) = w0; *(LAS u32x2*)(scr + r * 144 + 64 + (8 * g + 4 * h) * 2) = w1;
        }
        asm volatile("s_waitcnt lgkmcnt(0)" ::: "memory");
        int col = i * 64 + (lane & 7) * 8; bf16_t* ob = E.O;
        if (E.O2 && col >= E.split) { col -= E.split; ob = E.O2; }
#pragma unroll
        for (int pq = 0; pq < 4; ++pq) { const int rr = (lane >> 3) + 8 * pq;
            const u32x4 v = *(const LAS u32x4*)(scr + rr * 144 + (lane & 7) * 16);
            *(u32x4*)(ob + (size_t)(row0 + 32 * wave + rr) * E.ld + col) = v; }
        }
    }
#undef K256_FILL
    asm volatile("s_waitcnt vmcnt(0) lgkmcnt(0)" ::: "memory");
    __builtin_amdgcn_s_barrier(); asm volatile("" ::: "memory");
}


typedef int i32x8k __attribute__((ext_vector_type(8)));
constexpr int K8_BUF = 16384, K8_SCR_OFF = 3 * K8_BUF;
__device__ __forceinline__ void gemm_k256_f8(LAS unsigned char* lds, const unsigned char* A8, const unsigned char* Bt8, int nchunks, int row0, unsigned char* O8, int ld, float oscale) {
    int tid_ = threadIdx.x; asm volatile("; k256f8 ids" : "+v"(tid_));
    const int tid = tid_, lane = tid & 63, wave = __builtin_amdgcn_readfirstlane(tid >> 6), r = lane & 31, h = lane >> 5;
    i32x8k af[4];
    { const unsigned char* arow = A8 + (size_t)(32 * wave + r) * 256 + 32 * h;
#pragma unroll
      for (int s = 0; s < 4; ++s) { const u32x4 x0 = *(const u32x4*)(arow + 64 * s), x1 = *(const u32x4*)(arow + 64 * s + 16); af[s] = __builtin_bit_cast(i32x8k, __builtin_shufflevector(x0, x1, 0, 1, 2, 3, 4, 5, 6, 7)); } }
    unsigned foff[2];
#pragma unroll
    for (int q = 0; q < 2; ++q) { const int n = 4 * (2 * wave + q) + (lane >> 4); foff[q] = (unsigned)(n * 256 + (((lane & 15) ^ (n & 15)) << 4)); }
#define K8_FILL(chunk, buf) do { const unsigned char* _src = Bt8 + (size_t)(chunk) * (64 * 256); _Pragma("unroll") for (int q = 0; q < 2; ++q) \
        __builtin_amdgcn_global_load_lds((const unsigned*)(_src + foff[q]), (LAS unsigned*)(lds + (buf) * K8_BUF + (2 * wave + q) * 1024), 16, 0, 0); } while (0)
    K8_FILL(0, 0);
    if (nchunks > 1) K8_FILL(1, 1);
    LAS unsigned char* scr = lds + K8_SCR_OFF + wave * 2560;
    const float osc = F8_SCALE * oscale;
    for (int i = 0; i < nchunks; ++i) {
        {
            const int yo = 2 * ((i >= 2 ? 1 : 0) + (i >= 1 ? 1 : 0) + (i + 1 < nchunks ? 1 : 0));
            if (yo >= 6) asm volatile("s_waitcnt vmcnt(6)" ::: "memory"); else if (yo >= 4) asm volatile("s_waitcnt vmcnt(4)" ::: "memory");
            else if (yo >= 2) asm volatile("s_waitcnt vmcnt(2)" ::: "memory"); else asm volatile("s_waitcnt vmcnt(0)" ::: "memory");
        }
        __builtin_amdgcn_s_barrier(); asm volatile("" ::: "memory");
        if (i + 2 < nchunks) K8_FILL(i + 2, (i + 2) % 3);
        const LAS unsigned char* bb = lds + (i % 3) * K8_BUF + r * 256;
        f32x16 acc0, acc1;
#pragma unroll
        for (int j = 0; j < 16; ++j) { acc0[j] = 0.f; acc1[j] = 0.f; }
        i32x8k b0[4], b1[4];
#pragma unroll
        for (int s = 0; s < 4; ++s) {
            const int c0 = ((4 * s + 2 * h) ^ (r & 15)) << 4, c1 = ((4 * s + 2 * h + 1) ^ (r & 15)) << 4;
            const u32x4 p0 = *(const LAS u32x4*)(bb + c0), p1 = *(const LAS u32x4*)(bb + c1), q0 = *(const LAS u32x4*)(bb + 32 * 256 + c0), q1 = *(const LAS u32x4*)(bb + 32 * 256 + c1);
            b0[s] = __builtin_bit_cast(i32x8k, __builtin_shufflevector(p0, p1, 0, 1, 2, 3, 4, 5, 6, 7)); b1[s] = __builtin_bit_cast(i32x8k, __builtin_shufflevector(q0, q1, 0, 1, 2, 3, 4, 5, 6, 7));
        }
#pragma unroll
        for (int s = 0; s < 4; ++s) {
            acc0 = __builtin_amdgcn_mfma_scale_f32_32x32x64_f8f6f4(b0[s], af[s], acc0, 0, 0, 0, 0, 0, 0);
            acc1 = __builtin_amdgcn_mfma_scale_f32_32x32x64_f8f6f4(b1[s], af[s], acc1, 0, 0, 0, 0, 0, 0);
        }
#pragma unroll
        for (int g = 0; g < 4; ++g) {
            unsigned d0 = 0u, d1 = 0u;
            d0 = __builtin_amdgcn_cvt_pk_fp8_f32(acc0[4 * g] * osc, acc0[4 * g + 1] * osc, d0, false); d0 = __builtin_amdgcn_cvt_pk_fp8_f32(acc0[4 * g + 2] * osc, acc0[4 * g + 3] * osc, d0, true);
            d1 = __builtin_amdgcn_cvt_pk_fp8_f32(acc1[4 * g] * osc, acc1[4 * g + 1] * osc, d1, false); d1 = __builtin_amdgcn_cvt_pk_fp8_f32(acc1[4 * g + 2] * osc, acc1[4 * g + 3] * osc, d1, true);
            *(LAS unsigned*)(scr + r * 80 + 8 * g + 4 * h) = d0; *(LAS unsigned*)(scr + r * 80 + 32 + 8 * g + 4 * h) = d1;
        }
        asm volatile("s_waitcnt lgkmcnt(0)" ::: "memory");
#pragma unroll
        for (int pq = 0; pq < 2; ++pq) { const int rr = (lane >> 2) + 16 * pq;
            const u32x4 v = *(const LAS u32x4*)(scr + rr * 80 + (lane & 3) * 16);
            __builtin_nontemporal_store(v, (u32x4*)(O8 + (size_t)(row0 + 32 * wave + rr) * ld + i * 64 + (lane & 3) * 16)); }
    }
#undef K8_FILL
    asm volatile("s_waitcnt vmcnt(0) lgkmcnt(0)" ::: "memory");
    __builtin_amdgcn_s_barrier(); asm volatile("" ::: "memory");
}

__device__ __forceinline__ u32x4 pack8(const f32x4 a, const f32x4 b) { u32x4 w; w.x = pk2(a[0], a[1]); w.y = pk2(a[2], a[3]); w.z = pk2(b[0], b[1]); w.w = pk2(b[2], b[3]); return w; }
__device__ __forceinline__ void unpack8(const u32x4 w, f32x4& a, f32x4& b) { a = (f32x4){bflo(w.x), bfhi(w.x), bflo(w.y), bfhi(w.y)}; b = (f32x4){bflo(w.z), bfhi(w.z), bflo(w.w), bfhi(w.w)}; }

struct EpiWin {
    static constexpr bool PERM = true;
    bf16_t *q, *k, *v, *gr, *cq, *ckv, *sa, *sb, *kr; float* ga; const float* rope; int f8; float ascale;
    __device__ __forceinline__ void operator()(const AccT& acc, const Unit& u, int wr, int wc, int fr, int fq) const {
        const int pn = f8 ? (u.pn < 4 ? 8 + u.pn : 12 + u.pn) : u.pn, row0 = u.pm * 256 + wr * 64 + fr, lc0 = wc * 32 + 8 * fq;
        if (pn < 24) {
            bf16_t* dst; int ld, cb, mode = 0;
            if (pn < 2) { dst = q; ld = 512; cb = pn * 256; mode = 1; }
            else if (pn < 4) { dst = k; ld = 512; cb = (pn - 2) * 256; }
            else if (pn < 8) { dst = v; ld = 1024; cb = (pn - 4) * 256; }
            else if (pn < 12) { dst = gr; ld = 1024; cb = (pn - 8) * 256; mode = 2; }
            else if (pn < 15) { dst = cq; ld = 768; cb = (pn - 12) * 256; }
            else if (pn < 16) { dst = ckv; ld = 256; cb = 0; }
            else if (pn < 20) { dst = sa; ld = 512; cb = (pn - 16) * 128; mode = 3; }
            else { dst = sb; ld = 512; cb = (pn - 20) * 128; mode = 3; }
#pragma unroll
            for (int ai = 0; ai < 2; ++ai)
#pragma unroll
                for (int m = 0; m < 4; ++m) {
                    const int row = row0 + ai * 128 + m * 16;
#pragma unroll
                    for (int bj = 0; bj < 2; ++bj) {
                        f32x4 v0 = acc[ai][bj][m][0] * ascale, v1 = acc[ai][bj][m][1] * ascale;
                        if (mode == 1) { v0 *= 0.08838834764831845f; v1 *= 0.08838834764831845f; }
                        else if (mode == 2) {
#pragma unroll
                            for (int j = 0; j < 4; ++j) { v0[j] = silu(v0[j]); v1[j] = silu(v1[j]); } }
                        else if (mode == 3) {
#pragma unroll
                            for (int j = 0; j < 4; ++j) { v0[j] = sigm(v0[j]); v1[j] = sigm(v1[j]); } }
                        if (mode == 3) {
                            unsigned d0 = 0u, d1 = 0u;
#pragma unroll
                            for (int j = 0; j < 4; ++j) { d0 = __builtin_amdgcn_cvt_pk_u8_f32(v0[j] * 255.0f, j, d0); d1 = __builtin_amdgcn_cvt_pk_u8_f32(v1[j] * 255.0f, j, d1); }
                            *(u32x2*)((unsigned char*)dst + (size_t)row * 1024 + (size_t)cb * 2 + bj * 128 + lc0) = (u32x2){d0, d1};
                        } else
                        *(u32x4*)(dst + (size_t)row * ld + cb + bj * 128 + lc0) = pack8(v0, v1);
                    }
                }
        } else {
#pragma unroll
            for (int ai = 0; ai < 2; ++ai)
#pragma unroll
                for (int m = 0; m < 4; ++m) {
                    const int row = row0 + ai * 128 + m * 16;
#pragma unroll
                    for (int bj = 0; bj < 2; ++bj) {
                        const int col = bj * 128 + lc0; const f32x4 v0 = acc[ai][bj][m][0], v1 = acc[ai][bj][m][1];
                        if (col < 64) {
                            const int j = col >> 3;
                            const f32x4 cs = *(const f32x4*)(rope + (size_t)row * 64 + 4 * j), sn = *(const f32x4*)(rope + (size_t)row * 64 + 32 + 4 * j);
                            const f32x4 o1 = v0 * cs - v1 * sn, o2 = v1 * cs + v0 * sn;
                            u32x2 w1, w2; w1.x = pk2(o1[0], o1[1]); w1.y = pk2(o1[2], o1[3]); w2.x = pk2(o2[0], o2[1]); w2.y = pk2(o2[2], o2[3]);
                            *(u32x2*)(kr + (size_t)row * 64 + 4 * j) = w1; *(u32x2*)(kr + (size_t)row * 64 + 32 + 4 * j) = w2;
                        } else if (col < 80) {
                            *(f32x4*)(ga + (size_t)row * 16 + (col - 64)) = v0; *(f32x4*)(ga + (size_t)row * 16 + (col - 64) + 4) = v1;
                        }
                    }
                }
        }
    }
};
struct EpiQF {
    static constexpr bool PERM = true;
    bf16_t* qm; const float* cq_ss; const float* rope;
    __device__ __forceinline__ void operator()(const AccT& acc, const Unit& u, int wr, int wc, int fr, int fq) const {
        const int row0 = u.pm * 256 + wr * 64 + fr, lc0 = wc * 32 + 8 * fq;
        int colb[2], headb[2], jb[2]; bool ropeb[2];
#pragma unroll
        for (int bj = 0; bj < 2; ++bj) { colb[bj] = u.pn * 256 + bj * 128 + lc0; headb[bj] = colb[bj] / 192; const int within = colb[bj] - headb[bj] * 192; ropeb[bj] = within >= 128; jb[bj] = ropeb[bj] ? (within - 128) >> 3 : 0; }
#pragma unroll
        for (int ai = 0; ai < 2; ++ai) {
            float rsv[4]; f32x4 cs[4][2], sn[4][2];
#pragma unroll
            for (int m = 0; m < 4; ++m) { const int row = row0 + ai * 128 + m * 16; rsv[m] = cq_ss[row];
#pragma unroll
                for (int bj = 0; bj < 2; ++bj) if (ropeb[bj]) { cs[m][bj] = *(const f32x4*)(rope + (size_t)row * 64 + 4 * jb[bj]); sn[m][bj] = *(const f32x4*)(rope + (size_t)row * 64 + 32 + 4 * jb[bj]); } }
#pragma unroll
            for (int m = 0; m < 4; ++m) {
                const int row = row0 + ai * 128 + m * 16;
                const float rs = rsqrtf(rsv[m] * (1.0f / 768.0f) + RMS_EPS) * QSCALE;
#pragma unroll
                for (int bj = 0; bj < 2; ++bj) {
                    const f32x4 v0 = acc[ai][bj][m][0] * rs, v1 = acc[ai][bj][m][1] * rs;
                    if (!ropeb[bj]) *(u32x4*)(qm + (size_t)row * 1536 + colb[bj]) = pack8(v0, v1);
                    else {
                        const f32x4 o1 = v0 * cs[m][bj] - v1 * sn[m][bj], o2 = v1 * cs[m][bj] + v0 * sn[m][bj];
                        u32x2 w1, w2; w1.x = pk2(o1[0], o1[1]); w1.y = pk2(o1[2], o1[3]); w2.x = pk2(o2[0], o2[1]); w2.y = pk2(o2[2], o2[3]);
                        bf16_t* p = qm + (size_t)row * 1536 + headb[bj] * 192 + 128 + 4 * jb[bj];
                        *(u32x2*)p = w1; *(u32x2*)(p + 32) = w2;
                    }
                }
            }
        }
    }
};
struct EpiKV {
    static constexpr bool PERM = true;
    bf16_t *kn, *vm; const float* ckv_ss;
    __device__ __forceinline__ void operator()(const AccT& acc, const Unit& u, int wr, int wc, int fr, int fq) const {
        const int row0 = u.pm * 256 + wr * 64 + fr, lc0 = wc * 32 + 8 * fq;
        bf16_t* dst = u.pn < 4 ? kn : vm; const int cb = (u.pn & 3) * 256;
#pragma unroll
        for (int ai = 0; ai < 2; ++ai)
#pragma unroll
            for (int m = 0; m < 4; ++m) {
                const int row = row0 + ai * 128 + m * 16;
                const float rs = rsqrtf(ckv_ss[row] * (1.0f / 256.0f) + RMS_EPS);
#pragma unroll
                for (int bj = 0; bj < 2; ++bj)
                    *(u32x4*)(dst + (size_t)row * 1024 + cb + bj * 128 + lc0) = pack8(acc[ai][bj][m][0] * rs, acc[ai][bj][m][1] * rs);
            }
    }
};
template <bool ADD> struct EpiGate {
    static constexpr bool PERM = true;
    bf16_t* Y; const unsigned char* gate;
    __device__ __forceinline__ void operator()(const AccT& acc, const Unit& u, int wr, int wc, int fr, int fq) const {
        const int row0 = u.pm * 256 + wr * 64 + fr, lc0 = u.pn * 256 + wc * 32 + 8 * fq;
#pragma unroll
        for (int ai = 0; ai < 2; ++ai) {
            u32x2 gq[4][2]; u32x4 yq[4][2];
#pragma unroll
            for (int m = 0; m < 4; ++m)
#pragma unroll
                for (int bj = 0; bj < 2; ++bj) { const size_t o = (size_t)(row0 + ai * 128 + m * 16) * 1024 + lc0 + bj * 128; gq[m][bj] = *(const u32x2*)(gate + o); if (ADD) yq[m][bj] = *(const u32x4*)(Y + o); }
#pragma unroll
            for (int m = 0; m < 4; ++m)
#pragma unroll
                for (int bj = 0; bj < 2; ++bj) {
                    const size_t o = (size_t)(row0 + ai * 128 + m * 16) * 1024 + lc0 + bj * 128;
                    const unsigned ga_ = gq[m][bj].x, gb_ = gq[m][bj].y; const float k255 = 1.0f / 255.0f;
                    const f32x4 g0 = (f32x4){(float)(ga_ & 255u), (float)((ga_ >> 8) & 255u), (float)((ga_ >> 16) & 255u), (float)(ga_ >> 24)} * k255;
                    const f32x4 g1 = (f32x4){(float)(gb_ & 255u), (float)((gb_ >> 8) & 255u), (float)((gb_ >> 16) & 255u), (float)(gb_ >> 24)} * k255;
                    f32x4 v0 = acc[ai][bj][m][0] * g0, v1 = acc[ai][bj][m][1] * g1;
                    if (ADD) { f32x4 y0, y1; unpack8(yq[m][bj], y0, y1); v0 += y0; v1 += y1; }
                    *(u32x4*)(Y + o) = pack8(v0, v1);
                }
        }
    }
};
struct EpiZ {
    static constexpr bool PERM = false;
    float* z; const float* x; const float* mod;
    __device__ __forceinline__ void operator()(const AccT& acc, const Unit& u, int wr, int wc, int fr, int fq) const {
        const int row0 = u.pm * 256 + wr * 64 + fr, col0 = u.pn * 256 + wc * 32 + 4 * fq;
        const float* g = mod + (size_t)(u.pm >> 3) * 6144 + 2048;
        f32x4 gv[2][2];
#pragma unroll
        for (int bj = 0; bj < 2; ++bj)
#pragma unroll
            for (int n = 0; n < 2; ++n) gv[bj][n] = *(const f32x4*)(g + col0 + bj * 128 + n * 16) + 1.0f;
#pragma unroll
        for (int ai = 0; ai < 2; ++ai)
#pragma unroll
            for (int m = 0; m < 4; ++m) {
                const size_t ro = (size_t)(row0 + ai * 128 + m * 16) * 1024 + col0;
#pragma unroll
                for (int bj = 0; bj < 2; ++bj)
#pragma unroll
                    for (int n = 0; n < 2; ++n) { const size_t o = ro + bj * 128 + n * 16; *(f32x4*)(z + o) = *(const f32x4*)(x + o) * ALPHA + gv[bj][n] * acc[ai][bj][m][n]; }
            }
    }
};
struct EpiF32 {
    static constexpr bool PERM = false;
    float* C; int ldc;
    __device__ __forceinline__ void operator()(const AccT& acc, const Unit& u, int wr, int wc, int fr, int fq) const {
        const int row0 = u.pm * 256 + wr * 64 + fr, col0 = u.pn * 256 + wc * 32 + 4 * fq;
#pragma unroll
        for (int ai = 0; ai < 2; ++ai)
#pragma unroll
            for (int m = 0; m < 4; ++m) { float* rowp = C + (size_t)(row0 + ai * 128 + m * 16) * ldc + col0;
#pragma unroll
                for (int bj = 0; bj < 2; ++bj)
#pragma unroll
                    for (int n = 0; n < 2; ++n) *(f32x4*)(rowp + bj * 128 + n * 16) = acc[ai][bj][m][n]; }
    }
};
struct EpiGLU {
    static constexpr bool PERM = true;
    bf16_t* hid; float scale; int f8;
    __device__ __forceinline__ void operator()(const AccT& acc, const Unit& u, int wr, int wc, int fr, int fq) const {
        const int row0 = u.pm * 256 + wr * 64 + fr, lc0 = u.pn * 256 + wc * 32 + 8 * fq;
#pragma unroll
        for (int ai = 0; ai < 2; ++ai)
#pragma unroll
            for (int m = 0; m < 4; ++m) {
                const int row = row0 + ai * 128 + m * 16;
#pragma unroll
                for (int bj = 0; bj < 2; ++bj) {
                    const f32x4 gg = acc[ai][bj][m][0] * scale, uu = acc[ai][bj][m][1] * scale;
                    const float h0 = silu(gg[0]) * uu[0], h1 = silu(gg[1]) * uu[1], h2_ = silu(gg[2]) * uu[2], h3 = silu(gg[3]) * uu[3];
                    if (f8) { unsigned d = 0u; d = __builtin_amdgcn_cvt_pk_fp8_f32(h0, h1, d, false); d = __builtin_amdgcn_cvt_pk_fp8_f32(h2_, h3, d, true);
                        *(unsigned*)((unsigned char*)hid + (size_t)row * 256 + ((lc0 + bj * 128) >> 1)) = d; }
                    else { u32x2 w; w.x = pk2(h0, h1); w.y = pk2(h2_, h3); *(u32x2*)(hid + (size_t)row * 256 + ((lc0 + bj * 128) >> 1)) = w; }
                }
            }
    }
};
struct EpiGluMoe {
    static constexpr bool PERM = true;
    unsigned char* hidA; unsigned char* hidB; int t0, tstep; float scale;
    static constexpr size_t SLOT = (size_t)NWG * 65536;
    __device__ __forceinline__ void operator()(const AccT& acc, const Unit& u, int wr, int wc, int fr, int fq) const {
        const int j = (u.pm - t0) >> tstep;
        unsigned char* hb = (j < 4 ? hidA + (size_t)j * SLOT : hidB + (size_t)(j - 4) * SLOT) + (u.pn & 1) * 128 + ((wc * 32 + 8 * fq) >> 1);
        const int rl0 = wr * 64 + fr;
#pragma unroll
        for (int ai = 0; ai < 2; ++ai)
#pragma unroll
            for (int m = 0; m < 4; ++m) {
                const int rl = rl0 + ai * 128 + m * 16;
#pragma unroll
                for (int bj = 0; bj < 2; ++bj) {
                    const f32x4 gg = acc[ai][bj][m][0] * scale, uu = acc[ai][bj][m][1] * scale;
                    unsigned d = 0u; d = __builtin_amdgcn_cvt_pk_fp8_f32(silu(gg[0]) * uu[0], silu(gg[1]) * uu[1], d, false); d = __builtin_amdgcn_cvt_pk_fp8_f32(silu(gg[2]) * uu[2], silu(gg[3]) * uu[3], d, true);
                    *(unsigned*)(hb + (size_t)rl * 256 + bj * 64) = d;
                }
            }
    }
};
struct EpiBf16 {
    static constexpr bool PERM = true;
    bf16_t* O; int ld;
    __device__ __forceinline__ void operator()(const AccT& acc, const Unit& u, int wr, int wc, int fr, int fq) const {
        const int row0 = u.pm * 256 + wr * 64 + fr, lc0 = u.pn * 256 + wc * 32 + 8 * fq;
#pragma unroll
        for (int ai = 0; ai < 2; ++ai)
#pragma unroll
            for (int m = 0; m < 4; ++m) {
                const int row = row0 + ai * 128 + m * 16;
#pragma unroll
                for (int bj = 0; bj < 2; ++bj) *(u32x4*)(O + (size_t)row * ld + lc0 + bj * 128) = pack8(acc[ai][bj][m][0], acc[ai][bj][m][1]);
            }
    }
};
typedef __bf16 bf16v2 __attribute__((ext_vector_type(2)));
__device__ __forceinline__ void atom_pk_bf16(bf16_t* p, unsigned w) {
    asm volatile("global_atomic_pk_add_bf16 %0, %1, off" :: "v"(p), "v"(w) : "memory");
}
struct EpiAtom {
    static constexpr bool PERM = true;
    bf16_t* accb; const int* slot_tok; const float* slot_w;
    __device__ __forceinline__ void operator()(const AccT& acc, const Unit& u, int wr, int wc, int fr, int fq) const {
        const int row0 = u.pm * 256 + wr * 64 + fr, lc0 = u.pn * 256 + wc * 32 + 8 * fq;
#pragma unroll
        for (int ai = 0; ai < 2; ++ai)
#pragma unroll
            for (int m = 0; m < 4; ++m) {
                const int slot = row0 + ai * 128 + m * 16;
                const int tok = slot_tok[slot];
                if (tok >= 0) {
                    const float w = slot_w[slot];
#pragma unroll
                    for (int bj = 0; bj < 2; ++bj) {
                        const u32x4 pw = pack8(acc[ai][bj][m][0] * w, acc[ai][bj][m][1] * w);
                        bf16_t* p = accb + (size_t)tok * 1024 + lc0 + bj * 128;
                        atom_pk_bf16(p, pw.x); atom_pk_bf16(p + 2, pw.y); atom_pk_bf16(p + 4, pw.z); atom_pk_bf16(p + 6, pw.w);
                    }
                }
            }
    }
};

struct Params { const float* in[28]; float* out; unsigned char* ws; int ph_lo, ph_hi, flags, pad; };
enum { I_X = 0, I_C, I_POS, I_WADA, I_BADA, I_WIN, I_WGA2, I_BGA, I_GGN, I_WGLAO, I_GCQ, I_WUQ, I_GCKV, I_WUKV, I_WMLAO, I_WOUT, I_LN1G, I_LN1B, I_WRT, I_BRT, I_WE1, I_WE3, I_WE2, I_WS1, I_WS3, I_WS2, I_LN2G, I_LN2B };
constexpr int LDS_STAGE = 131072, LDS_BYTES = 147456, LDS_MISC = LDS_BYTES - 2048;

template <class Map>
__device__ __forceinline__ void tr_item(const float* W, int K, int Nsrc, bf16_t* WT, const Map& map, const float* kscale, LAS unsigned* scr, int kb, int nb, int lane) {
    const int k0 = 64 * kb, n0 = 64 * nb;
    const int sc = map(n0 + lane);
#pragma unroll 8
    for (int kp = 0; kp < 32; ++kp) {
        float a = 0.f, b = 0.f;
        if (sc >= 0) { a = W[(size_t)(k0 + 2 * kp) * Nsrc + sc]; b = W[(size_t)(k0 + 2 * kp + 1) * Nsrc + sc]; }
        if (kscale) { a *= kscale[k0 + 2 * kp]; b *= kscale[k0 + 2 * kp + 1]; }
        scr[kp * 65 + lane] = pk2(a, b);
    }
    LDS_WAIT(); asm volatile("" ::: "memory");
#pragma unroll
    for (int j = 0; j < 8; ++j) { const int id = lane + 64 * j, n = id >> 3, c = id & 7;
        u32x4 o; o.x = scr[(4 * c + 0) * 65 + n]; o.y = scr[(4 * c + 1) * 65 + n]; o.z = scr[(4 * c + 2) * 65 + n]; o.w = scr[(4 * c + 3) * 65 + n];
        *(u32x4*)(WT + (size_t)(n0 + n) * K + k0 + 8 * c) = o; }
    LDS_WAIT(); asm volatile("" ::: "memory");
}
struct MapId { int off; __device__ __forceinline__ int operator()(int n) const { return off + n; } };
struct MapWin {
    __device__ __forceinline__ int operator()(int n) const {
        if (n < 3072) return n;
        if (n < 3840) return 3088 + (n - 3072);
        if (n < 4096) return 3856 + (n - 3840);
        if (n < 6144) return 4176 + (n - 4096);
        const int t = n - 6144;
        if (t < 64) { const int j = t >> 3, i = t & 7; return 4112 + (i < 4 ? 4 * j + i : 32 + 4 * j + (i - 4)); }
        if (t < 80) return 3072 + (t - 64);
        return -1;
    }
};
struct MapUq { __device__ __forceinline__ int operator()(int n) const { const int h = n / 192, w = n - h * 192; if (w < 128) return n; const int t = w - 128, j = t >> 3, i = t & 7; return h * 192 + 128 + (i < 4 ? 4 * j + i : 32 + 4 * j + (i - 4)); } };
struct MapUkv { __device__ __forceinline__ int operator()(int n) const { const int part = n >> 10, r = n & 1023, h = r >> 7, d = r & 127; return h * 256 + part * 128 + d; } };
struct MapGlu { int coff; __device__ __forceinline__ int operator()(int n) const { return coff + ((n >> 3) << 2) + (n & 3); } };
__device__ __forceinline__ void tr_glu_item(const float* W1, const float* W3, int K, int Nsrc, bf16_t* WT, LAS unsigned* scr, int kb, int nb, int lane) {
    const int k0 = 64 * kb, n0 = 64 * nb, n = n0 + lane;
    const float* W = (n & 4) ? W3 : W1; const int sc = ((n >> 3) << 2) + (n & 3);
#pragma unroll 8
    for (int kp = 0; kp < 32; ++kp) scr[kp * 65 + lane] = pk2(W[(size_t)(k0 + 2 * kp) * Nsrc + sc], W[(size_t)(k0 + 2 * kp + 1) * Nsrc + sc]);
    LDS_WAIT(); asm volatile("" ::: "memory");
#pragma unroll
    for (int j = 0; j < 8; ++j) { const int id = lane + 64 * j, nn = id >> 3, c = id & 7;
        u32x4 o; o.x = scr[(4 * c + 0) * 65 + nn]; o.y = scr[(4 * c + 1) * 65 + nn]; o.z = scr[(4 * c + 2) * 65 + nn]; o.w = scr[(4 * c + 3) * 65 + nn];
        *(u32x4*)(WT + (size_t)(n0 + nn) * K + k0 + 8 * c) = o; }
    LDS_WAIT(); asm volatile("" ::: "memory");
}


__device__ __forceinline__ void tr_glu8_item(const float* W1, const float* W3, int K, int Nsrc, unsigned char* WT, LAS unsigned* scr, int kb, int nb, int lane) {
    const int k0 = 64 * kb, n0 = 64 * nb, n = n0 + lane;
    const float* W = (n & 4) ? W3 : W1; const int sc = ((n >> 3) << 2) + (n & 3);
#pragma unroll 4
    for (int kq = 0; kq < 16; ++kq) { const float* wp = W + (size_t)(k0 + 4 * kq) * Nsrc + sc;
        unsigned d = 0u; d = __builtin_amdgcn_cvt_pk_fp8_f32(wp[0] * 32.0f, wp[Nsrc] * 32.0f, d, false); d = __builtin_amdgcn_cvt_pk_fp8_f32(wp[2 * (size_t)Nsrc] * 32.0f, wp[3 * (size_t)Nsrc] * 32.0f, d, true);
        scr[kq * 65 + lane] = d; }
    LDS_WAIT(); asm volatile("" ::: "memory");
#pragma unroll
    for (int j = 0; j < 4; ++j) { const int id = lane + 64 * j, nn = id >> 2, c = id & 3;
        u32x4 o; o.x = scr[(4 * c + 0) * 65 + nn]; o.y = scr[(4 * c + 1) * 65 + nn]; o.z = scr[(4 * c + 2) * 65 + nn]; o.w = scr[(4 * c + 3) * 65 + nn];
        *(u32x4*)(WT + (size_t)(n0 + nn) * K + k0 + 16 * c) = o; }
    LDS_WAIT(); asm volatile("" ::: "memory");
}

template <class Map>
__device__ __forceinline__ void tr8_item(const float* W, int K, int Nsrc, unsigned char* WT, const Map& map, LAS unsigned* scr, int kb, int nb, int lane) {
    const int k0 = 64 * kb, n0 = 64 * nb; const int sc = map(n0 + lane);
#pragma unroll 4
    for (int kq = 0; kq < 16; ++kq) { const float* wp = W + (size_t)(k0 + 4 * kq) * Nsrc + sc;
        unsigned d = 0u; d = __builtin_amdgcn_cvt_pk_fp8_f32(wp[0] * 32.0f, wp[Nsrc] * 32.0f, d, false); d = __builtin_amdgcn_cvt_pk_fp8_f32(wp[2 * (size_t)Nsrc] * 32.0f, wp[3 * (size_t)Nsrc] * 32.0f, d, true);
        scr[kq * 65 + lane] = d; }
    LDS_WAIT(); asm volatile("" ::: "memory");
#pragma unroll
    for (int j = 0; j < 4; ++j) { const int id = lane + 64 * j, nn = id >> 2, c = id & 3;
        u32x4 o; o.x = scr[(4 * c + 0) * 65 + nn]; o.y = scr[(4 * c + 1) * 65 + nn]; o.z = scr[(4 * c + 2) * 65 + nn]; o.w = scr[(4 * c + 3) * 65 + nn];
        *(u32x4*)(WT + (size_t)(n0 + nn) * K + k0 + 16 * c) = o; }
    LDS_WAIT(); asm volatile("" ::: "memory");
}

struct MapWin8 { __device__ __forceinline__ int operator()(int n) const { return n < 1024 ? 2048 + n : 4176 + (n - 1024); } };
__device__ __forceinline__ void phase0(const Params& p, LAS unsigned char* lds, int gw, int ngw, int lane, int wave) {
    unsigned char* ws = p.ws;
    {
        const int cb = blockIdx.x, tid = threadIdx.x;
        if (cb < 96) {
            const float* c = p.in[I_C]; const float* wada = p.in[I_WADA]; const float* bada = p.in[I_BADA]; float* mod = (float*)(ws + WS_MOD);
            LAS float* tab = (LAS float*)lds;
            for (int i = tid; i < 32 * 1024 / 4; i += NTHR) { const f32x4 v = ((const f32x4*)c)[i]; f32x4 o; o[0] = silu(v[0]); o[1] = silu(v[1]); o[2] = silu(v[2]); o[3] = silu(v[3]); ((LAS f32x4*)tab)[i] = o; }
            __syncthreads();
            float acc[32];
#pragma unroll
            for (int b = 0; b < 32; ++b) acc[b] = 0.f;
            const int col = cb * 64 + lane;
            for (int k4 = 0; k4 < 32; ++k4) {
                const int k = wave * 128 + k4 * 4;
                float w[4];
#pragma unroll
                for (int q = 0; q < 4; ++q) w[q] = wada[(size_t)(k + q) * 6144 + col];
#pragma unroll
                for (int b = 0; b < 32; ++b) { const f32x4 t = *(const LAS f32x4*)(tab + b * 1024 + k); acc[b] += t[0] * w[0] + t[1] * w[1] + t[2] * w[2] + t[3] * w[3]; }
            }
            __syncthreads();
            LAS float* part = (LAS float*)lds;
#pragma unroll
            for (int b = 0; b < 32; ++b) part[(wave * 32 + b) * 64 + lane] = acc[b];
            __syncthreads();
#pragma unroll
            for (int i = 0; i < 4; ++i) { const int o = tid + 512 * i, b = o >> 6, l = o & 63; float sum = 0.f;
#pragma unroll
                for (int w8 = 0; w8 < 8; ++w8) sum += part[(w8 * 32 + b) * 64 + l];
                mod[b * 6144 + cb * 64 + l] = sum + bada[cb * 64 + l]; }
            __syncthreads();
        }
    }
    LAS unsigned* scr = (LAS unsigned*)(lds + wave * 8448);
    constexpr int T_WIN = 16 * 100, T_GLAO = 16 * 16, T_UQ = 12 * 24, T_UKV = 4 * 32, T_MLAO = 256, T_OUT = 256, T_RT = 16 * 4, T_S13 = 16 * 8, T_S2 = 4 * 16, T_WIN8 = 16 * 48;
    constexpr int T_ALL = T_WIN + T_GLAO + T_UQ + T_UKV + T_MLAO + T_OUT + T_RT + T_S13 + T_S2 + T_WIN8;
    for (int it = gw; it < T_ALL; it += ngw) {
        int r = it;
        if (r < T_WIN) { tr_item(p.in[I_WIN], 1024, 6224, (bf16_t*)(ws + WS_WIN), MapWin{}, nullptr, scr, r / 100, r % 100, lane); continue; } r -= T_WIN;
        if (r < T_GLAO) { tr_item(p.in[I_WGLAO], 1024, 1024, (bf16_t*)(ws + WS_WGLAO), MapId{0}, nullptr, scr, r / 16, r % 16, lane); continue; } r -= T_GLAO;
        if (r < T_UQ) { tr_item(p.in[I_WUQ], 768, 1536, (bf16_t*)(ws + WS_WUQ), MapUq{}, p.in[I_GCQ], scr, r / 24, r % 24, lane); continue; } r -= T_UQ;
        if (r < T_UKV) { tr_item(p.in[I_WUKV], 256, 2048, (bf16_t*)(ws + WS_WUKV), MapUkv{}, p.in[I_GCKV], scr, r / 32, r % 32, lane); continue; } r -= T_UKV;
        if (r < T_MLAO) { tr_item(p.in[I_WMLAO], 1024, 1024, (bf16_t*)(ws + WS_WMLAO), MapId{0}, nullptr, scr, r / 16, r % 16, lane); continue; } r -= T_MLAO;
        if (r < T_OUT) { tr_item(p.in[I_WOUT], 1024, 1024, (bf16_t*)(ws + WS_WOUT), MapId{0}, nullptr, scr, r / 16, r % 16, lane); continue; } r -= T_OUT;
        if (r < T_RT) { tr_item(p.in[I_WRT], 1024, 256, (bf16_t*)(ws + WS_WRT), MapId{0}, nullptr, scr, r / 4, r % 4, lane); continue; } r -= T_RT;
        if (r < T_S13) { tr_glu_item(p.in[I_WS1], p.in[I_WS3], 1024, 256, (bf16_t*)(ws + WS_WS13), scr, r / 8, r % 8, lane); continue; } r -= T_S13;
        if (r < T_S2) { tr_item(p.in[I_WS2], 256, 1024, (bf16_t*)(ws + WS_WS2), MapId{0}, nullptr, scr, r / 16, r % 16, lane); continue; } r -= T_S2;
        tr8_item(p.in[I_WIN], 1024, 6224, ws + WS_WIN8, MapWin8{}, scr, r / 48, r % 48, lane);
    }
    { int* st = (int*)(ws + WS_STOK); for (int i = gw * 64 + lane; i < NSLOT; i += ngw * 64) st[i] = -1; }
}

__device__ __forceinline__ void phase1(const Params& p, int gw, int ngw, int lane) {
    const float* x = p.in[I_X]; const float* mod = (const float*)(p.ws + WS_MOD); bf16_t* h = (bf16_t*)(p.ws + WS_BIG(0));
    const int* pos = (const int*)p.in[I_POS]; float* rope = (float*)((unsigned char*)p.out + 192 * MiB);
    const float invf = exp2f(-(float)(lane & 31) * (13.287712379549449f / 32.0f));
    for (int m = gw; m < NTOK; m += ngw) {
        const int b = m >> 11; const float* sh = mod + b * 6144; const float* sc = sh + 1024;
        const f32x4* xr = (const f32x4*)(x + (size_t)m * 1024) + lane;
        u32x2* o = (u32x2*)(h + (size_t)m * 1024) + lane;
#pragma unroll
        for (int j = 0; j < 4; ++j) { const f32x4 v = xr[64 * j], s = *((const f32x4*)sc + lane + 64 * j) + 1.0f, t = *((const f32x4*)sh + lane + 64 * j);
            const f32x4 r = v * s + t; u32x2 w; w.x = pk2(r[0], r[1]); w.y = pk2(r[2], r[3]); o[64 * j] = w;
            unsigned w8 = 0u; w8 = __builtin_amdgcn_cvt_pk_fp8_f32(r[0], r[1], w8, false); w8 = __builtin_amdgcn_cvt_pk_fp8_f32(r[2], r[3], w8, true);
            ((unsigned*)(p.ws + WS_BIG(7) + (size_t)m * 1024))[lane + 64 * j] = w8; }
        const float ang = (float)pos[m] * invf;
        rope[(size_t)m * 64 + lane] = lane < 32 ? cosf(ang) : sinf(ang);
    }
}

__device__ __forceinline__ void ln1_row(float* zrow, bf16_t* h2row, const float* g, const float* bta, const float* sh2, const float* sc2, int lane) {
    f32x4* zr = (f32x4*)zrow + lane; f32x4 v[4]; float s = 0.f;
#pragma unroll
    for (int j = 0; j < 4; ++j) { v[j] = zr[64 * j]; s += (v[j][0] + v[j][1]) + (v[j][2] + v[j][3]); }
    const float mean = wave_sum(s) * (1.f / 1024.f); float s2 = 0.f;
#pragma unroll
    for (int j = 0; j < 4; ++j) { v[j] = v[j] - mean; s2 += (v[j][0] * v[j][0] + v[j][1] * v[j][1]) + (v[j][2] * v[j][2] + v[j][3] * v[j][3]); }
    const float rstd = rsqrtf(wave_sum(s2) * (1.f / 1024.f) + LN_EPS);
    u32x2* o = (u32x2*)h2row + lane;
#pragma unroll
    for (int j = 0; j < 4; ++j) {
        const int ci = lane + 64 * j;
        const f32x4 x1 = v[j] * rstd * ((const f32x4*)g)[ci] + ((const f32x4*)bta)[ci];
        zr[64 * j] = x1;
        const f32x4 hh = x1 * (((const f32x4*)sc2)[ci] + 1.0f) + ((const f32x4*)sh2)[ci];
        u32x2 w; w.x = pk2(hh[0], hh[1]); w.y = pk2(hh[2], hh[3]); o[64 * j] = w;
    }
}
__device__ __forceinline__ void ln2_row(float* orow, const bf16_t* frow, const float* g, const float* bta, const float* gt2, int lane) {
    f32x4* zr = (f32x4*)orow + lane; const u32x2* fr = (const u32x2*)frow + lane; f32x4 v[4]; float s = 0.f;
#pragma unroll
    for (int j = 0; j < 4; ++j) { const u32x2 w = fr[64 * j]; const f32x4 f = (f32x4){bflo(w.x), bfhi(w.x), bflo(w.y), bfhi(w.y)};
        v[j] = zr[64 * j] * ALPHA + (((const f32x4*)gt2)[lane + 64 * j] + 1.0f) * f; s += (v[j][0] + v[j][1]) + (v[j][2] + v[j][3]); }
    const float mean = wave_sum(s) * (1.f / 1024.f); float s2 = 0.f;
#pragma unroll
    for (int j = 0; j < 4; ++j) { v[j] = v[j] - mean; s2 += (v[j][0] * v[j][0] + v[j][1] * v[j][1]) + (v[j][2] * v[j][2] + v[j][3] * v[j][3]); }
    const float rstd = rsqrtf(wave_sum(s2) * (1.f / 1024.f) + LN_EPS);
#pragma unroll
    for (int j = 0; j < 4; ++j) { const int ci = lane + 64 * j; zr[64 * j] = v[j] * rstd * ((const f32x4*)g)[ci] + ((const f32x4*)bta)[ci]; }
}

__device__ __forceinline__ void gla_phase(const Params& p, LAS unsigned char* lds, int bh, bool nostore) {
    const int tid = threadIdx.x, lane = tid & 63, wave = __builtin_amdgcn_readfirstlane(tid >> 6), fr = lane & 15, g = lane >> 4;
    const int b = bh >> 2, h = bh & 3;
    const bf16_t* qg = (const bf16_t*)(p.ws + WS_BIG(1)); const bf16_t* kg = qg + (size_t)NTOK * 512; const bf16_t* vg = (const bf16_t*)(p.ws + WS_BIG(2));
    bf16_t* gr = (bf16_t*)(p.ws + WS_BIG(3)); const float* gag = (const float*)(p.ws + WS_GA);
    LAS bf16_t* KdT = (LAS bf16_t*)lds;
    LAS bf16_t* VT = (LAS bf16_t*)(lds + 18432);
    LAS bf16_t* ST = (LAS bf16_t*)lds;
    LAS bf16_t* QS = (LAS bf16_t*)(lds + 69632);
    LAS float* DEC = (LAS float*)(lds + 87040);
    LAS float* PART = (LAS float*)(lds + 87552);
    LAS float* GAC = (LAS float*)(lds + 89600);
    LAS float* SS = (LAS float*)(lds + 93696);
    const int dk = tid & 127, tq = tid >> 7;
    float w2[16];
#pragma unroll
    for (int r = 0; r < 16; ++r) w2[r] = p.in[I_WGA2][r * 512 + h * 128 + dk];
    const float bias = p.in[I_BGA][h * 128 + dk];
    const int rg = wave & 3, ch = wave >> 2;
    float gnv[8];
#pragma unroll
    for (int nt = 0; nt < 8; ++nt) gnv[nt] = p.in[I_GGN][128 * ch + 16 * nt + fr];
    f32x4 st[8][2];
#pragma unroll
    for (int mt = 0; mt < 8; ++mt) { st[mt][0] = (f32x4){0.f, 0.f, 0.f, 0.f}; st[mt][1] = (f32x4){0.f, 0.f, 0.f, 0.f}; }
    const int dvp = tid & 127, tq4 = tid >> 7;
    bf16_t kraw[16]; unsigned vraw[16]; u32x4 qraw[2]; f32x4 garaw = (f32x4){0.f, 0.f, 0.f, 0.f};
#define GLA_LOAD(n_) do { const int tk_ = b * 2048 + (n_) * 64; \
        if (tid < 256) garaw = *(const f32x4*)(gag + (size_t)(tk_ + (tid >> 2)) * 16 + (tid & 3) * 4); \
        _Pragma("unroll") for (int j = 0; j < 16; ++j) kraw[j] = kg[(size_t)(tk_ + 16 * tq + j) * 512 + h * 128 + dk]; \
        _Pragma("unroll") for (int j = 0; j < 16; ++j) vraw[j] = *(const unsigned*)(vg + (size_t)(tk_ + 16 * tq4 + j) * 1024 + h * 256 + 2 * dvp); \
        _Pragma("unroll") for (int i = 0; i < 2; ++i) { const int id = tid + 512 * i; qraw[i] = *(const u32x4*)(qg + (size_t)(tk_ + (id >> 4)) * 512 + h * 128 + (id & 15) * 8); } } while (0)
    GLA_LOAD(0);
    for (int n = 0; n < 32; ++n) {
        const int tok0 = b * 2048 + n * 64;
        if (tid < 256) *(LAS f32x4*)(GAC + tid * 4) = garaw;
        __syncthreads();
        float cs[16]; float run = 0.f;
#pragma unroll
        for (int j = 0; j < 16; ++j) {
            const LAS f32x4* gp = (const LAS f32x4*)(GAC + (16 * tq + j) * 16);
            float d = bias;
#pragma unroll
            for (int r4 = 0; r4 < 4; ++r4) { const f32x4 gv = gp[r4]; d += gv[0] * w2[4 * r4] + gv[1] * w2[4 * r4 + 1] + gv[2] * w2[4 * r4 + 2] + gv[3] * w2[4 * r4 + 3]; }
            const float ls = fminf(d, 0.f) - __logf(1.0f + __expf(-fabsf(d)));
            run += ls * (1.0f / 16.0f); cs[j] = run;
        }
        PART[tq * 128 + dk] = run;
        __syncthreads();
        {
            const float p0 = PART[dk], p1 = PART[128 + dk], p2 = PART[256 + dk], p3 = PART[384 + dk];
            const float total = (p0 + p1) + (p2 + p3);
            const float off = tq == 0 ? 0.f : tq == 1 ? p0 : tq == 2 ? (p0 + p1) : (p0 + p1) + p2;
            if (tq == 0) DEC[dk] = __expf(total);
            unsigned kd[8];
#pragma unroll
            for (int j = 0; j < 8; ++j) kd[j] = pk2(bf2f(kraw[2 * j]) * __expf(total - (off + cs[2 * j])), bf2f(kraw[2 * j + 1]) * __expf(total - (off + cs[2 * j + 1])));
            LAS u32x4* kdst = (LAS u32x4*)(KdT + dk * 72 + 16 * tq);
            kdst[0] = (u32x4){kd[0], kd[1], kd[2], kd[3]}; kdst[1] = (u32x4){kd[4], kd[5], kd[6], kd[7]};
            unsigned v0[8], v1[8];
#pragma unroll
            for (int j = 0; j < 8; ++j) { v0[j] = (vraw[2 * j] & 0xffffu) | (vraw[2 * j + 1] << 16); v1[j] = (vraw[2 * j] >> 16) | (vraw[2 * j + 1] & 0xffff0000u); }
            LAS u32x4* vd0 = (LAS u32x4*)(VT + (2 * dvp) * 72 + 16 * tq4); LAS u32x4* vd1 = (LAS u32x4*)(VT + (2 * dvp + 1) * 72 + 16 * tq4);
            vd0[0] = (u32x4){v0[0], v0[1], v0[2], v0[3]}; vd0[1] = (u32x4){v0[4], v0[5], v0[6], v0[7]};
            vd1[0] = (u32x4){v1[0], v1[1], v1[2], v1[3]}; vd1[1] = (u32x4){v1[4], v1[5], v1[6], v1[7]};
#pragma unroll
            for (int i = 0; i < 2; ++i) { const int id = tid + 512 * i; *(LAS u32x4*)(QS + (id >> 4) * 136 + (id & 15) * 8) = qraw[i]; }
        }
        if (n + 1 < 32) GLA_LOAD(n + 1);
        __syncthreads();
#pragma unroll
        for (int mt = 0; mt < 8; ++mt) { const f32x4 d4 = *(const LAS f32x4*)(DEC + 16 * mt + 4 * g); st[mt][0] *= d4; st[mt][1] *= d4; }
#pragma unroll
        for (int ks = 0; ks < 2; ++ks) {
            bf16x8 bfr[2];
#pragma unroll
            for (int nt = 0; nt < 2; ++nt) bfr[nt] = *(const LAS bf16x8*)(VT + (32 * wave + 16 * nt + fr) * 72 + 32 * ks + 8 * g);
#pragma unroll
            for (int mt = 0; mt < 8; ++mt) {
                const bf16x8 a = *(const LAS bf16x8*)(KdT + (16 * mt + fr) * 72 + 32 * ks + 8 * g);
                st[mt][0] = __builtin_amdgcn_mfma_f32_16x16x32_bf16(a, bfr[0], st[mt][0], 0, 0, 0);
                st[mt][1] = __builtin_amdgcn_mfma_f32_16x16x32_bf16(a, bfr[1], st[mt][1], 0, 0, 0);
            }
        }
        __syncthreads();
#pragma unroll
        for (int mt = 0; mt < 8; ++mt)
#pragma unroll
            for (int nt = 0; nt < 2; ++nt) { u32x2 w; w.x = pk2(st[mt][nt][0], st[mt][nt][1]); w.y = pk2(st[mt][nt][2], st[mt][nt][3]);
                *(LAS u32x2*)(ST + (32 * wave + 16 * nt + fr) * 136 + 16 * mt + 4 * g) = w; }
        __syncthreads();
        f32x4 o[8];
#pragma unroll
        for (int nt = 0; nt < 8; ++nt) o[nt] = (f32x4){0.f, 0.f, 0.f, 0.f};
#pragma unroll
        for (int ks = 0; ks < 4; ++ks) {
            const bf16x8 a = *(const LAS bf16x8*)(QS + (16 * rg + fr) * 136 + 32 * ks + 8 * g);
#pragma unroll
            for (int nt = 0; nt < 8; ++nt) { const bf16x8 bb = *(const LAS bf16x8*)(ST + (128 * ch + 16 * nt + fr) * 136 + 32 * ks + 8 * g);
                o[nt] = __builtin_amdgcn_mfma_f32_16x16x32_bf16(a, bb, o[nt], 0, 0, 0); }
        }
        {
            f32x4 s2 = (f32x4){0.f, 0.f, 0.f, 0.f};
#pragma unroll
            for (int nt = 0; nt < 8; ++nt) s2 += o[nt] * o[nt];
#pragma unroll
            for (int r = 0; r < 4; ++r) { float s = s2[r]; s += __shfl_xor(s, 1); s += __shfl_xor(s, 2); s += __shfl_xor(s, 4); s += __shfl_xor(s, 8); if (fr == 0) SS[(16 * rg + 4 * g + r) * 2 + ch] = s; }
        }
        __syncthreads();
#pragma unroll
        for (int r = 0; r < 4; ++r) {
            const int t = 16 * rg + 4 * g + r;
            const float rstd = rsqrtf((SS[t * 2] + SS[t * 2 + 1]) * (1.0f / 256.0f) + RMS_EPS);
            bf16_t* grow = gr + (size_t)(tok0 + t) * 1024 + h * 256 + 128 * ch + fr;
#pragma unroll
#if defined(GLA_DBG) && GLA_DBG == 1
            for (int nt = 0; nt < 8; ++nt) grow[16 * nt] = f2bf(o[nt][r]);
#elif defined(GLA_DBG) && GLA_DBG == 2
            for (int nt = 0; nt < 8; ++nt) grow[16 * nt] = f2bf(rstd);
#else
            for (int nt = 0; nt < 8; ++nt) { const bf16_t y = f2bf(o[nt][r] * rstd * gnv[nt] * bf2f(grow[16 * nt])); if (!nostore) grow[16 * nt] = y; }
#endif
        }
    }
#undef GLA_LOAD
    __syncthreads();
}

__device__ __forceinline__ float xor16_max(float v) { const auto r = __builtin_amdgcn_permlane16_swap(__float_as_uint(v), __float_as_uint(v), false, false); return fmaxf(__uint_as_float(r[0]), __uint_as_float(r[1])); }
__device__ __forceinline__ float xor32_max(float v) { const auto r = __builtin_amdgcn_permlane32_swap(__float_as_uint(v), __float_as_uint(v), false, false); return fmaxf(__uint_as_float(r[0]), __uint_as_float(r[1])); }
__device__ __forceinline__ float xor16_sum(float v) { const auto r = __builtin_amdgcn_permlane16_swap(__float_as_uint(v), __float_as_uint(v), false, false); return __uint_as_float(r[0]) + __uint_as_float(r[1]); }
__device__ __forceinline__ float xor32_sum(float v) { const auto r = __builtin_amdgcn_permlane32_swap(__float_as_uint(v), __float_as_uint(v), false, false); return __uint_as_float(r[0]) + __uint_as_float(r[1]); }
constexpr int ATT_BUF = 43008, ATT_VOFF = 24576;
__device__ __forceinline__ void attn_phase(const Params& p, LAS unsigned char* lds, int bh) {
    const int tid = threadIdx.x, lane = tid & 63, wave = __builtin_amdgcn_readfirstlane(tid >> 6), fr = lane & 15, g = lane >> 4;
    const int b = bh >> 3, h = bh & 7;
    const bf16_t* qm = (const bf16_t*)p.out; const bf16_t* kn = (const bf16_t*)(p.ws + WS_BIG(0)); const bf16_t* vm = (const bf16_t*)(p.ws + WS_BIG(7));
    const bf16_t* kr = (const bf16_t*)(p.ws + WS_KR); bf16_t* ob = (bf16_t*)(p.ws + WS_BIG(1));
    const int kp = tid & 31, dvc = tid >> 5;
    unsigned koff[3]; bool krope[3];
#pragma unroll
    for (int j = 0; j < 3; ++j) { const int L = (8 * j + wave) * 64 + lane, key = L / 24, sl = L % 24, c = (sl & ~7) | ((sl & 7) ^ (key & 7));
        krope[j] = c >= 16; koff[j] = krope[j] ? (unsigned)(key * 128 + 16 * (c - 16)) : (unsigned)(key * 2048 + h * 256 + 16 * c); }
    for (int qb = 0; qb < 8; ++qb) {
        const int q0 = b * 2048 + 256 * qb + 32 * wave;
        bf16x8 qf[2][6];
#pragma unroll
        for (int nt = 0; nt < 2; ++nt)
#pragma unroll
            for (int ks = 0; ks < 6; ++ks) qf[nt][ks] = *(const bf16x8*)(qm + (size_t)(q0 + 16 * nt + fr) * 1536 + h * 192 + 32 * ks + 8 * g);
        f32x4 O[8][2];
#pragma unroll
        for (int mt = 0; mt < 8; ++mt) { O[mt][0] = (f32x4){0.f, 0.f, 0.f, 0.f}; O[mt][1] = (f32x4){0.f, 0.f, 0.f, 0.f}; }
        float m_run[2] = {-1e30f, -1e30f}, l_part[2] = {0.f, 0.f};
        const int ntile = 4 * qb + 4, my_last = 4 * qb + (wave >> 1);
        u32x4 vreg[2];
#define ATT_PREFETCH(kt, buf) do { const int tk0 = b * 2048 + 64 * (kt); const char* knb = (const char*)(kn + (size_t)tk0 * 1024); const char* krb = (const char*)(kr + (size_t)tk0 * 64); \
            _Pragma("unroll") for (int j = 0; j < 3; ++j) __builtin_amdgcn_global_load_lds((const unsigned*)((krope[j] ? krb : knb) + koff[j]), (LAS unsigned*)(lds + (buf) * ATT_BUF + (8 * j + wave) * 1024), 16, 0, 0); \
            vreg[0] = *(const u32x4*)(vm + (size_t)(tk0 + 2 * kp) * 1024 + h * 128 + 8 * dvc); vreg[1] = *(const u32x4*)(vm + (size_t)(tk0 + 2 * kp + 1) * 1024 + h * 128 + 8 * dvc); } while (0)
#define ATT_WRITE(buf) do { LAS unsigned* VTw = (LAS unsigned*)(lds + (buf) * ATT_BUF + ATT_VOFF); \
            _Pragma("unroll") for (int i = 0; i < 4; ++i) { const unsigned a_ = vreg[0][i], b_ = vreg[1][i]; \
                VTw[(8 * dvc + 2 * i) * 36 + kp] = (a_ & 0xffffu) | (b_ << 16); VTw[(8 * dvc + 2 * i + 1) * 36 + kp] = (a_ >> 16) | (b_ & 0xffff0000u); } \
            asm volatile("s_waitcnt vmcnt(0)" ::: "memory"); } while (0)
        __syncthreads();
        ATT_PREFETCH(0, 0);
        ATT_WRITE(0);
        __syncthreads();
        for (int kt = 0; kt < ntile; ++kt) {
            if (kt + 1 < ntile) ATT_PREFETCH(kt + 1, (kt + 1) & 1);
            if (kt <= my_last) {
                const LAS unsigned char* KS = lds + (kt & 1) * ATT_BUF; const LAS unsigned* VT = (const LAS unsigned*)(lds + (kt & 1) * ATT_BUF + ATT_VOFF);
                f32x4 s[4][2];
#pragma unroll
                for (int mt = 0; mt < 4; ++mt) { s[mt][0] = (f32x4){0.f, 0.f, 0.f, 0.f}; s[mt][1] = (f32x4){0.f, 0.f, 0.f, 0.f}; }
                {
                    bf16x8 ka[2][4];
                    const LAS unsigned char* kb0 = KS + fr * 384 + 16 * (g ^ (fr & 7));
                    const LAS unsigned char* kb1 = KS + fr * 384 + 16 * ((4 + g) ^ (fr & 7));
#pragma unroll
                    for (int mt = 0; mt < 4; ++mt) ka[0][mt] = *(const LAS bf16x8*)(kb0 + mt * 6144);
#pragma unroll
                    for (int ks = 0; ks < 6; ++ks) {
                        if (ks < 5) {
#pragma unroll
                            for (int mt = 0; mt < 4; ++mt) ka[(ks + 1) & 1][mt] = *(const LAS bf16x8*)((((ks + 1) & 1) ? kb1 : kb0) + mt * 6144 + 128 * ((ks + 1) >> 1));
                            asm volatile("s_waitcnt lgkmcnt(4)" ::: "memory");
                        } else asm volatile("s_waitcnt lgkmcnt(0)" ::: "memory");
                        __builtin_amdgcn_sched_barrier(0);
#pragma unroll
                        for (int mt = 0; mt < 4; ++mt) {
                            s[mt][0] = __builtin_amdgcn_mfma_f32_16x16x32_bf16(ka[ks & 1][mt], qf[0][ks], s[mt][0], 0, 0, 0);
                            s[mt][1] = __builtin_amdgcn_mfma_f32_16x16x32_bf16(ka[ks & 1][mt], qf[1][ks], s[mt][1], 0, 0, 0);
                        }
                        __builtin_amdgcn_sched_barrier(0);
                    }
                }
                bf16x8 pf[2][2]; float al[2];
#pragma unroll
                for (int nt = 0; nt < 2; ++nt) {
                    float mx = fmaxf(fmaxf(s[0][nt][0], s[0][nt][1]), fmaxf(s[0][nt][2], s[0][nt][3]));
#pragma unroll
                    for (int mt = 1; mt < 4; ++mt) mx = fmaxf(mx, fmaxf(fmaxf(s[mt][nt][0], s[mt][nt][1]), fmaxf(s[mt][nt][2], s[mt][nt][3])));
                    mx = xor16_max(mx); mx = xor32_max(mx);
                    const float mn = fmaxf(m_run[nt], mx); al[nt] = __builtin_amdgcn_exp2f(m_run[nt] - mn); m_run[nt] = mn;
                    float rs = 0.f;
#pragma unroll
                    for (int mt = 0; mt < 4; ++mt)
#pragma unroll
                        for (int r = 0; r < 4; ++r) { const float e = __builtin_amdgcn_exp2f(s[mt][nt][r] - mn); s[mt][nt][r] = e; rs += e; }
                    l_part[nt] = l_part[nt] * al[nt] + rs;
#pragma unroll
                    for (int k2 = 0; k2 < 2; ++k2) {
                        u32x4 w; w.x = pk2(s[2 * k2][nt][0], s[2 * k2][nt][1]); w.y = pk2(s[2 * k2][nt][2], s[2 * k2][nt][3]);
                        w.z = pk2(s[2 * k2 + 1][nt][0], s[2 * k2 + 1][nt][1]); w.w = pk2(s[2 * k2 + 1][nt][2], s[2 * k2 + 1][nt][3]);
                        pf[nt][k2] = __builtin_bit_cast(bf16x8, w);
                    }
                }
                if (__any(al[0] != 1.0f || al[1] != 1.0f)) {
#pragma unroll
                    for (int mt = 0; mt < 8; ++mt) { O[mt][0] *= al[0]; O[mt][1] *= al[1]; }
                }
                {
                    u32x2 vf[2][2][2];
                    const LAS unsigned* vbase = VT + fr * 36 + 2 * g;
#pragma unroll
                    for (int k2 = 0; k2 < 2; ++k2) { vf[0][k2][0] = *(const LAS u32x2*)(vbase + 16 * k2); vf[0][k2][1] = *(const LAS u32x2*)(vbase + 16 * k2 + 8); }
#pragma unroll
                    for (int mt = 0; mt < 8; ++mt) {
                        if (mt < 7) {
#pragma unroll
                            for (int k2 = 0; k2 < 2; ++k2) { vf[(mt + 1) & 1][k2][0] = *(const LAS u32x2*)(vbase + 16 * (mt + 1) * 36 + 16 * k2); vf[(mt + 1) & 1][k2][1] = *(const LAS u32x2*)(vbase + 16 * (mt + 1) * 36 + 16 * k2 + 8); }
                            asm volatile("s_waitcnt lgkmcnt(4)" ::: "memory");
                        } else asm volatile("s_waitcnt lgkmcnt(0)" ::: "memory");
                        __builtin_amdgcn_sched_barrier(0);
#pragma unroll
                        for (int k2 = 0; k2 < 2; ++k2) {
                            const u32x2 lo = vf[mt & 1][k2][0], hi = vf[mt & 1][k2][1];
                            const bf16x8 a = __builtin_bit_cast(bf16x8, ((u32x4){lo.x, lo.y, hi.x, hi.y}));
                            O[mt][0] = __builtin_amdgcn_mfma_f32_16x16x32_bf16(a, pf[0][k2], O[mt][0], 0, 0, 0);
                            O[mt][1] = __builtin_amdgcn_mfma_f32_16x16x32_bf16(a, pf[1][k2], O[mt][1], 0, 0, 0);
                        }
                        __builtin_amdgcn_sched_barrier(0);
                    }
                }
            }
            if (kt + 1 < ntile) ATT_WRITE((kt + 1) & 1);
            __syncthreads();
        }
#undef ATT_PREFETCH
#undef ATT_WRITE
#pragma unroll
        for (int nt = 0; nt < 2; ++nt) {
            float l = l_part[nt]; l = xor16_sum(l); l = xor32_sum(l);
            const float inv = 1.0f / l;
            bf16_t* orow = ob + (size_t)(q0 + 16 * nt + fr) * 1024 + h * 128 + 4 * g;
#pragma unroll
            for (int mt = 0; mt < 8; ++mt) { u32x2 w; w.x = pk2(O[mt][nt][0] * inv, O[mt][nt][1] * inv); w.y = pk2(O[mt][nt][2] * inv, O[mt][nt][3] * inv); *(u32x2*)(orow + 16 * mt) = w; }
        }
    }
    __syncthreads();
}

__device__ __forceinline__ unsigned dpp_umax_step_shr(unsigned v, int) { return v; }
__device__ __forceinline__ unsigned wave_umax(unsigned v) {
    unsigned t;
    t = (unsigned)__builtin_amdgcn_update_dpp(0, (int)v, 0x111, 0xf, 0xf, true); v = v > t ? v : t;
    t = (unsigned)__builtin_amdgcn_update_dpp(0, (int)v, 0x112, 0xf, 0xf, true); v = v > t ? v : t;
    t = (unsigned)__builtin_amdgcn_update_dpp(0, (int)v, 0x114, 0xf, 0xf, true); v = v > t ? v : t;
    t = (unsigned)__builtin_amdgcn_update_dpp(0, (int)v, 0x118, 0xf, 0xf, true); v = v > t ? v : t;
    t = (unsigned)__builtin_amdgcn_update_dpp(0, (int)v, 0x142, 0xa, 0xf, false); v = v > t ? v : t;
    t = (unsigned)__builtin_amdgcn_update_dpp(0, (int)v, 0x143, 0xc, 0xf, false); v = v > t ? v : t;
    return (unsigned)__builtin_amdgcn_readlane((int)v, 63);
}
template <int CTRL> __device__ __forceinline__ float dpp_f(float v) { return __builtin_bit_cast(float, __builtin_amdgcn_update_dpp(0, __builtin_bit_cast(int, v), CTRL, 0xf, 0xf, false)); }
template <int CTRL> __device__ __forceinline__ void top2_merge(float& t1, float& t2) { const float p1 = dpp_f<CTRL>(t1), p2 = dpp_f<CTRL>(t2); const float n1 = fmaxf(t1, p1), n2 = fmaxf(fminf(t1, p1), fmaxf(t2, p2)); t1 = n1; t2 = n2; }
__device__ __forceinline__ void route_row2(const float* lrow, const float* brt, int* tidx, float* tw, LAS int* etab, int lane) {
    const f32x4 bb = *(const f32x4*)(brt + 4 * lane);
    float sc[2][4], mv[2][4], t1[2], t2[2];
#pragma unroll
    for (int q = 0; q < 2; ++q) {
        const f32x4 lg = *(const f32x4*)(lrow + q * 256 + 4 * lane);
#pragma unroll
        for (int i = 0; i < 4; ++i) { sc[q][i] = sigm(lg[i]); mv[q][i] = sc[q][i] + bb[i]; }
        t1[q] = fmaxf(fmaxf(mv[q][0], mv[q][1]), fmaxf(mv[q][2], mv[q][3]));
        const float a = fmaxf(mv[q][0], mv[q][1]), bq = fminf(mv[q][0], mv[q][1]), c = fmaxf(mv[q][2], mv[q][3]), d = fminf(mv[q][2], mv[q][3]); t2[q] = fmaxf(fminf(a, c), fmaxf(bq, d));
    }
    top2_merge<0xB1>(t1[0], t2[0]); top2_merge<0xB1>(t1[1], t2[1]);
    top2_merge<0x4E>(t1[0], t2[0]); top2_merge<0x4E>(t1[1], t2[1]);
    top2_merge<0x141>(t1[0], t2[0]); top2_merge<0x141>(t1[1], t2[1]);
    const int mygrp = lane >> 3;
#pragma unroll
    for (int q = 0; q < 2; ++q) {
        const float gs = t1[q] + t2[q]; int rank = 0;
#pragma unroll
        for (int j = 0; j < 8; ++j) { const float o = __builtin_bit_cast(float, __builtin_amdgcn_readlane(__builtin_bit_cast(int, gs), 8 * j)); rank += (o > gs || (o == gs && j < mygrp)) ? 1 : 0; }
        if (rank >= 4) {
#pragma unroll
            for (int i = 0; i < 4; ++i) mv[q][i] = -3.0e38f;
        }
    }
    float wsel[2] = {0.f, 0.f}, wsum[2] = {0.f, 0.f}; int esel[2] = {0, 0};
#pragma unroll
    for (int r = 0; r < 8; ++r) {
        unsigned key[2];
#pragma unroll
        for (int q = 0; q < 2; ++q) {
            float bv = mv[q][0]; int bi = 0;
#pragma unroll
            for (int i = 1; i < 4; ++i) if (mv[q][i] > bv) { bv = mv[q][i]; bi = i; }
            unsigned u = __builtin_bit_cast(unsigned, bv); u = (u & 0x80000000u) ? ~u : (u | 0x80000000u);
            key[q] = (u & 0xFFFFFF00u) | (unsigned)(255 - (4 * lane + bi));
        }
        unsigned v0 = key[0], v1 = key[1], t0, t1_;
#define RSTEP(ctrl, rm, bc) t0 = (unsigned)__builtin_amdgcn_update_dpp(0, (int)v0, ctrl, rm, 0xf, bc); t1_ = (unsigned)__builtin_amdgcn_update_dpp(0, (int)v1, ctrl, rm, 0xf, bc); v0 = v0 > t0 ? v0 : t0; v1 = v1 > t1_ ? v1 : t1_;
        RSTEP(0x111, 0xf, true) RSTEP(0x112, 0xf, true) RSTEP(0x114, 0xf, true) RSTEP(0x118, 0xf, true) RSTEP(0x142, 0xa, false) RSTEP(0x143, 0xc, false)
#undef RSTEP
        const unsigned km[2] = {(unsigned)__builtin_amdgcn_readlane((int)v0, 63), (unsigned)__builtin_amdgcn_readlane((int)v1, 63)};
#pragma unroll
        for (int q = 0; q < 2; ++q) {
            const int e = 255 - (int)(km[q] & 255u), ii = e & 3;
            const float cand = ii == 0 ? sc[q][0] : ii == 1 ? sc[q][1] : ii == 2 ? sc[q][2] : sc[q][3];
            const float sv = __builtin_bit_cast(float, __builtin_amdgcn_readlane(__builtin_bit_cast(int, cand), e >> 2));
#pragma unroll
            for (int i = 0; i < 4; ++i) mv[q][i] = (4 * lane + i == e) ? -3.0e38f : mv[q][i];
            wsum[q] += sv;
            if (lane == r) { wsel[q] = sv; esel[q] = e; }
        }
    }
    if (lane < 8) {
#pragma unroll
        for (int q = 0; q < 2; ++q) { tidx[q * 8 + lane] = esel[q]; tw[q * 8 + lane] = wsel[q] / wsum[q] * 2.5f; etab[q * 8 + lane] = esel[q]; }
    }
}

__global__ void __launch_bounds__(NTHR, 2) mk_fwd(Params p) {
    extern __shared__ __attribute__((aligned(16))) unsigned char lds_raw[];
    LAS unsigned char* lds = (LAS unsigned char*)lds_raw;
    int tid = threadIdx.x, lane = tid & 63; const int wave = __builtin_amdgcn_readfirstlane(tid >> 6);
#define FRESH_IDS() do { int _t = threadIdx.x; asm volatile("; fresh ids" : "+v"(_t)); tid = _t; lane = _t & 63; } while (0)
    const int c = blockIdx.x, G = gridDim.x;
    const int gw = c * 8 + wave, ngw = G * 8;
    unsigned char* ws = p.ws;
    volatile LAS unsigned* MISC = (volatile LAS unsigned*)(lds + LDS_MISC);
    for (int u = tid; u < (LDS_BYTES - LDS_MISC) / 4; u += NTHR) ((LAS unsigned*)(lds + LDS_MISC))[u] = 0u;
    __syncthreads();
    XcdBarrier bar; bar.bar = (unsigned*)(ws + WS_BAR); bar.x = 0; bar.st = nullptr;
#if MK_ONE_LAUNCH
    bar = xcd_barrier_post((unsigned*)(ws + WS_BAR), MISC + 8);
#endif
    const int lo = p.ph_lo, hi = p.ph_hi;
#ifndef PH_MASK
#define PH_MASK 0x1ffff
#endif
#define IN(k) (((PH_MASK >> (k)) & 1) && lo <= (k) && (k) < hi)
#define SEAM(k) do { if (IN(k) && IN((k) + 1)) xcd_barrier(bar); } while (0)

    if (IN(0)) { FRESH_IDS(); phase0(p, lds, gw, ngw, lane, wave); }
    SEAM(0);
    if (IN(1)) { FRESH_IDS(); phase1(p, gw, ngw, lane); }
    SEAM(1);
    if (IN(2)) { FRESH_IDS();
        pg8::Gemm g{(const bf16_t*)(ws + WS_BIG(0)), (const bf16_t*)(ws + WS_WIN), 1024, nullptr, 0, 0};
        pg8::StaticOrder S; S.init(NTOK, 13 * 256, G, c); S.remap = 1;
        EpiWin E; E.q = (bf16_t*)(ws + WS_BIG(1)); E.k = E.q + (size_t)NTOK * 512; E.v = (bf16_t*)(ws + WS_BIG(2)); E.gr = (bf16_t*)(ws + WS_BIG(3));
        E.cq = (bf16_t*)(ws + WS_BIG(4)); E.ckv = E.cq + (size_t)NTOK * 768; E.sa = (bf16_t*)(ws + WS_BIG(5)); E.sb = (bf16_t*)(ws + WS_BIG(6));
        E.kr = (bf16_t*)(ws + WS_KR); E.ga = (float*)(ws + WS_GA);
        E.rope = (const float*)((unsigned char*)p.out + 192 * MiB); E.f8 = 0; E.ascale = 1.0f;
        pg8::gemm_phase<EpiWin, pg8::StaticOrder, false>(lds, g, S, E);
        pg8::Gemm g8{(const bf16_t*)(ws + WS_BIG(7)), (const bf16_t*)(ws + WS_WIN8), 512, nullptr, 0, 0};
        pg8::StaticOrder S8; S8.init(NTOK, 12 * 256, G, c);
        E.f8 = 1; E.ascale = 1.0f / 32.0f;
        pg8::gemm_phase<EpiWin, pg8::StaticOrder, false, true>(lds, g8, S8, E);
    }
    SEAM(2);
    if (IN(3)) { FRESH_IDS();
#ifndef NO_GLA
        if (c < 128 && !(p.flags & 1)) gla_phase(p, lds, c, (p.flags & 2) != 0);
#endif
#ifndef NO_P3GEMM
        if (!(p.flags & 2)) { const int pm = c;
            {
                const bf16_t* cqb = (const bf16_t*)(ws + WS_BIG(4)); const bf16_t* ckvb = cqb + (size_t)NTOK * 768;
                float* cqss = (float*)(ws + WS_CQSS); float* ckvss = (float*)(ws + WS_CKVSS);
                for (int r = 0; r < 32; ++r) { const int row = pm * 256 + wave * 32 + r;
                    float s = 0.f;
#pragma unroll
                    for (int j = 0; j < 3; ++j) { const u32x2 w = *((const u32x2*)(cqb + (size_t)row * 768) + lane + 64 * j); const float a0 = bflo(w.x), a1 = bfhi(w.x), a2 = bflo(w.y), a3 = bfhi(w.y); s += (a0 * a0 + a1 * a1) + (a2 * a2 + a3 * a3); }
                    const u32x2 w = *((const u32x2*)(ckvb + (size_t)row * 256) + lane); const float a0 = bflo(w.x), a1 = bfhi(w.x), a2 = bflo(w.y), a3 = bfhi(w.y);
                    const float s1 = wave_sum(s), s2 = wave_sum((a0 * a0 + a1 * a1) + (a2 * a2 + a3 * a3));
                    if (lane == 0) { cqss[row] = s1; ckvss[row] = s2; } }
                if (c >= 128 && G == 256) {
                    for (int r = 0; r < 32; ++r) { const int row = (pm - 128) * 256 + wave * 32 + r;
                        float s = 0.f;
#pragma unroll
                        for (int j = 0; j < 3; ++j) { const u32x2 w = *((const u32x2*)(cqb + (size_t)row * 768) + lane + 64 * j); const float a0 = bflo(w.x), a1 = bfhi(w.x), a2 = bflo(w.y), a3 = bfhi(w.y); s += (a0 * a0 + a1 * a1) + (a2 * a2 + a3 * a3); }
                        const float s1 = wave_sum(s);
                        if (lane == 0) cqss[row] = s1; }
                }
                wg_global_sync();
            }
#ifndef NO_QF
            {
                constexpr int QSPLIT = 2;
                const bool glawg = (c < 128) && G == 256;
                EpiQF E{(bf16_t*)p.out, (const float*)(ws + WS_CQSS), (const float*)((unsigned char*)p.out + 192 * MiB)};
                pg8::Gemm g{(const bf16_t*)(ws + WS_BIG(4)), (const bf16_t*)(ws + WS_WUQ), 768, nullptr, 0, 0};
                if (!glawg && G == 256) { pg8::PanelOrder S{pm - 128, 6 - QSPLIT, QSPLIT}; pg8::gemm_phase<EpiQF, pg8::PanelOrder, false>(lds, g, S, E); }
                { pg8::PanelOrder S{pm, glawg ? QSPLIT : 6, 0}; pg8::gemm_phase<EpiQF, pg8::PanelOrder, false>(lds, g, S, E); }
            }
#endif
#ifndef NO_KV
            { const K256Store E{(bf16_t*)(ws + WS_BIG(0)), 1024, (const float*)(ws + WS_CKVSS), 1.0f / 256.0f, (bf16_t*)(ws + WS_BIG(7)), 1024, 0};
              gemm_k256(lds, (const bf16_t*)(ws + WS_BIG(4)) + (size_t)NTOK * 768 + (size_t)pm * 65536, (const bf16_t*)(ws + WS_WUKV), 32, pm * 256, E); }
#endif
        }
#endif
    }
    SEAM(3);
    if (IN(4)) { FRESH_IDS(); attn_phase(p, lds, c); }
    SEAM(4);
    if (IN(5)) { FRESH_IDS();
        LAS int* hist = (LAS int*)lds;
        { const int pm = c;
            bf16_t* Y = (bf16_t*)(ws + WS_BIG(2));
            { pg8::Gemm g{(const bf16_t*)(ws + WS_BIG(3)), (const bf16_t*)(ws + WS_WGLAO), 1024, nullptr, 0, 0}; pg8::PanelOrder S{pm, 4, 0};
              EpiGate<false> E{Y, (const unsigned char*)(ws + WS_BIG(5))}; pg8::gemm_phase<EpiGate<false>, pg8::PanelOrder, false>(lds, g, S, E); }
            { pg8::Gemm g{(const bf16_t*)(ws + WS_BIG(1)), (const bf16_t*)(ws + WS_WMLAO), 1024, nullptr, 0, 0}; pg8::PanelOrder S{pm, 4, 0};
              EpiGate<true> E{Y, (const unsigned char*)(ws + WS_BIG(6))}; pg8::gemm_phase<EpiGate<true>, pg8::PanelOrder, false>(lds, g, S, E); }
            wg_global_sync();
            { pg8::Gemm g{Y, (const bf16_t*)(ws + WS_WOUT), 1024, nullptr, 0, 0}; pg8::PanelOrder S{pm, 4, 0};
              EpiBf16 E{(bf16_t*)(ws + ((p.flags & 4096) ? WS_BIG(7) : WS_BIG(1))), 1024}; pg8::gemm_phase<EpiBf16, pg8::PanelOrder, false>(lds, g, S, E); }
            wg_global_sync();
            if (!(p.flags & 4)) {
                const int b = pm >> 3; const float* mod = (const float*)(ws + WS_MOD) + b * 6144;
                const bf16_t* mix = (const bf16_t*)(ws + ((p.flags & 4096) ? WS_BIG(7) : WS_BIG(1))); bf16_t* h2 = (bf16_t*)(ws + WS_BIG(4));
                f32x4 g1[4], gg[4], gb[4], s2v[4], h2v[4];
#pragma unroll
                for (int j = 0; j < 4; ++j) { const int ci = lane + 64 * j; g1[j] = ((const f32x4*)(mod + 2048))[ci] + 1.0f; gg[j] = ((const f32x4*)p.in[I_LN1G])[ci]; gb[j] = ((const f32x4*)p.in[I_LN1B])[ci];
                    s2v[j] = ((const f32x4*)(mod + 4096))[ci] + 1.0f; h2v[j] = ((const f32x4*)(mod + 3072))[ci]; }
                for (int r0 = 0; r0 < 32; r0 += 4) {
                    const int row0 = pm * 256 + wave * 32 + r0;
                    f32x4 v[4][4]; u32x2 mw[4][4];
#pragma unroll
                    for (int t = 0; t < 4; ++t)
#pragma unroll
                        for (int j = 0; j < 4; ++j) { v[t][j] = ((const f32x4*)(p.in[I_X] + (size_t)(row0 + t) * 1024))[lane + 64 * j]; mw[t][j] = ((const u32x2*)(mix + (size_t)(row0 + t) * 1024))[lane + 64 * j]; }
#pragma unroll
                    for (int t = 0; t < 4; ++t) {
                        float s = 0.f;
#pragma unroll
                        for (int j = 0; j < 4; ++j) { const u32x2 w = mw[t][j]; v[t][j] = v[t][j] * ALPHA + g1[j] * (f32x4){bflo(w.x), bfhi(w.x), bflo(w.y), bfhi(w.y)}; s += (v[t][j][0] + v[t][j][1]) + (v[t][j][2] + v[t][j][3]); }
                        const float mean = wave_sum(s) * (1.f / 1024.f); float q = 0.f;
#pragma unroll
                        for (int j = 0; j < 4; ++j) { v[t][j] = v[t][j] - mean; q += (v[t][j][0] * v[t][j][0] + v[t][j][1] * v[t][j][1]) + (v[t][j][2] * v[t][j][2] + v[t][j][3] * v[t][j][3]); }
                        const float rstd = rsqrtf(wave_sum(q) * (1.f / 1024.f) + LN_EPS);
#pragma unroll
                        for (int j = 0; j < 4; ++j) { const f32x4 x1 = v[t][j] * rstd * gg[j] + gb[j];
                            { u32x2 xw; xw.x = pk2(x1[0], x1[1]); xw.y = pk2(x1[2], x1[3]); ((u32x2*)(p.out + (size_t)(row0 + t) * 1024))[lane + 64 * j] = xw; }
                            const f32x4 hh = x1 * s2v[j] + h2v[j]; u32x2 w; w.x = pk2(hh[0], hh[1]); w.y = pk2(hh[2], hh[3]);
                            ((u32x2*)(h2 + (size_t)(row0 + t) * 1024))[lane + 64 * j] = w;
                            unsigned w8 = 0u; w8 = __builtin_amdgcn_cvt_pk_fp8_f32(hh[0], hh[1], w8, false); w8 = __builtin_amdgcn_cvt_pk_fp8_f32(hh[2], hh[3], w8, true);
                            ((unsigned*)(ws + WS_BIG(6) + 64 * MiB + (size_t)(row0 + t) * 1024))[lane + 64 * j] = w8; }
                    }
                }
            }
            wg_global_sync();
            { pg8::Gemm g{(const bf16_t*)(ws + WS_BIG(4)), (const bf16_t*)(ws + WS_WRT), 1024, nullptr, 0, 0}; pg8::PanelOrder S{pm, 1, 0};
              EpiF32 E{(float*)(ws + WS_BIG(0)), 256}; pg8::gemm_phase<EpiF32, pg8::PanelOrder, false>(lds, g, S, E); }
            { pg8::Gemm g{(const bf16_t*)(ws + WS_BIG(4)), (const bf16_t*)(ws + WS_WS13), 1024, nullptr, 0, 0}; pg8::PanelOrder S{pm, 2, 0};
              EpiGLU E{(bf16_t*)(ws + WS_BIG(0) + 64 * MiB), 1.0f, 0}; pg8::gemm_phase<EpiGLU, pg8::PanelOrder, false>(lds, g, S, E); }
            wg_global_sync();
            { const K256Store E{(bf16_t*)(ws + WS_BIG(7)), 1024, nullptr, 0.f, nullptr, 0, 0};
              gemm_k256(lds, (const bf16_t*)(ws + WS_BIG(0) + 64 * MiB) + (size_t)pm * 65536, (const bf16_t*)(ws + WS_WS2), 16, pm * 256, E); }
            if (!(p.flags & 8)) {
            LAS int* etab = (LAS int*)(lds + 1024);
            LAS int* lrk = (LAS int*)(lds + 1024 + 8192);
            __syncthreads();
            for (int r = 0; r < 32; r += 2) { const int rl = wave * 32 + r, row = pm * 256 + rl;
                route_row2((const float*)(ws + WS_BIG(0)) + (size_t)row * 256, p.in[I_BRT], (int*)(ws + WS_TIDX) + row * 8, (float*)(ws + WS_TW) + row * 8, etab + rl * 8, lane); }
            __syncthreads();
            if (tid < 256) { int cnt = 0;
#pragma unroll 8
                for (int a2 = 0; a2 < 2048; ++a2) if (etab[a2] == tid) { lrk[a2] = cnt; ++cnt; }
                hist[tid] = cnt; }
            __syncthreads();
            if (tid < 256) ((int*)(ws + WS_CNTWG))[pm * 256 + tid] = hist[tid];
#pragma unroll
            for (int i = 0; i < 4; ++i) ((int*)(ws + WS_LRANK))[pm * 2048 + tid + 512 * i] = lrk[tid + 512 * i];
            __syncthreads();
            }
        }
    }
    SEAM(5);
    if (IN(6)) { FRESH_IDS();
        LAS int* pstart = (LAS int*)lds;
        LAS int* wbase = (LAS int*)(lds + 2048);
        LAS int* tot = (LAS int*)(lds + 4096);
        const int* cntwg = (const int*)(ws + WS_CNTWG);
        { const int pm = c;
            if (tid < 256) { int t = 0, bs = 0; for (int w = 0; w < 256; ++w) { const int v = cntwg[w * 256 + tid]; t += v; bs += (w < pm) ? v : 0; } tot[tid] = t; wbase[tid] = bs; }
            __syncthreads();
            if (tid == 0) { int run = 0; for (int e = 0; e < 256; ++e) { pstart[e] = run; run += (tot[e] + 255) & ~255; } pstart[256] = run; }
            __syncthreads();
            if (pm == 0 && tid <= 256) ((int*)(ws + WS_TAB))[tid] = pstart[tid];
            const int* tidx = (const int*)(ws + WS_TIDX); int* lrank = (int*)(ws + WS_LRANK);
            int* stok = (int*)(ws + WS_STOK);
#pragma unroll
            for (int i = 0; i < 4; ++i) { const int a = pm * 2048 + tid * 4 + i; const int e = tidx[a]; const int slot = pstart[e] + wbase[e] + lrank[a]; stok[slot] = a >> 3; ((int*)(ws + WS_SW))[a] = slot; }
            __syncthreads();
        }
        LAS unsigned* scr = (LAS unsigned*)(lds + 8192 + wave * 8448);
        bf16_t* e13 = (bf16_t*)(ws + WS_BIG(5)); bf16_t* e2 = (bf16_t*)(ws + WS_BIG(0));
        for (int it = gw; it < 256 * 192; it += ngw) {
            const int e = it / 192, r = it % 192;
            if (r < 128) tr_glu8_item(p.in[I_WE1] + (size_t)e * 262144, p.in[I_WE3] + (size_t)e * 262144, 1024, 256, (unsigned char*)e13 + (size_t)e * 524288, scr, r >> 3, r & 7, lane);
            else { const int r2 = r - 128; tr8_item(p.in[I_WE2] + (size_t)e * 262144, 256, 1024, (unsigned char*)e2 + (size_t)e * 262144, MapId{0}, scr, r2 >> 4, r2 & 15, lane); }
        }
    }
    SEAM(6);
    constexpr int GT = 1536, NGRP = 2;
    bf16_t* ffn = (bf16_t*)(ws + WS_BIG(7));
    unsigned char* out8 = ws + WS_BIG(1);
    bf16_t* hidscr = c < 192 ? (bf16_t*)(ws + WS_WIN) + (size_t)c * 65536 : (bf16_t*)(ws + WS_KR) + (size_t)(c - 192) * 65536;
    for (int grp = 0; grp < NGRP; ++grp) {
        const int phg = 7 + 2 * grp;
        if (IN(phg)) { FRESH_IDS();
            LAS int* pstart = (LAS int*)(lds + LDS_MISC + 256);
            for (int i = tid; i <= 256; i += NTHR) pstart[i] = ((const int*)(ws + WS_TAB))[i];
            __syncthreads();
            const int ntiles = pstart[256] >> 8;
            const int t1 = (grp + 1) * GT < ntiles ? (grp + 1) * GT : ntiles;
            const int T0 = grp * GT + (c & 7) * 32 + (c >> 3);
            unsigned char* hidA = ws + WS_BIG(6) + (size_t)c * 65536; unsigned char* hidB = ws + WS_BIG(0) + 64 * MiB + (size_t)c * 65536;
            if (!(p.flags & 32)) {
                LAS int* ridx = (LAS int*)(lds + LDS_STAGE);
                { int jj = 0; for (int T = T0; T < t1; T += G, ++jj) if (tid < 256) ridx[jj * 256 + tid] = ((const int*)(ws + WS_STOK))[T * 256 + tid]; }
                __syncthreads();
                pg8::Gemm g{(const bf16_t*)(ws + WS_BIG(6) + 64 * MiB), (const bf16_t*)(ws + WS_BIG(5)), 512, ridx, T0, 8};
                pg8::MoeUpOrder S{T0, G, t1, pstart};
                EpiGluMoe E{hidA, hidB, T0, 8, 1.0f / 32.0f};
                pg8::gemm_phase<EpiGluMoe, pg8::MoeUpOrder, true, true>(lds, g, S, E);
            }
            wg_global_sync();
            int j = 0;
            for (int T = T0; T < t1; T += G, ++j) {
                int e = 0; { int lo_ = 0, hi_ = 256; while (hi_ - lo_ > 1) { const int mid = (lo_ + hi_) >> 1; if ((pstart[mid] >> 8) <= T) lo_ = mid; else hi_ = mid; } e = lo_; }
                e = __builtin_amdgcn_readfirstlane(e);
                const unsigned char* hs = j < 4 ? hidA + (size_t)j * EpiGluMoe::SLOT : hidB + (size_t)(j - 4) * EpiGluMoe::SLOT;
                if (!(p.flags & 64)) gemm_k256_f8(lds, hs, ws + WS_BIG(0) + (size_t)e * 262144, 16, T * 256, out8 - (ptrdiff_t)grp * GT * 262144, 1024, 1.0f / 32.0f);
            }
        }
        SEAM(phg);
        if (IN(phg + 1)) { FRESH_IDS();
            const int s0 = grp * GT * 256, s1 = s0 + GT * 256;
            const int* slot_of = (const int*)(ws + WS_SW); const float* tw = (const float*)(ws + WS_TW);
            const bool fin = (grp == NGRP - 1);
#define F8_ACC(dst, w16, wk) do { const u32x4 w_ = (w16); const float k_ = (wk); _Pragma("unroll") for (int j_ = 0; j_ < 4; ++j_) { \
                const f32x2 lo_ = __builtin_amdgcn_cvt_pk_f32_fp8(w_[j_], false), hi_ = __builtin_amdgcn_cvt_pk_f32_fp8(w_[j_], true); \
                dst[j_] += (f32x4){lo_[0], lo_[1], hi_[0], hi_[1]} * k_; } } while (0)
            for (int m0 = gw * 4; m0 < NTOK; m0 += ngw * 4) {
                int sl = -1; float wv = 0.f;
                if (lane < 32) { sl = slot_of[m0 * 8 + lane]; wv = tw[m0 * 8 + lane] * (1.0f / F8_SCALE); }
                const bool hit = sl >= s0 && sl < s1;
                const unsigned long long bal = __ballot(hit);
                f32x4 a[4][4];
#pragma unroll
                for (int t = 0; t < 4; ++t) { const u32x4* fr4 = (const u32x4*)(ffn + (size_t)(m0 + t) * 1024) + 2 * lane; const u32x4 f0 = fr4[0], f1 = fr4[1];
                    unpack8(f0, a[t][0], a[t][1]); unpack8(f1, a[t][2], a[t][3]); }
                u32x4 rw[4][3]; float rwt[4][3];
#pragma unroll
                for (int t = 0; t < 4; ++t) {
                    unsigned mk = (unsigned)(bal >> (8 * t)) & 0xffu;
#pragma unroll
                    for (int q = 0; q < 3; ++q) {
                        const int k = mk ? __builtin_ctz(mk) : 0; const bool ok = mk != 0u; mk &= mk - 1u;
                        const int sk = __shfl(sl, 8 * t + k); rwt[t][q] = ok ? __shfl(wv, 8 * t + k) : 0.f;
                        u32x4 w = __builtin_nontemporal_load((const u32x4*)(out8 + (size_t)(ok ? sk - s0 : 0) * 1024) + lane); if (!ok) w = (u32x4){0u, 0u, 0u, 0u};
                        rw[t][q] = w;
                    }
                }
#pragma unroll
                for (int t = 0; t < 4; ++t) {
#pragma unroll
                    for (int q = 0; q < 3; ++q) F8_ACC(a[t], rw[t][q], rwt[t][q]);
                    unsigned mk = (unsigned)(bal >> (8 * t)) & 0xffu; mk &= mk - 1u; mk &= mk - 1u; mk &= mk - 1u;
                    while (mk) { const int k = __builtin_ctz(mk); mk &= mk - 1u; const int sk = __shfl(sl, 8 * t + k); const float wk = __shfl(wv, 8 * t + k);
                        const u32x4 w = __builtin_nontemporal_load((const u32x4*)(out8 + (size_t)(sk - s0) * 1024) + lane); F8_ACC(a[t], w, wk); }
                }
                if (!fin) {
#pragma unroll
                    for (int t = 0; t < 4; ++t) if (((bal >> (8 * t)) & 0xffull) != 0ull && !(p.flags & 16)) {
                        u32x4* fw4 = (u32x4*)(ffn + (size_t)(m0 + t) * 1024) + 2 * lane; fw4[0] = pack8(a[t][0], a[t][1]); fw4[1] = pack8(a[t][2], a[t][3]); }
                } else {
                    const int b = m0 >> 11; const float* gt2 = (const float*)(ws + WS_MOD) + b * 6144 + 5 * 1024;
                    f32x4 gv[4], lg[4], lb[4];
#pragma unroll
                    for (int j = 0; j < 4; ++j) { gv[j] = ((const f32x4*)gt2)[4 * lane + j] + 1.0f; lg[j] = ((const f32x4*)p.in[I_LN2G])[4 * lane + j]; lb[j] = ((const f32x4*)p.in[I_LN2B])[4 * lane + j]; }
                    f32x4 v[4][4];
#pragma unroll
                    for (int t = 0; t < 4; ++t)
#pragma unroll
                        for (int j = 0; j < 4; j += 2) { const u32x4 xw = ((const u32x4*)(p.out + (size_t)(m0 + t) * 1024))[2 * lane + (j >> 1)]; unpack8(xw, v[t][j], v[t][j + 1]); }
#pragma unroll
                    for (int t = 0; t < 4; ++t) {
                        float sacc = 0.f;
#pragma unroll
                        for (int j = 0; j < 4; ++j) { v[t][j] = v[t][j] * ALPHA + gv[j] * a[t][j]; sacc += (v[t][j][0] + v[t][j][1]) + (v[t][j][2] + v[t][j][3]); }
                        const float mean = wave_sum(sacc) * (1.f / 1024.f); float s2 = 0.f;
#pragma unroll
                        for (int j = 0; j < 4; ++j) { v[t][j] = v[t][j] - mean; s2 += (v[t][j][0] * v[t][j][0] + v[t][j][1] * v[t][j][1]) + (v[t][j][2] * v[t][j][2] + v[t][j][3] * v[t][j][3]); }
                        const float rstd = rsqrtf(wave_sum(s2) * (1.f / 1024.f) + LN_EPS);
#pragma unroll
                        for (int j = 0; j < 4; ++j) ((f32x4*)(p.out + (size_t)(m0 + t) * 1024))[4 * lane + j] = v[t][j] * rstd * lg[j] + lb[j];
                    }
                }
            }
#undef F8_ACC
        }
        if (grp < NGRP - 1) SEAM(phg + 1);
    }
}


__global__ void dump_bf16(const bf16_t* src, float* dst, size_t n) { for (size_t i = (size_t)blockIdx.x * blockDim.x + threadIdx.x; i < n; i += (size_t)gridDim.x * blockDim.x) dst[i] = bf2f(src[i]); }
extern "C" void kernel_launch(void* const* d_in, const int* in_sizes, int n_in, void* d_out, int out_size, void* d_ws, size_t ws_size, hipStream_t stream) {
    static int ready = 0;
    if (!ready) {
        if (n_in != 28 || out_size != NTOK * DM || ws_size < WS_END) { fprintf(stderr, "kernel_launch: unexpected problem (n_in %d out %d ws %zu need %zu)\n", n_in, out_size, ws_size, (size_t)WS_END); return; }
        if (hipFuncSetAttribute((const void*)mk_fwd, hipFuncAttributeMaxDynamicSharedMemorySize, LDS_BYTES) != hipSuccess) { fprintf(stderr, "kernel_launch: hipFuncSetAttribute failed\n"); return; }
        ready = 1;
    }
    (void)hipMemsetAsync((char*)d_ws + WS_CTL, 0, CTL_ZERO_BYTES, stream);
    Params p{};
    for (int i = 0; i < 28; ++i) p.in[i] = (const float*)d_in[i];
    p.out = (float*)d_out; p.ws = (unsigned char*)d_ws;
#if MK_ONE_LAUNCH
    p.ph_lo = 0; p.ph_hi = 11;
    hipLaunchKernelGGL(mk_fwd, dim3(NWG), dim3(NTHR), LDS_BYTES, stream, p);
#else
#ifndef DIAG_NPH
#define DIAG_NPH 11
#endif
#ifndef DIAG_REP_MASK
#define DIAG_REP_MASK 0
#endif
#ifndef DIAG_REP_FLAGS
#define DIAG_REP_FLAGS 1
#endif
    for (int k = 0; k < DIAG_NPH; ++k) { p.ph_lo = k; p.ph_hi = k + 1;
        if (((DIAG_REP_MASK >> k) & 1) && (DIAG_REP_FLAGS & ~31)) { p.flags = DIAG_REP_FLAGS; hipLaunchKernelGGL(mk_fwd, dim3(NWG), dim3(NTHR), LDS_BYTES, stream, p); }
        p.flags = 0; hipLaunchKernelGGL(mk_fwd, dim3(NWG), dim3(NTHR), LDS_BYTES, stream, p);
        if (((DIAG_REP_MASK >> k) & 1) && !(DIAG_REP_FLAGS & ~31)) { p.flags = DIAG_REP_FLAGS; hipLaunchKernelGGL(mk_fwd, dim3(NWG), dim3(NTHR), LDS_BYTES, stream, p); } }
#ifdef DIAG_DUMP
    hipLaunchKernelGGL(dump_bf16, dim3(2048), dim3(256), 0, stream, (const bf16_t*)((unsigned char*)d_ws + DIAG_DUMP), (float*)d_out, (size_t)NTOK * 1024);
#endif
#endif
}
```

```cpp
#include <hip/hip_runtime.h>
#include <cstdio>
#include <cstdint>

#ifndef MK_ONE_LAUNCH
#define MK_ONE_LAUNCH 1
#endif

#define GAS __attribute__((address_space(1)))
#define LAS __attribute__((address_space(3)))
typedef unsigned short bf16_t;
typedef short bf16x8 __attribute__((ext_vector_type(8)));
typedef short bf16x4 __attribute__((ext_vector_type(4)));
typedef float f32x4 __attribute__((ext_vector_type(4)));
typedef float f32x2 __attribute__((ext_vector_type(2)));
typedef unsigned u32x4 __attribute__((ext_vector_type(4)));
typedef unsigned u32x2 __attribute__((ext_vector_type(2)));

constexpr int NTOK = 65536, DM = 1024, SEQ = 2048, NB = 32;
constexpr int NWG = 256, NTHR = 512;
constexpr float LN_EPS = 1e-5f, RMS_EPS = 1e-6f;
constexpr float ALPHA = 1.189207115002721f;
constexpr float QSCALE = 0.07216878364870322f * 1.4426950408889634f;
constexpr int NSLOT = 589824;

constexpr size_t MiB = 1u << 20;
constexpr size_t WS_CTL = 0, CTL_ZERO_BYTES = 3 * MiB;
constexpr size_t WS_BAR = 16384;
constexpr size_t WS_MOD = 1 * MiB;
constexpr size_t WS_CQSS = 2 * MiB, WS_CKVSS = 2 * MiB + 256 * 1024;
constexpr size_t WS_TAB = 3 * MiB;
constexpr size_t WS_CNTWG = 3 * MiB + 64 * 1024;
constexpr size_t WS_WIN = 4 * MiB;
constexpr size_t WS_WGLAO = WS_WIN + 6400 * 1024 * 2;
constexpr size_t WS_WUQ = WS_WGLAO + 2 * MiB;
constexpr size_t WS_WUKV = WS_WUQ + 1536 * 768 * 2;
constexpr size_t WS_WMLAO = WS_WUKV + 1 * MiB;
constexpr size_t WS_WOUT = WS_WMLAO + 2 * MiB;
constexpr size_t WS_WRT = WS_WOUT + 2 * MiB;
constexpr size_t WS_WS13 = WS_WRT + 512 * 1024;
constexpr size_t WS_WS2 = WS_WS13 + 1 * MiB;
static_assert(WS_WS2 + 512 * 1024 <= 28 * MiB, "small weights");
constexpr size_t WS_TIDX = 28 * MiB, WS_TW = 30 * MiB, WS_LRANK = 32 * MiB, WS_STOK = 34 * MiB, WS_SW = 37 * MiB;
constexpr size_t WS_WIN8 = 52 * MiB;
constexpr size_t WS_KR = 40 * MiB;
constexpr size_t WS_GA = 48 * MiB;
constexpr size_t WS_BIG0 = 56 * MiB, BIGU = 128 * MiB;
#define WS_BIG(i) (WS_BIG0 + (size_t)(i) * BIGU)
constexpr size_t WS_END = WS_BIG0 + 8 * BIGU;

typedef __bf16 bf16v2_t __attribute__((ext_vector_type(2)));
__device__ __forceinline__ unsigned pk2(float lo, float hi) { const f32x2 v = {lo, hi}; const bf16v2_t r = __builtin_convertvector(v, bf16v2_t); return __builtin_bit_cast(unsigned, r); }
__device__ __forceinline__ float bflo(unsigned w) { return __uint_as_float(w << 16); }
__device__ __forceinline__ float bfhi(unsigned w) { return __uint_as_float(w & 0xffff0000u); }
__device__ __forceinline__ float bf2f(bf16_t b) { return __uint_as_float(((unsigned)b) << 16); }
__device__ __forceinline__ bf16_t f2bf(float f) { return (bf16_t)(pk2(f, 0.f) & 0xffffu); }
__device__ __forceinline__ float sigm(float x) { return __builtin_amdgcn_rcpf(1.0f + __expf(-x)); }
__device__ __forceinline__ float silu(float x) { return x * __builtin_amdgcn_rcpf(1.0f + __expf(-x)); }
__device__ __forceinline__ float wave_sum(float v) {
#pragma unroll
    for (int o = 1; o < 64; o <<= 1) v += __shfl_xor(v, o);
    return v;
}
#define LDS_WAIT() asm volatile("s_waitcnt lgkmcnt(0)" ::: "memory")
#define VM_WAIT() asm volatile("s_waitcnt vmcnt(0)" ::: "memory")

#define XB_TMO      128
#define XB_XCNT(j)  (256  + 64 * (j))
#define XB_XSUB(j)  (1280 + 64 * (j))
#define XB_XGEN(j)  (2304 + 64 * (j))
#define XB_TOP      3328
#define XB_TOPGEN   3392
#define XCD_BAR_WORDS 3456
#define XB_SPIN_CAP (1u << 18)
__device__ __forceinline__ unsigned xb_ld(unsigned* p)              { return __hip_atomic_load(p, __ATOMIC_RELAXED, __HIP_MEMORY_SCOPE_AGENT); }
__device__ __forceinline__ unsigned xb_add(unsigned* p, unsigned v) { return __hip_atomic_fetch_add(p, v, __ATOMIC_RELAXED, __HIP_MEMORY_SCOPE_AGENT); }
__device__ __forceinline__ unsigned xb_xcc_id() { return (unsigned)__builtin_amdgcn_s_getreg((3 << 11) | 20) & 0xFu; }
#define XB_SPIN(cond, bar) do { unsigned _sp = 0; while (cond) { __builtin_amdgcn_s_sleep(1); \
    if ((++_sp & 255u) == 0u) { if (xb_ld(&(bar)[XB_TMO])) break; if (_sp > XB_SPIN_CAP) { atomicAdd(&(bar)[XB_TMO], 1u); break; } } } } while (0)
struct XcdBarrier { unsigned* bar; unsigned x; volatile LAS unsigned* st; };
__device__ __forceinline__ XcdBarrier xcd_barrier_post(unsigned* bar, volatile LAS unsigned* st) {
    XcdBarrier b; b.bar = bar; b.x = xb_xcc_id(); b.st = st;
    if (threadIdx.x == 0) (void)xb_add(&bar[XB_XCNT(b.x)], 1u);
    return b;
}
__device__ __forceinline__ void xcd_barrier_complete(unsigned* bar, unsigned x, unsigned& nloc, unsigned& nx) {
    const unsigned G = gridDim.x * gridDim.y * gridDim.z;
    unsigned sum, cnt, mine, sp = 0u;
    for (;;) {
        sum = 0u; cnt = 0u; mine = 0u;
#pragma unroll
        for (unsigned j = 0; j < 16; ++j) { const unsigned c = xb_ld(&bar[XB_XCNT(j)]); sum += c; cnt += (c > 0u) ? 1u : 0u; mine = (j == x) ? c : mine; }
        if (sum == G) break;
        __builtin_amdgcn_s_sleep(1);
        if ((++sp & 255u) == 0u) { if (xb_ld(&bar[XB_TMO])) break; if (sp > XB_SPIN_CAP) { atomicAdd(&bar[XB_TMO], 1u); break; } }
    }
    nloc = mine > 0u ? mine : 1u; nx = cnt > 0u ? cnt : 1u;
}
__device__ __forceinline__ void xcd_barrier(const XcdBarrier& b) {
    asm volatile("s_waitcnt vmcnt(0)" ::: "memory");
    __syncthreads();
    if (threadIdx.x == 0) {
        unsigned* bar = b.bar;
        __builtin_amdgcn_s_waitcnt(0);
        unsigned nloc = b.st[0], nx = b.st[1];
        if (nloc == 0u) { xcd_barrier_complete(bar, b.x, nloc, nx); b.st[0] = nloc; b.st[1] = nx; }
        const unsigned old = xb_add(&bar[XB_XSUB(b.x)], 1u);
        const unsigned gen = old / nloc;
        if (old + 1u == (gen + 1u) * nloc) {
            __builtin_amdgcn_fence(__ATOMIC_RELEASE, "agent");
            asm volatile("s_waitcnt vmcnt(0)" ::: "memory");
            const unsigned og = xb_add(&bar[XB_TOP], 1u);
            const unsigned tg = og / nx;
            if (og + 1u == (tg + 1u) * nx) xb_add(&bar[XB_TOPGEN], 1u);
            else XB_SPIN(xb_ld(&bar[XB_TOPGEN]) == tg, bar);
            __builtin_amdgcn_fence(__ATOMIC_ACQUIRE, "agent");
            xb_add(&bar[XB_XGEN(b.x)], 1u);
            asm volatile("s_waitcnt vmcnt(0)" ::: "memory");
        } else {
            XB_SPIN(xb_ld(&bar[XB_XGEN(b.x)]) == gen, bar);
            __builtin_amdgcn_fence(__ATOMIC_ACQUIRE, "agent");
            asm volatile("s_waitcnt vmcnt(0)" ::: "memory");
        }
    }
    __syncthreads();
}
__device__ __forceinline__ void wg_global_sync() {
    asm volatile("s_waitcnt vmcnt(0)" ::: "memory");
    __syncthreads();
    if (threadIdx.x < 64) {
        __builtin_amdgcn_fence(__ATOMIC_ACQUIRE, "agent");
        asm volatile("s_waitcnt vmcnt(0)" ::: "memory");
    }
    __syncthreads();
}

namespace pg8 {
constexpr int BM = 256, BK = 64, HALF = 128, HTB = HALF * BK * 2, STAGE_BYTES = 8 * HTB;
__host__ __device__ __forceinline__ int lds_byte(int r, int c) { const int st = (r >> 4) * 2 + (c >> 5), rr = r & 15, cc = c & 31, ob = rr * 64 + cc * 2; return st * 1024 + (ob ^ (((ob >> 9) & 1) << 5)); }
__host__ __device__ __forceinline__ void stage_rc(int b, int& R, int& C) { const int st = b / 1024, sb = b % 1024, swz = sb ^ (((sb >> 9) & 1) << 5); R = (st >> 1) * 16 + swz / 64; C = (st & 1) * 32 + (swz % 64) / 2; }
__host__ __device__ __forceinline__ int perm32(int rho) { const int n = rho >> 4, i = rho & 15; return 8 * (i >> 2) + 4 * n + (i & 3); }
struct Unit { int pm, pn; };
struct Gemm { const bf16_t* A; const bf16_t* Bt; int K; const int* rowidx; };
struct StaticOrder {
    int nM, nN, nwg, G, c, remap;
    __device__ void init(int M, int N, int G_, int c_) { nM = M / BM; nN = N / BM; nwg = nM * nN; G = G_; c = c_; remap = 0; }
    __device__ bool next(int i, Unit& u) const {
        const long L = (long)i * G + c; if (L >= nwg) return false;
        int wgid = (int)L; { const int q = nwg / 8, r = nwg % 8, xcd = wgid % 8, off = wgid / 8; wgid = (xcd < r ? xcd * (q + 1) : r * (q + 1) + (xcd - r) * q) + off; }
        const int nig = 8 * nN, gid = wgid / nig, fm = gid * 8, gsz = (nM - fm) < 8 ? (nM - fm) : 8;
        u.pm = fm + ((wgid % nig) % gsz); u.pn = (wgid % nig) / gsz; if (remap) u.pn = u.pn < 8 ? u.pn : u.pn < 12 ? u.pn + 4 : 24; return true;
    }
};
struct PanelOrder {
    int pm, nN, pn0;
    __device__ bool next(int i, Unit& u) const { int nq = nN; asm volatile("; opaque nN" : "+s"(nq)); if (i >= nq) return false; int a = pm, b = pn0 + i; asm volatile("; opaque unit" : "+s"(a), "+s"(b)); u.pm = a; u.pn = b; return true; }
};

typedef int i32x8 __attribute__((ext_vector_type(8)));
template <class Epi, class Sched, bool GATHER, bool FP8 = false>
__device__ __forceinline__ void gemm_phase(LAS unsigned char* lds, const Gemm g, const Sched& S, const Epi& E) {
    int tid_ = threadIdx.x; asm volatile("; pg8 ids" : "+v"(tid_));
    const int tid = tid_, wid = __builtin_amdgcn_readfirstlane(tid >> 6), lane = tid & 63, wr = wid >> 2, wc = wid & 3, fr = lane & 15, fq = lane >> 4;
    int Kq = g.K; asm volatile("; opaque K" : "+s"(Kq));
    const int K = Kq, nt = K / BK;
    Unit cur, nxt; int ui = 0;
    if (!S.next(0, cur)) return;
    unsigned aoff[2][2], voffB[2];
#pragma unroll
    for (int i = 0; i < 2; ++i) { int R, C; stage_rc(tid * 16 + i * 8192, R, C); const int Rb = Epi::PERM ? ((R & ~31) + perm32(R & 31)) : R;
        voffB[i] = (unsigned)(Rb * K + C) * 2u;
#pragma unroll
        for (int h = 0; h < 2; ++h) {
            if (GATHER) { int t = g.rowidx[cur.pm * BM + h * HALF + R]; t = t < 0 ? 0 : t; aoff[h][i] = (unsigned)(t * K + C) * 2u; }
            else aoff[h][i] = (unsigned)((h * HALF + R) * K + C) * 2u;
        } }
    const size_t kstep = (size_t)(BK * 2);
    const size_t hstep = (size_t)HALF * K * 2;
    const size_t tstep = 2 * hstep;
    const unsigned ldsw = (unsigned)wid * 1024u;
    const int aoffl0 = lds_byte(wr * 64 + fr, fq * 8), aoffl1 = aoffl0 + 1024;
    const int boffl0 = lds_byte(wc * 32 + fr, fq * 8), boffl1 = boffl0 + 1024;
#define PG8_SA(b, h) (((b) * 2 + (h)) * HTB)
#define PG8_SB(b, h) ((4 + (b) * 2 + (h)) * HTB)
#define PG8_STAGE(bufoff, gbase, voff) do { _Pragma("unroll") for (int _i = 0; _i < 2; ++_i) \
        __builtin_amdgcn_global_load_lds((const unsigned*)((const char*)(gbase) + (voff)[_i]), (LAS unsigned*)(lds + (bufoff) + ldsw + _i * 8192), 16, 0, 0); } while (0)
#define PG8_STAGE_A(bufoff, gbase, h) PG8_STAGE(bufoff, gbase, aoff[h])
#define PG8_LDA(dst, b, h) do { _Pragma("unroll") for (int m = 0; m < 4; ++m) _Pragma("unroll") for (int k = 0; k < 2; ++k) dst[m][k] = *(const LAS bf16x8*)(lds + PG8_SA(b, h) + aoffl0 + m * 2048 + k * 1024); } while (0)
#define PG8_LDA8(dst, b, h) do { _Pragma("unroll") for (int m = 0; m < 4; ++m) { const u32x4 x0_ = *(const LAS u32x4*)(lds + PG8_SA(b, h) + aoffl0 + m * 2048), x1_ = *(const LAS u32x4*)(lds + PG8_SA(b, h) + aoffl1 + m * 2048); dst[m] = __builtin_bit_cast(i32x8, __builtin_shufflevector(x0_, x1_, 0, 1, 2, 3, 4, 5, 6, 7)); } } while (0)
#define PG8_LDB(dst, b, h) do { _Pragma("unroll") for (int n = 0; n < 2; ++n) _Pragma("unroll") for (int k = 0; k < 2; ++k) dst[n][k] = *(const LAS bf16x8*)(lds + PG8_SB(b, h) + boffl0 + n * 2048 + k * 1024); } while (0)
#define PG8_LDB8(dst, b, h) do { _Pragma("unroll") for (int n = 0; n < 2; ++n) { const u32x4 x0_ = *(const LAS u32x4*)(lds + PG8_SB(b, h) + boffl0 + n * 2048), x1_ = *(const LAS u32x4*)(lds + PG8_SB(b, h) + boffl1 + n * 2048); dst[n] = __builtin_bit_cast(i32x8, __builtin_shufflevector(x0_, x1_, 0, 1, 2, 3, 4, 5, 6, 7)); } } while (0)
#define PG8_MMA(ai, bj, At, Bt) do { __builtin_amdgcn_s_setprio(1); _Pragma("unroll") for (int m = 0; m < 4; ++m) _Pragma("unroll") for (int n = 0; n < 2; ++n) _Pragma("unroll") for (int k = 0; k < 2; ++k) \
        acc[ai][bj][m][n] = __builtin_amdgcn_mfma_f32_16x16x32_bf16(Bt[n][k], At[m][k], acc[ai][bj][m][n], 0, 0, 0); __builtin_amdgcn_s_setprio(0); } while (0)
#define PG8_MMA8(ai, bj, At, Bt) do { __builtin_amdgcn_s_setprio(1); _Pragma("unroll") for (int m = 0; m < 4; ++m) _Pragma("unroll") for (int n = 0; n < 2; ++n) \
        asm volatile("v_mfma_f32_16x16x128_f8f6f4 %0, %1, %2, %0" : "+v"(acc[ai][bj][m][n]) : "v"(Bt[n]), "v"(At[m])); __builtin_amdgcn_s_setprio(0); } while (0)
#define PG8_WAIT_V(n) asm volatile("s_waitcnt vmcnt(" #n ")" ::: "memory")
#define PG8_WAIT_L(n) asm volatile("s_waitcnt lgkmcnt(" #n ")" ::: "memory")
#define PG8_BAR __builtin_amdgcn_s_barrier()
#define PG8_SCHED __builtin_amdgcn_sched_barrier(0)
    f32x4 acc[2][2][4][2];
#pragma unroll
    for (int a = 0; a < 2; ++a)
#pragma unroll
        for (int b = 0; b < 2; ++b)
#pragma unroll
            for (int m = 0; m < 4; ++m)
#pragma unroll
                for (int n = 0; n < 2; ++n) acc[a][b][m][n] = (f32x4){0.f, 0.f, 0.f, 0.f};
    bf16x8 At[4][2], B0[2][2], B1[2][2]; i32x8 At8[4], B08[2], B18[2];
    const char* cA = (const char*)g.A + (GATHER ? (size_t)0 : (size_t)cur.pm * tstep); const char* cB = (const char*)g.Bt + (size_t)cur.pn * tstep;
    if (GATHER) PG8_WAIT_V(0);
    PG8_STAGE(PG8_SB(0, 0), cB, voffB); PG8_STAGE_A(PG8_SA(0, 0), cA, 0); PG8_STAGE(PG8_SB(0, 1), cB + hstep, voffB); PG8_STAGE_A(PG8_SA(0, 1), cA, 1);
    if (wr == 1) PG8_BAR;
    PG8_WAIT_V(4); PG8_BAR;
    PG8_STAGE(PG8_SB(1, 0), cB + kstep, voffB); PG8_STAGE_A(PG8_SA(1, 0), cA + kstep, 0); PG8_STAGE(PG8_SB(1, 1), cB + hstep + kstep, voffB);
    PG8_WAIT_V(6); PG8_BAR;
    for (;;) {
        const bool has_next = S.next(ui + 1, nxt);
        const char* nA = has_next ? (const char*)g.A + (GATHER ? (size_t)0 : (size_t)nxt.pm * tstep) : cA; const char* nB = has_next ? (const char*)g.Bt + (size_t)nxt.pn * tstep : cB;
        for (int t = 0; t < nt; t += 2) {
            const bool last = (t == nt - 2);
            const char* a1 = cA + (size_t)(t + 1) * kstep;
            const char* a2 = last ? nA : cA + (size_t)(t + 2) * kstep; const char* b2 = last ? nB : cB + (size_t)(t + 2) * kstep;
            const char* a3 = a2 + kstep; const char* b3 = b2 + kstep;
            if constexpr (FP8) {
            PG8_LDB8(B08, 0, 0); PG8_SCHED; PG8_LDA8(At8, 0, 0); PG8_STAGE_A(PG8_SA(1, 1), a1, 1);
            PG8_WAIT_L(8); PG8_BAR; PG8_WAIT_L(0); PG8_MMA8(0, 0, At8, B08); PG8_BAR; PG8_SCHED;
            PG8_LDB8(B18, 0, 1); PG8_STAGE(PG8_SB(0, 0), b2, voffB);
            PG8_BAR; PG8_WAIT_L(0); PG8_MMA8(0, 1, At8, B18); PG8_BAR;
            PG8_LDA8(At8, 0, 1); PG8_STAGE_A(PG8_SA(0, 0), a2, 0);
            PG8_BAR; PG8_WAIT_L(0); PG8_MMA8(1, 0, At8, B08); PG8_BAR; PG8_SCHED;
            PG8_STAGE(PG8_SB(0, 1), b2 + hstep, voffB);
            PG8_WAIT_V(6); PG8_BAR; PG8_MMA8(1, 1, At8, B18); PG8_BAR;
            PG8_LDB8(B08, 1, 0); PG8_SCHED; PG8_LDA8(At8, 1, 0); PG8_STAGE_A(PG8_SA(0, 1), a2, 1);
            PG8_WAIT_L(8); PG8_BAR; PG8_WAIT_L(0); PG8_MMA8(0, 0, At8, B08); PG8_BAR; PG8_SCHED;
            PG8_LDB8(B18, 1, 1); PG8_STAGE(PG8_SB(1, 0), b3, voffB);
            PG8_BAR; PG8_WAIT_L(0); PG8_MMA8(0, 1, At8, B18); PG8_BAR;
            PG8_LDA8(At8, 1, 1); PG8_STAGE_A(PG8_SA(1, 0), a3, 0);
            PG8_BAR; PG8_WAIT_L(0); PG8_MMA8(1, 0, At8, B08); PG8_BAR; PG8_SCHED;
            PG8_STAGE(PG8_SB(1, 1), b3 + hstep, voffB);
            PG8_WAIT_V(6); PG8_BAR; PG8_MMA8(1, 1, At8, B18); PG8_BAR;
            } else {
            PG8_LDB(B0, 0, 0); PG8_SCHED; PG8_LDA(At, 0, 0); PG8_STAGE_A(PG8_SA(1, 1), a1, 1);
            PG8_WAIT_L(8); PG8_BAR; PG8_WAIT_L(0); PG8_MMA(0, 0, At, B0); PG8_BAR; PG8_SCHED;
            PG8_LDB(B1, 0, 1); PG8_STAGE(PG8_SB(0, 0), b2, voffB);
            PG8_BAR; PG8_WAIT_L(0); PG8_MMA(0, 1, At, B1); PG8_BAR;
            PG8_LDA(At, 0, 1); PG8_STAGE_A(PG8_SA(0, 0), a2, 0);
            PG8_BAR; PG8_WAIT_L(0); PG8_MMA(1, 0, At, B0); PG8_BAR; PG8_SCHED;
            PG8_STAGE(PG8_SB(0, 1), b2 + hstep, voffB);
            PG8_WAIT_V(6); PG8_BAR; PG8_MMA(1, 1, At, B1); PG8_BAR;
            PG8_LDB(B0, 1, 0); PG8_SCHED; PG8_LDA(At, 1, 0); PG8_STAGE_A(PG8_SA(0, 1), a2, 1);
            PG8_WAIT_L(8); PG8_BAR; PG8_WAIT_L(0); PG8_MMA(0, 0, At, B0); PG8_BAR; PG8_SCHED;
            PG8_LDB(B1, 1, 1); PG8_STAGE(PG8_SB(1, 0), b3, voffB);
            PG8_BAR; PG8_WAIT_L(0); PG8_MMA(0, 1, At, B1); PG8_BAR;
            PG8_LDA(At, 1, 1); PG8_STAGE_A(PG8_SA(1, 0), a3, 0);
            PG8_BAR; PG8_WAIT_L(0); PG8_MMA(1, 0, At, B0); PG8_BAR; PG8_SCHED;
            PG8_STAGE(PG8_SB(1, 1), b3 + hstep, voffB);
            PG8_WAIT_V(6); PG8_BAR; PG8_MMA(1, 1, At, B1); PG8_BAR;
            }
        }
        if constexpr (FP8) asm volatile("s_nop 15\n\ts_nop 15\n\ts_nop 15\n\ts_nop 15" ::: "memory");
        E(acc, cur, wr, wc, fr, fq);
        if (!has_next) break;
#pragma unroll
        for (int a = 0; a < 2; ++a)
#pragma unroll
            for (int b = 0; b < 2; ++b)
#pragma unroll
                for (int m = 0; m < 4; ++m)
#pragma unroll
                    for (int n = 0; n < 2; ++n) acc[a][b][m][n] = (f32x4){0.f, 0.f, 0.f, 0.f};
        cur = nxt; cA = nA; cB = nB; ++ui;
    }
    PG8_WAIT_V(0);
    if (wr == 0) PG8_BAR;
    PG8_BAR;
#undef PG8_SA
#undef PG8_SB
#undef PG8_STAGE
#undef PG8_STAGE_A
#undef PG8_LDA
#undef PG8_LDB
#undef PG8_MMA
#undef PG8_MMA8
#undef PG8_LDA8
#undef PG8_LDB8
#undef PG8_WAIT_V
#undef PG8_WAIT_L
#undef PG8_BAR
#undef PG8_SCHED
}
}
using pg8::Unit;
typedef f32x4 AccT[2][2][4][2];

typedef float f32x16 __attribute__((ext_vector_type(16)));
#ifndef K256_DIST
#define K256_DIST 2
#endif
constexpr int K256_BUF = 32768, K256_NB = 3, K256_SCR_OFF = K256_NB * K256_BUF, K256_SCR_WAVE = 4608;
struct K256Store {
    bf16_t* O; int ld; const float* rs; float rs_mul; bf16_t* O2; int split; int fp8;
};
constexpr float F8_SCALE = 16.0f;
__device__ __forceinline__ void gemm_k256(LAS unsigned char* lds, const bf16_t* A, const bf16_t* Bt, int nchunks, int row0, const K256Store& E) {
    int tid_ = threadIdx.x; asm volatile("; k256 ids" : "+v"(tid_));
    const int tid = tid_, lane = tid & 63, wave = __builtin_amdgcn_readfirstlane(tid >> 6), r = lane & 31, h = lane >> 5;
    bf16x8 af[16];
    { const bf16_t* arow = A + (size_t)(32 * wave + r) * 256 + 8 * h;
#pragma unroll
      for (int s = 0; s < 16; ++s) af[s] = *(const bf16x8*)(arow + 16 * s); }
    float rscale = 1.0f;
    if (E.rs) rscale = rsqrtf(E.rs[row0 + 32 * wave + r] * E.rs_mul + RMS_EPS);
    unsigned foff[4];
#pragma unroll
    for (int q = 0; q < 4; ++q) { const int n = 2 * (4 * wave + q) + (lane >> 5); foff[q] = (unsigned)(n * 256 + (((lane & 31) ^ (n & 15)) << 3)) * 2u; }
#define K256_FILL(chunk, buf) do { const char* _src = (const char*)Bt + (size_t)(chunk) * (64 * 256 * 2); _Pragma("unroll") for (int q = 0; q < 4; ++q) \
        __builtin_amdgcn_global_load_lds((const unsigned*)(_src + foff[q]), (LAS unsigned*)(lds + (buf) * K256_BUF + (4 * wave + q) * 1024), 16, 0, 0); } while (0)
    K256_FILL(0, 0);
    if (K256_DIST == 2 && nchunks > 1) K256_FILL(1, 1);
    const int boff = (r * 32) * 16;
    LAS unsigned char* scr = lds + K256_SCR_OFF + wave * K256_SCR_WAVE;
    for (int i = 0; i < nchunks; ++i) {
        {
            const int ns = E.fp8 ? 2 : 4;
            const int yo = K256_DIST == 2 ? ns * ((i >= 2 ? 1 : 0) + (i >= 1 ? 1 : 0)) + (i + 1 < nchunks ? 4 : 0) : ns * (i >= 1 ? 1 : 0);
            if (yo >= 12) asm volatile("s_waitcnt vmcnt(12)" ::: "memory"); else if (yo >= 8) asm volatile("s_waitcnt vmcnt(8)" ::: "memory");
            else if (yo >= 6) asm volatile("s_waitcnt vmcnt(6)" ::: "memory"); else if (yo >= 4) asm volatile("s_waitcnt vmcnt(4)" ::: "memory");
            else if (yo >= 2) asm volatile("s_waitcnt vmcnt(2)" ::: "memory"); else asm volatile("s_waitcnt vmcnt(0)" ::: "memory");
        }
        __builtin_amdgcn_s_barrier(); asm volatile("" ::: "memory");
        if (i + K256_DIST < nchunks) K256_FILL(i + K256_DIST, (i + K256_DIST) % K256_NB);
        const LAS unsigned char* bb = lds + (i % K256_NB) * K256_BUF + boff;
        f32x16 acc0, acc1;
#pragma unroll
        for (int j = 0; j < 16; ++j) { acc0[j] = 0.f; acc1[j] = 0.f; }
        {
            bf16x8 bq[3][2];
#define K256_LDB(s_) do { const int co_ = (((2 * (s_) + h) ^ (r & 15)) << 4); bq[(s_) % 3][0] = *(const LAS bf16x8*)(bb + co_); bq[(s_) % 3][1] = *(const LAS bf16x8*)(bb + 32 * 512 + co_); } while (0)
            K256_LDB(0); K256_LDB(1);
#pragma unroll
            for (int s = 0; s < 16; ++s) {
                if (s + 2 < 16) K256_LDB(s + 2);
                acc0 = __builtin_amdgcn_mfma_f32_32x32x16_bf16(bq[s % 3][0], af[s], acc0, 0, 0, 0);
                acc1 = __builtin_amdgcn_mfma_f32_32x32x16_bf16(bq[s % 3][1], af[s], acc1, 0, 0, 0);
            }
            __builtin_amdgcn_sched_group_barrier(0x100, 4, 0);
#pragma unroll
            for (int s = 0; s < 16; ++s) { if (s + 2 < 16) __builtin_amdgcn_sched_group_barrier(0x100, 2, 0); __builtin_amdgcn_sched_group_barrier(0x008, 2, 0); }
#undef K256_LDB
        }
        if (E.fp8) {
#pragma unroll
            for (int g = 0; g < 4; ++g) {
                unsigned d0 = 0u, d1 = 0u;
                d0 = __builtin_amdgcn_cvt_pk_fp8_f32(acc0[4 * g] * F8_SCALE, acc0[4 * g + 1] * F8_SCALE, d0, false); d0 = __builtin_amdgcn_cvt_pk_fp8_f32(acc0[4 * g + 2] * F8_SCALE, acc0[4 * g + 3] * F8_SCALE, d0, true);
                d1 = __builtin_amdgcn_cvt_pk_fp8_f32(acc1[4 * g] * F8_SCALE, acc1[4 * g + 1] * F8_SCALE, d1, false); d1 = __builtin_amdgcn_cvt_pk_fp8_f32(acc1[4 * g + 2] * F8_SCALE, acc1[4 * g + 3] * F8_SCALE, d1, true);
                *(LAS unsigned*)(scr + r * 80 + 8 * g + 4 * h) = d0; *(LAS unsigned*)(scr + r * 80 + 32 + 8 * g + 4 * h) = d1;
            }
            asm volatile("s_waitcnt lgkmcnt(0)" ::: "memory");
            unsigned char* ob8 = (unsigned char*)E.O;
#pragma unroll
            for (int pq = 0; pq < 2; ++pq) { const int rr = (lane >> 2) + 16 * pq;
                const u32x4 v = *(const LAS u32x4*)(scr + rr * 80 + (lane & 3) * 16);
                __builtin_nontemporal_store(v, (u32x4*)(ob8 + (size_t)(row0 + 32 * wave + rr) * E.ld + i * 64 + (lane & 3) * 16)); }
        } else {
#pragma unroll
        for (int g = 0; g < 4; ++g) {
            u32x2 w0, w1;
            w0.x = pk2(acc0[4 * g] * rscale, acc0[4 * g + 1] * rscale); w0.y = pk2(acc0[4 * g + 2] * rscale, acc0[4 * g + 3] * rscale);
            w1.x = pk2(acc1[4 * g] * rscale, acc1[4 * g + 1] * rscale); w1.y = pk2(acc1[4 * g + 2] * rscale, acc1[4 * g + 3] * rscale);
            *(LAS u32x2*)(scr + r * 144 + (8 * g + 4 * h) * 2) = w0; *(LAS u32x2*)(scr + r * 144 + 64 + (8 * g + 4 * h) * 2) = w1;
        }
        asm volatile("s_waitcnt lgkmcnt(0)" ::: "memory");
        int col = i * 64 + (lane & 7) * 8; bf16_t* ob = E.O;
        if (E.O2 && col >= E.split) { col -= E.split; ob = E.O2; }
#pragma unroll
        for (int pq = 0; pq < 4; ++pq) { const int rr = (lane >> 3) + 8 * pq;
            const u32x4 v = *(const LAS u32x4*)(scr + rr * 144 + (lane & 7) * 16);
            *(u32x4*)(ob + (size_t)(row0 + 32 * wave + rr) * E.ld + col) = v; }
        }
    }
#undef K256_FILL
    asm volatile("s_waitcnt vmcnt(0) lgkmcnt(0)" ::: "memory");
    __builtin_amdgcn_s_barrier(); asm volatile("" ::: "memory");
}


typedef int i32x8k __attribute__((ext_vector_type(8)));
constexpr int K8_BUF = 16384, K8_SCR_OFF = 3 * K8_BUF;
__device__ __forceinline__ void gemm_k256_f8(LAS unsigned char* lds, const unsigned char* A8, const unsigned char* Bt8, int nchunks, int row0, unsigned char* O8, int ld, float oscale) {
    int tid_ = threadIdx.x; asm volatile("; k256f8 ids" : "+v"(tid_));
    const int tid = tid_, lane = tid & 63, wave = __builtin_amdgcn_readfirstlane(tid >> 6), r = lane & 31, h = lane >> 5;
    i32x8k af[4];
    { const unsigned char* arow = A8 + (size_t)(32 * wave + r) * 256 + 32 * h;
#pragma unroll
      for (int s = 0; s < 4; ++s) { const u32x4 x0 = *(const u32x4*)(arow + 64 * s), x1 = *(const u32x4*)(arow + 64 * s + 16); af[s] = __builtin_bit_cast(i32x8k, __builtin_shufflevector(x0, x1, 0, 1, 2, 3, 4, 5, 6, 7)); } }
    unsigned foff[2];
#pragma unroll
    for (int q = 0; q < 2; ++q) { const int n = 4 * (2 * wave + q) + (lane >> 4); foff[q] = (unsigned)(n * 256 + (((lane & 15) ^ (n & 15)) << 4)); }
#define K8_FILL(chunk, buf) do { const unsigned char* _src = Bt8 + (size_t)(chunk) * (64 * 256); _Pragma("unroll") for (int q = 0; q < 2; ++q) \
        __builtin_amdgcn_global_load_lds((const unsigned*)(_src + foff[q]), (LAS unsigned*)(lds + (buf) * K8_BUF + (2 * wave + q) * 1024), 16, 0, 0); } while (0)
    K8_FILL(0, 0);
    if (nchunks > 1) K8_FILL(1, 1);
    LAS unsigned char* scr = lds + K8_SCR_OFF + wave * 2560;
    const float osc = F8_SCALE * oscale;
    for (int i = 0; i < nchunks; ++i) {
        {
            const int yo = 2 * ((i >= 2 ? 1 : 0) + (i >= 1 ? 1 : 0) + (i + 1 < nchunks ? 1 : 0));
            if (yo >= 6) asm volatile("s_waitcnt vmcnt(6)" ::: "memory"); else if (yo >= 4) asm volatile("s_waitcnt vmcnt(4)" ::: "memory");
            else if (yo >= 2) asm volatile("s_waitcnt vmcnt(2)" ::: "memory"); else asm volatile("s_waitcnt vmcnt(0)" ::: "memory");
        }
        __builtin_amdgcn_s_barrier(); asm volatile("" ::: "memory");
        if (i + 2 < nchunks) K8_FILL(i + 2, (i + 2) % 3);
        const LAS unsigned char* bb = lds + (i % 3) * K8_BUF + r * 256;
        f32x16 acc0, acc1;
#pragma unroll
        for (int j = 0; j < 16; ++j) { acc0[j] = 0.f; acc1[j] = 0.f; }
        i32x8k b0[4], b1[4];
#pragma unroll
        for (int s = 0; s < 4; ++s) {
            const int c0 = ((4 * s + 2 * h) ^ (r & 15)) << 4, c1 = ((4 * s + 2 * h + 1) ^ (r & 15)) << 4;
            const u32x4 p0 = *(const LAS u32x4*)(bb + c0), p1 = *(const LAS u32x4*)(bb + c1), q0 = *(const LAS u32x4*)(bb + 32 * 256 + c0), q1 = *(const LAS u32x4*)(bb + 32 * 256 + c1);
            b0[s] = __builtin_bit_cast(i32x8k, __builtin_shufflevector(p0, p1, 0, 1, 2, 3, 4, 5, 6, 7)); b1[s] = __builtin_bit_cast(i32x8k, __builtin_shufflevector(q0, q1, 0, 1, 2, 3, 4, 5, 6, 7));
        }
#pragma unroll
        for (int s = 0; s < 4; ++s) {
            acc0 = __builtin_amdgcn_mfma_scale_f32_32x32x64_f8f6f4(b0[s], af[s], acc0, 0, 0, 0, 0, 0, 0);
            acc1 = __builtin_amdgcn_mfma_scale_f32_32x32x64_f8f6f4(b1[s], af[s], acc1, 0, 0, 0, 0, 0, 0);
        }
#pragma unroll
        for (int g = 0; g < 4; ++g) {
            unsigned d0 = 0u, d1 = 0u;
            d0 = __builtin_amdgcn_cvt_pk_fp8_f32(acc0[4 * g] * osc, acc0[4 * g + 1] * osc, d0, false); d0 = __builtin_amdgcn_cvt_pk_fp8_f32(acc0[4 * g + 2] * osc, acc0[4 * g + 3] * osc, d0, true);
            d1 = __builtin_amdgcn_cvt_pk_fp8_f32(acc1[4 * g] * osc, acc1[4 * g + 1] * osc, d1, false); d1 = __builtin_amdgcn_cvt_pk_fp8_f32(acc1[4 * g + 2] * osc, acc1[4 * g + 3] * osc, d1, true);
            *(LAS unsigned*)(scr + r * 80 + 8 * g + 4 * h) = d0; *(LAS unsigned*)(scr + r * 80 + 32 + 8 * g + 4 * h) = d1;
        }
        asm volatile("s_waitcnt lgkmcnt(0)" ::: "memory");
#pragma unroll
        for (int pq = 0; pq < 2; ++pq) { const int rr = (lane >> 2) + 16 * pq;
            const u32x4 v = *(const LAS u32x4*)(scr + rr * 80 + (lane & 3) * 16);
            __builtin_nontemporal_store(v, (u32x4*)(O8 + (size_t)(row0 + 32 * wave + rr) * ld + i * 64 + (lane & 3) * 16)); }
    }
#undef K8_FILL
    asm volatile("s_waitcnt vmcnt(0) lgkmcnt(0)" ::: "memory");
    __builtin_amdgcn_s_barrier(); asm volatile("" ::: "memory");
}

__device__ __forceinline__ u32x4 pack8(const f32x4 a, const f32x4 b) { u32x4 w; w.x = pk2(a[0], a[1]); w.y = pk2(a[2], a[3]); w.z = pk2(b[0], b[1]); w.w = pk2(b[2], b[3]); return w; }
__device__ __forceinline__ void unpack8(const u32x4 w, f32x4& a, f32x4& b) { a = (f32x4){bflo(w.x), bfhi(w.x), bflo(w.y), bfhi(w.y)}; b = (f32x4){bflo(w.z), bfhi(w.z), bflo(w.w), bfhi(w.w)}; }

struct EpiWin {
    static constexpr bool PERM = true;
    bf16_t *q, *k, *v, *gr, *cq, *ckv, *sa, *sb, *kr; float* ga; const float* rope; int f8; float ascale;
    __device__ __forceinline__ void operator()(const AccT& acc, const Unit& u, int wr, int wc, int fr, int fq) const {
        const int pn = f8 ? (u.pn < 4 ? 8 + u.pn : 12 + u.pn) : u.pn, row0 = u.pm * 256 + wr * 64 + fr, lc0 = wc * 32 + 8 * fq;
        if (pn < 24) {
            bf16_t* dst; int ld, cb, mode = 0;
            if (pn < 2) { dst = q; ld = 512; cb = pn * 256; mode = 1; }
            else if (pn < 4) { dst = k; ld = 512; cb = (pn - 2) * 256; }
            else if (pn < 8) { dst = v; ld = 1024; cb = (pn - 4) * 256; }
            else if (pn < 12) { dst = gr; ld = 1024; cb = (pn - 8) * 256; mode = 2; }
            else if (pn < 15) { dst = cq; ld = 768; cb = (pn - 12) * 256; }
            else if (pn < 16) { dst = ckv; ld = 256; cb = 0; }
            else if (pn < 20) { dst = sa; ld = 512; cb = (pn - 16) * 128; mode = 3; }
            else { dst = sb; ld = 512; cb = (pn - 20) * 128; mode = 3; }
#pragma unroll
            for (int ai = 0; ai < 2; ++ai)
#pragma unroll
                for (int m = 0; m < 4; ++m) {
                    const int row = row0 + ai * 128 + m * 16;
#pragma unroll
                    for (int bj = 0; bj < 2; ++bj) {
                        f32x4 v0 = acc[ai][bj][m][0] * ascale, v1 = acc[ai][bj][m][1] * ascale;
                        if (mode == 1) { v0 *= 0.08838834764831845f; v1 *= 0.08838834764831845f; }
                        else if (mode == 2) {
#pragma unroll
                            for (int j = 0; j < 4; ++j) { v0[j] = silu(v0[j]); v1[j] = silu(v1[j]); } }
                        else if (mode == 3) {
#pragma unroll
                            for (int j = 0; j < 4; ++j) { v0[j] = sigm(v0[j]); v1[j] = sigm(v1[j]); } }
                        if (mode == 3) {
                            unsigned d0 = 0u, d1 = 0u;
#pragma unroll
                            for (int j = 0; j < 4; ++j) { d0 = __builtin_amdgcn_cvt_pk_u8_f32(v0[j] * 255.0f, j, d0); d1 = __builtin_amdgcn_cvt_pk_u8_f32(v1[j] * 255.0f, j, d1); }
                            *(u32x2*)((unsigned char*)dst + (size_t)row * 1024 + (size_t)cb * 2 + bj * 128 + lc0) = (u32x2){d0, d1};
                        } else
                        *(u32x4*)(dst + (size_t)row * ld + cb + bj * 128 + lc0) = pack8(v0, v1);
                    }
                }
        } else {
#pragma unroll
            for (int ai = 0; ai < 2; ++ai)
#pragma unroll
                for (int m = 0; m < 4; ++m) {
                    const int row = row0 + ai * 128 + m * 16;
#pragma unroll
                    for (int bj = 0; bj < 2; ++bj) {
                        const int col = bj * 128 + lc0; const f32x4 v0 = acc[ai][bj][m][0], v1 = acc[ai][bj][m][1];
                        if (col < 64) {
                            const int j = col >> 3;
                            const f32x4 cs = *(const f32x4*)(rope + (size_t)row * 64 + 4 * j), sn = *(const f32x4*)(rope + (size_t)row * 64 + 32 + 4 * j);
                            const f32x4 o1 = v0 * cs - v1 * sn, o2 = v1 * cs + v0 * sn;
                            u32x2 w1, w2; w1.x = pk2(o1[0], o1[1]); w1.y = pk2(o1[2], o1[3]); w2.x = pk2(o2[0], o2[1]); w2.y = pk2(o2[2], o2[3]);
                            *(u32x2*)(kr + (size_t)row * 64 + 4 * j) = w1; *(u32x2*)(kr + (size_t)row * 64 + 32 + 4 * j) = w2;
                        } else if (col < 80) {
                            *(f32x4*)(ga + (size_t)row * 16 + (col - 64)) = v0; *(f32x4*)(ga + (size_t)row * 16 + (col - 64) + 4) = v1;
                        }
                    }
                }
        }
    }
};
struct EpiQF {
    static constexpr bool PERM = true;
    bf16_t* qm; const float* cq_ss; const float* rope;
    __device__ __forceinline__ void operator()(const AccT& acc, const Unit& u, int wr, int wc, int fr, int fq) const {
        const int row0 = u.pm * 256 + wr * 64 + fr, lc0 = wc * 32 + 8 * fq;
        int colb[2], headb[2], jb[2]; bool ropeb[2];
#pragma unroll
        for (int bj = 0; bj < 2; ++bj) { colb[bj] = u.pn * 256 + bj * 128 + lc0; headb[bj] = colb[bj] / 192; const int within = colb[bj] - headb[bj] * 192; ropeb[bj] = within >= 128; jb[bj] = ropeb[bj] ? (within - 128) >> 3 : 0; }
#pragma unroll
        for (int ai = 0; ai < 2; ++ai) {
            float rsv[4]; f32x4 cs[4][2], sn[4][2];
#pragma unroll
            for (int m = 0; m < 4; ++m) { const int row = row0 + ai * 128 + m * 16; rsv[m] = cq_ss[row];
#pragma unroll
                for (int bj = 0; bj < 2; ++bj) if (ropeb[bj]) { cs[m][bj] = *(const f32x4*)(rope + (size_t)row * 64 + 4 * jb[bj]); sn[m][bj] = *(const f32x4*)(rope + (size_t)row * 64 + 32 + 4 * jb[bj]); } }
#pragma unroll
            for (int m = 0; m < 4; ++m) {
                const int row = row0 + ai * 128 + m * 16;
                const float rs = rsqrtf(rsv[m] * (1.0f / 768.0f) + RMS_EPS) * QSCALE;
#pragma unroll
                for (int bj = 0; bj < 2; ++bj) {
                    const f32x4 v0 = acc[ai][bj][m][0] * rs, v1 = acc[ai][bj][m][1] * rs;
                    if (!ropeb[bj]) *(u32x4*)(qm + (size_t)row * 1536 + colb[bj]) = pack8(v0, v1);
                    else {
                        const f32x4 o1 = v0 * cs[m][bj] - v1 * sn[m][bj], o2 = v1 * cs[m][bj] + v0 * sn[m][bj];
                        u32x2 w1, w2; w1.x = pk2(o1[0], o1[1]); w1.y = pk2(o1[2], o1[3]); w2.x = pk2(o2[0], o2[1]); w2.y = pk2(o2[2], o2[3]);
                        bf16_t* p = qm + (size_t)row * 1536 + headb[bj] * 192 + 128 + 4 * jb[bj];
                        *(u32x2*)p = w1; *(u32x2*)(p + 32) = w2;
                    }
                }
            }
        }
    }
};
struct EpiKV {
    static constexpr bool PERM = true;
    bf16_t *kn, *vm; const float* ckv_ss;
    __device__ __forceinline__ void operator()(const AccT& acc, const Unit& u, int wr, int wc, int fr, int fq) const {
        const int row0 = u.pm * 256 + wr * 64 + fr, lc0 = wc * 32 + 8 * fq;
        bf16_t* dst = u.pn < 4 ? kn : vm; const int cb = (u.pn & 3) * 256;
#pragma unroll
        for (int ai = 0; ai < 2; ++ai)
#pragma unroll
            for (int m = 0; m < 4; ++m) {
                const int row = row0 + ai * 128 + m * 16;
                const float rs = rsqrtf(ckv_ss[row] * (1.0f / 256.0f) + RMS_EPS);
#pragma unroll
                for (int bj = 0; bj < 2; ++bj)
                    *(u32x4*)(dst + (size_t)row * 1024 + cb + bj * 128 + lc0) = pack8(acc[ai][bj][m][0] * rs, acc[ai][bj][m][1] * rs);
            }
    }
};
template <bool ADD> struct EpiGate {
    static constexpr bool PERM = true;
    bf16_t* Y; const unsigned char* gate;
    __device__ __forceinline__ void operator()(const AccT& acc, const Unit& u, int wr, int wc, int fr, int fq) const {
        const int row0 = u.pm * 256 + wr * 64 + fr, lc0 = u.pn * 256 + wc * 32 + 8 * fq;
#pragma unroll
        for (int ai = 0; ai < 2; ++ai) {
            u32x2 gq[4][2]; u32x4 yq[4][2];
#pragma unroll
            for (int m = 0; m < 4; ++m)
#pragma unroll
                for (int bj = 0; bj < 2; ++bj) { const size_t o = (size_t)(row0 + ai * 128 + m * 16) * 1024 + lc0 + bj * 128; gq[m][bj] = *(const u32x2*)(gate + o); if (ADD) yq[m][bj] = *(const u32x4*)(Y + o); }
#pragma unroll
            for (int m = 0; m < 4; ++m)
#pragma unroll
                for (int bj = 0; bj < 2; ++bj) {
                    const size_t o = (size_t)(row0 + ai * 128 + m * 16) * 1024 + lc0 + bj * 128;
                    const unsigned ga_ = gq[m][bj].x, gb_ = gq[m][bj].y; const float k255 = 1.0f / 255.0f;
                    const f32x4 g0 = (f32x4){(float)(ga_ & 255u), (float)((ga_ >> 8) & 255u), (float)((ga_ >> 16) & 255u), (float)(ga_ >> 24)} * k255;
                    const f32x4 g1 = (f32x4){(float)(gb_ & 255u), (float)((gb_ >> 8) & 255u), (float)((gb_ >> 16) & 255u), (float)(gb_ >> 24)} * k255;
                    f32x4 v0 = acc[ai][bj][m][0] * g0, v1 = acc[ai][bj][m][1] * g1;
                    if (ADD) { f32x4 y0, y1; unpack8(yq[m][bj], y0, y1); v0 += y0; v1 += y1; }
                    *(u32x4*)(Y + o) = pack8(v0, v1);
                }
        }
    }
};
struct EpiZ {
    static constexpr bool PERM = false;
    float* z; const float* x; const float* mod;
    __device__ __forceinline__ void operator()(const AccT& acc, const Unit& u, int wr, int wc, int fr, int fq) const {
        const int row0 = u.pm * 256 + wr * 64 + fr, col0 = u.pn * 256 + wc * 32 + 4 * fq;
        const float* g = mod + (size_t)(u.pm >> 3) * 6144 + 2048;
        f32x4 gv[2][2];
#pragma unroll
        for (int bj = 0; bj < 2; ++bj)
#pragma unroll
            for (int n = 0; n < 2; ++n) gv[bj][n] = *(const f32x4*)(g + col0 + bj * 128 + n * 16) + 1.0f;
#pragma unroll
        for (int ai = 0; ai < 2; ++ai)
#pragma unroll
            for (int m = 0; m < 4; ++m) {
                const size_t ro = (size_t)(row0 + ai * 128 + m * 16) * 1024 + col0;
#pragma unroll
                for (int bj = 0; bj < 2; ++bj)
#pragma unroll
                    for (int n = 0; n < 2; ++n) { const size_t o = ro + bj * 128 + n * 16; *(f32x4*)(z + o) = *(const f32x4*)(x + o) * ALPHA + gv[bj][n] * acc[ai][bj][m][n]; }
            }
    }
};
struct EpiF32 {
    static constexpr bool PERM = false;
    float* C; int ldc;
    __device__ __forceinline__ void operator()(const AccT& acc, const Unit& u, int wr, int wc, int fr, int fq) const {
        const int row0 = u.pm * 256 + wr * 64 + fr, col0 = u.pn * 256 + wc * 32 + 4 * fq;
#pragma unroll
        for (int ai = 0; ai < 2; ++ai)
#pragma unroll
            for (int m = 0; m < 4; ++m) { float* rowp = C + (size_t)(row0 + ai * 128 + m * 16) * ldc + col0;
#pragma unroll
                for (int bj = 0; bj < 2; ++bj)
#pragma unroll
                    for (int n = 0; n < 2; ++n) *(f32x4*)(rowp + bj * 128 + n * 16) = acc[ai][bj][m][n]; }
    }
};
struct EpiGLU {
    static constexpr bool PERM = true;
    bf16_t* hid; float scale; int f8;
    __device__ __forceinline__ void operator()(const AccT& acc, const Unit& u, int wr, int wc, int fr, int fq) const {
        const int row0 = u.pm * 256 + wr * 64 + fr, lc0 = u.pn * 256 + wc * 32 + 8 * fq;
#pragma unroll
        for (int ai = 0; ai < 2; ++ai)
#pragma unroll
            for (int m = 0; m < 4; ++m) {
                const int row = row0 + ai * 128 + m * 16;
#pragma unroll
                for (int bj = 0; bj < 2; ++bj) {
                    const f32x4 gg = acc[ai][bj][m][0] * scale, uu = acc[ai][bj][m][1] * scale;
                    const float h0 = silu(gg[0]) * uu[0], h1 = silu(gg[1]) * uu[1], h2_ = silu(gg[2]) * uu[2], h3 = silu(gg[3]) * uu[3];
                    if (f8) { unsigned d = 0u; d = __builtin_amdgcn_cvt_pk_fp8_f32(h0, h1, d, false); d = __builtin_amdgcn_cvt_pk_fp8_f32(h2_, h3, d, true);
                        *(unsigned*)((unsigned char*)hid + (size_t)row * 256 + ((lc0 + bj * 128) >> 1)) = d; }
                    else { u32x2 w; w.x = pk2(h0, h1); w.y = pk2(h2_, h3); *(u32x2*)(hid + (size_t)row * 256 + ((lc0 + bj * 128) >> 1)) = w; }
                }
            }
    }
};
struct EpiBf16 {
    static constexpr bool PERM = true;
    bf16_t* O; int ld;
    __device__ __forceinline__ void operator()(const AccT& acc, const Unit& u, int wr, int wc, int fr, int fq) const {
        const int row0 = u.pm * 256 + wr * 64 + fr, lc0 = u.pn * 256 + wc * 32 + 8 * fq;
#pragma unroll
        for (int ai = 0; ai < 2; ++ai)
#pragma unroll
            for (int m = 0; m < 4; ++m) {
                const int row = row0 + ai * 128 + m * 16;
#pragma unroll
                for (int bj = 0; bj < 2; ++bj) *(u32x4*)(O + (size_t)row * ld + lc0 + bj * 128) = pack8(acc[ai][bj][m][0], acc[ai][bj][m][1]);
            }
    }
};
typedef __bf16 bf16v2 __attribute__((ext_vector_type(2)));
__device__ __forceinline__ void atom_pk_bf16(bf16_t* p, unsigned w) {
    asm volatile("global_atomic_pk_add_bf16 %0, %1, off" :: "v"(p), "v"(w) : "memory");
}
struct EpiAtom {
    static constexpr bool PERM = true;
    bf16_t* accb; const int* slot_tok; const float* slot_w;
    __device__ __forceinline__ void operator()(const AccT& acc, const Unit& u, int wr, int wc, int fr, int fq) const {
        const int row0 = u.pm * 256 + wr * 64 + fr, lc0 = u.pn * 256 + wc * 32 + 8 * fq;
#pragma unroll
        for (int ai = 0; ai < 2; ++ai)
#pragma unroll
            for (int m = 0; m < 4; ++m) {
                const int slot = row0 + ai * 128 + m * 16;
                const int tok = slot_tok[slot];
                if (tok >= 0) {
                    const float w = slot_w[slot];
#pragma unroll
                    for (int bj = 0; bj < 2; ++bj) {
                        const u32x4 pw = pack8(acc[ai][bj][m][0] * w, acc[ai][bj][m][1] * w);
                        bf16_t* p = accb + (size_t)tok * 1024 + lc0 + bj * 128;
                        atom_pk_bf16(p, pw.x); atom_pk_bf16(p + 2, pw.y); atom_pk_bf16(p + 4, pw.z); atom_pk_bf16(p + 6, pw.w);
                    }
                }
            }
    }
};

struct Params { const float* in[28]; float* out; unsigned char* ws; int ph_lo, ph_hi, flags, pad; };
enum { I_X = 0, I_C, I_POS, I_WADA, I_BADA, I_WIN, I_WGA2, I_BGA, I_GGN, I_WGLAO, I_GCQ, I_WUQ, I_GCKV, I_WUKV, I_WMLAO, I_WOUT, I_LN1G, I_LN1B, I_WRT, I_BRT, I_WE1, I_WE3, I_WE2, I_WS1, I_WS3, I_WS2, I_LN2G, I_LN2B };
constexpr int LDS_STAGE = 131072, LDS_BYTES = 147456, LDS_MISC = LDS_BYTES - 2048;

template <class Map>
__device__ __forceinline__ void tr_item(const float* W, int K, int Nsrc, bf16_t* WT, const Map& map, const float* kscale, LAS unsigned* scr, int kb, int nb, int lane) {
    const int k0 = 64 * kb, n0 = 64 * nb;
    const int sc = map(n0 + lane);
#pragma unroll 8
    for (int kp = 0; kp < 32; ++kp) {
        float a = 0.f, b = 0.f;
        if (sc >= 0) { a = W[(size_t)(k0 + 2 * kp) * Nsrc + sc]; b = W[(size_t)(k0 + 2 * kp + 1) * Nsrc + sc]; }
        if (kscale) { a *= kscale[k0 + 2 * kp]; b *= kscale[k0 + 2 * kp + 1]; }
        scr[kp * 65 + lane] = pk2(a, b);
    }
    LDS_WAIT(); asm volatile("" ::: "memory");
#pragma unroll
    for (int j = 0; j < 8; ++j) { const int id = lane + 64 * j, n = id >> 3, c = id & 7;
        u32x4 o; o.x = scr[(4 * c + 0) * 65 + n]; o.y = scr[(4 * c + 1) * 65 + n]; o.z = scr[(4 * c + 2) * 65 + n]; o.w = scr[(4 * c + 3) * 65 + n];
        *(u32x4*)(WT + (size_t)(n0 + n) * K + k0 + 8 * c) = o; }
    LDS_WAIT(); asm volatile("" ::: "memory");
}
struct MapId { int off; __device__ __forceinline__ int operator()(int n) const { return off + n; } };
struct MapWin {
    __device__ __forceinline__ int operator()(int n) const {
        if (n < 3072) return n;
        if (n < 3840) return 3088 + (n - 3072);
        if (n < 4096) return 3856 + (n - 3840);
        if (n < 6144) return 4176 + (n - 4096);
        const int t = n - 6144;
        if (t < 64) { const int j = t >> 3, i = t & 7; return 4112 + (i < 4 ? 4 * j + i : 32 + 4 * j + (i - 4)); }
        if (t < 80) return 3072 + (t - 64);
        return -1;
    }
};
struct MapUq { __device__ __forceinline__ int operator()(int n) const { const int h = n / 192, w = n - h * 192; if (w < 128) return n; const int t = w - 128, j = t >> 3, i = t & 7; return h * 192 + 128 + (i < 4 ? 4 * j + i : 32 + 4 * j + (i - 4)); } };
struct MapUkv { __device__ __forceinline__ int operator()(int n) const { const int part = n >> 10, r = n & 1023, h = r >> 7, d = r & 127; return h * 256 + part * 128 + d; } };
struct MapGlu { int coff; __device__ __forceinline__ int operator()(int n) const { return coff + ((n >> 3) << 2) + (n & 3); } };
__device__ __forceinline__ void tr_glu_item(const float* W1, const float* W3, int K, int Nsrc, bf16_t* WT, LAS unsigned* scr, int kb, int nb, int lane) {
    const int k0 = 64 * kb, n0 = 64 * nb, n = n0 + lane;
    const float* W = (n & 4) ? W3 : W1; const int sc = ((n >> 3) << 2) + (n & 3);
#pragma unroll 8
    for (int kp = 0; kp < 32; ++kp) scr[kp * 65 + lane] = pk2(W[(size_t)(k0 + 2 * kp) * Nsrc + sc], W[(size_t)(k0 + 2 * kp + 1) * Nsrc + sc]);
    LDS_WAIT(); asm volatile("" ::: "memory");
#pragma unroll
    for (int j = 0; j < 8; ++j) { const int id = lane + 64 * j, nn = id >> 3, c = id & 7;
        u32x4 o; o.x = scr[(4 * c + 0) * 65 + nn]; o.y = scr[(4 * c + 1) * 65 + nn]; o.z = scr[(4 * c + 2) * 65 + nn]; o.w = scr[(4 * c + 3) * 65 + nn];
        *(u32x4*)(WT + (size_t)(n0 + nn) * K + k0 + 8 * c) = o; }
    LDS_WAIT(); asm volatile("" ::: "memory");
}


__device__ __forceinline__ void tr_glu8_item(const float* W1, const float* W3, int K, int Nsrc, unsigned char* WT, LAS unsigned* scr, int kb, int nb, int lane) {
    const int k0 = 64 * kb, n0 = 64 * nb, n = n0 + lane;
    const float* W = (n & 4) ? W3 : W1; const int sc = ((n >> 3) << 2) + (n & 3);
#pragma unroll 4
    for (int kq = 0; kq < 16; ++kq) { const float* wp = W + (size_t)(k0 + 4 * kq) * Nsrc + sc;
        unsigned d = 0u; d = __builtin_amdgcn_cvt_pk_fp8_f32(wp[0] * 32.0f, wp[Nsrc] * 32.0f, d, false); d = __builtin_amdgcn_cvt_pk_fp8_f32(wp[2 * (size_t)Nsrc] * 32.0f, wp[3 * (size_t)Nsrc] * 32.0f, d, true);
        scr[kq * 65 + lane] = d; }
    LDS_WAIT(); asm volatile("" ::: "memory");
#pragma unroll
    for (int j = 0; j < 4; ++j) { const int id = lane + 64 * j, nn = id >> 2, c = id & 3;
        u32x4 o; o.x = scr[(4 * c + 0) * 65 + nn]; o.y = scr[(4 * c + 1) * 65 + nn]; o.z = scr[(4 * c + 2) * 65 + nn]; o.w = scr[(4 * c + 3) * 65 + nn];
        *(u32x4*)(WT + (size_t)(n0 + nn) * K + k0 + 16 * c) = o; }
    LDS_WAIT(); asm volatile("" ::: "memory");
}

template <class Map>
__device__ __forceinline__ void tr8_item(const float* W, int K, int Nsrc, unsigned char* WT, const Map& map, LAS unsigned* scr, int kb, int nb, int lane) {
    const int k0 = 64 * kb, n0 = 64 * nb; const int sc = map(n0 + lane);
#pragma unroll 4
    for (int kq = 0; kq < 16; ++kq) { const float* wp = W + (size_t)(k0 + 4 * kq) * Nsrc + sc;
        unsigned d = 0u; d = __builtin_amdgcn_cvt_pk_fp8_f32(wp[0] * 32.0f, wp[Nsrc] * 32.0f, d, false); d = __builtin_amdgcn_cvt_pk_fp8_f32(wp[2 * (size_t)Nsrc] * 32.0f, wp[3 * (size_t)Nsrc] * 32.0f, d, true);
        scr[kq * 65 + lane] = d; }
    LDS_WAIT(); asm volatile("" ::: "memory");
#pragma unroll
    for (int j = 0; j < 4; ++j) { const int id = lane + 64 * j, nn = id >> 2, c = id & 3;
        u32x4 o; o.x = scr[(4 * c + 0) * 65 + nn]; o.y = scr[(4 * c + 1) * 65 + nn]; o.z = scr[(4 * c + 2) * 65 + nn]; o.w = scr[(4 * c + 3) * 65 + nn];
        *(u32x4*)(WT + (size_t)(n0 + nn) * K + k0 + 16 * c) = o; }
    LDS_WAIT(); asm volatile("" ::: "memory");
}

struct MapWin8 { __device__ __forceinline__ int operator()(int n) const { return n < 1024 ? 2048 + n : 4176 + (n - 1024); } };
__device__ __forceinline__ void phase0(const Params& p, LAS unsigned char* lds, int gw, int ngw, int lane, int wave) {
    unsigned char* ws = p.ws;
    {
        const int cb = blockIdx.x, tid = threadIdx.x;
        if (cb < 96) {
            const float* c = p.in[I_C]; const float* wada = p.in[I_WADA]; const float* bada = p.in[I_BADA]; float* mod = (float*)(ws + WS_MOD);
            LAS float* tab = (LAS float*)lds;
            for (int i = tid; i < 32 * 1024 / 4; i += NTHR) { const f32x4 v = ((const f32x4*)c)[i]; f32x4 o; o[0] = silu(v[0]); o[1] = silu(v[1]); o[2] = silu(v[2]); o[3] = silu(v[3]); ((LAS f32x4*)tab)[i] = o; }
            __syncthreads();
            float acc[32];
#pragma unroll
            for (int b = 0; b < 32; ++b) acc[b] = 0.f;
            const int col = cb * 64 + lane;
            for (int k4 = 0; k4 < 32; ++k4) {
                const int k = wave * 128 + k4 * 4;
                float w[4];
#pragma unroll
                for (int q = 0; q < 4; ++q) w[q] = wada[(size_t)(k + q) * 6144 + col];
#pragma unroll
                for (int b = 0; b < 32; ++b) { const f32x4 t = *(const LAS f32x4*)(tab + b * 1024 + k); acc[b] += t[0] * w[0] + t[1] * w[1] + t[2] * w[2] + t[3] * w[3]; }
            }
            __syncthreads();
            LAS float* part = (LAS float*)lds;
#pragma unroll
            for (int b = 0; b < 32; ++b) part[(wave * 32 + b) * 64 + lane] = acc[b];
            __syncthreads();
#pragma unroll
            for (int i = 0; i < 4; ++i) { const int o = tid + 512 * i, b = o >> 6, l = o & 63; float sum = 0.f;
#pragma unroll
                for (int w8 = 0; w8 < 8; ++w8) sum += part[(w8 * 32 + b) * 64 + l];
                mod[b * 6144 + cb * 64 + l] = sum + bada[cb * 64 + l]; }
            __syncthreads();
        }
    }
    LAS unsigned* scr = (LAS unsigned*)(lds + wave * 8448);
    constexpr int T_WIN = 16 * 100, T_GLAO = 16 * 16, T_UQ = 12 * 24, T_UKV = 4 * 32, T_MLAO = 256, T_OUT = 256, T_RT = 16 * 4, T_S13 = 16 * 8, T_S2 = 4 * 16, T_WIN8 = 16 * 48;
    constexpr int T_ALL = T_WIN + T_GLAO + T_UQ + T_UKV + T_MLAO + T_OUT + T_RT + T_S13 + T_S2 + T_WIN8;
    for (int it = gw; it < T_ALL; it += ngw) {
        int r = it;
        if (r < T_WIN) { tr_item(p.in[I_WIN], 1024, 6224, (bf16_t*)(ws + WS_WIN), MapWin{}, nullptr, scr, r / 100, r % 100, lane); continue; } r -= T_WIN;
        if (r < T_GLAO) { tr_item(p.in[I_WGLAO], 1024, 1024, (bf16_t*)(ws + WS_WGLAO), MapId{0}, nullptr, scr, r / 16, r % 16, lane); continue; } r -= T_GLAO;
        if (r < T_UQ) { tr_item(p.in[I_WUQ], 768, 1536, (bf16_t*)(ws + WS_WUQ), MapUq{}, p.in[I_GCQ], scr, r / 24, r % 24, lane); continue; } r -= T_UQ;
        if (r < T_UKV) { tr_item(p.in[I_WUKV], 256, 2048, (bf16_t*)(ws + WS_WUKV), MapUkv{}, p.in[I_GCKV], scr, r / 32, r % 32, lane); continue; } r -= T_UKV;
        if (r < T_MLAO) { tr_item(p.in[I_WMLAO], 1024, 1024, (bf16_t*)(ws + WS_WMLAO), MapId{0}, nullptr, scr, r / 16, r % 16, lane); continue; } r -= T_MLAO;
        if (r < T_OUT) { tr_item(p.in[I_WOUT], 1024, 1024, (bf16_t*)(ws + WS_WOUT), MapId{0}, nullptr, scr, r / 16, r % 16, lane); continue; } r -= T_OUT;
        if (r < T_RT) { tr_item(p.in[I_WRT], 1024, 256, (bf16_t*)(ws + WS_WRT), MapId{0}, nullptr, scr, r / 4, r % 4, lane); continue; } r -= T_RT;
        if (r < T_S13) { tr_glu_item(p.in[I_WS1], p.in[I_WS3], 1024, 256, (bf16_t*)(ws + WS_WS13), scr, r / 8, r % 8, lane); continue; } r -= T_S13;
        if (r < T_S2) { tr_item(p.in[I_WS2], 256, 1024, (bf16_t*)(ws + WS_WS2), MapId{0}, nullptr, scr, r / 16, r % 16, lane); continue; } r -= T_S2;
        tr8_item(p.in[I_WIN], 1024, 6224, ws + WS_WIN8, MapWin8{}, scr, r / 48, r % 48, lane);
    }
    { int* st = (int*)(ws + WS_STOK); for (int i = gw * 64 + lane; i < NSLOT; i += ngw * 64) st[i] = -1; }
}

__device__ __forceinline__ void phase1(const Params& p, int gw, int ngw, int lane) {
    const float* x = p.in[I_X]; const float* mod = (const float*)(p.ws + WS_MOD); bf16_t* h = (bf16_t*)(p.ws + WS_BIG(0));
    const int* pos = (const int*)p.in[I_POS]; float* rope = (float*)((unsigned char*)p.out + 192 * MiB);
    const float invf = exp2f(-(float)(lane & 31) * (13.287712379549449f / 32.0f));
    for (int m = gw; m < NTOK; m += ngw) {
        const int b = m >> 11; const float* sh = mod + b * 6144; const float* sc = sh + 1024;
        const f32x4* xr = (const f32x4*)(x + (size_t)m * 1024) + lane;
        u32x2* o = (u32x2*)(h + (size_t)m * 1024) + lane;
#pragma unroll
        for (int j = 0; j < 4; ++j) { const f32x4 v = xr[64 * j], s = *((const f32x4*)sc + lane + 64 * j) + 1.0f, t = *((const f32x4*)sh + lane + 64 * j);
            const f32x4 r = v * s + t; u32x2 w; w.x = pk2(r[0], r[1]); w.y = pk2(r[2], r[3]); o[64 * j] = w;
            unsigned w8 = 0u; w8 = __builtin_amdgcn_cvt_pk_fp8_f32(r[0], r[1], w8, false); w8 = __builtin_amdgcn_cvt_pk_fp8_f32(r[2], r[3], w8, true);
            ((unsigned*)(p.ws + WS_BIG(7) + (size_t)m * 1024))[lane + 64 * j] = w8; }
        const float ang = (float)pos[m] * invf;
        rope[(size_t)m * 64 + lane] = lane < 32 ? cosf(ang) : sinf(ang);
    }
}

__device__ __forceinline__ void ln1_row(float* zrow, bf16_t* h2row, const float* g, const float* bta, const float* sh2, const float* sc2, int lane) {
    f32x4* zr = (f32x4*)zrow + lane; f32x4 v[4]; float s = 0.f;
#pragma unroll
    for (int j = 0; j < 4; ++j) { v[j] = zr[64 * j]; s += (v[j][0] + v[j][1]) + (v[j][2] + v[j][3]); }
    const float mean = wave_sum(s) * (1.f / 1024.f); float s2 = 0.f;
#pragma unroll
    for (int j = 0; j < 4; ++j) { v[j] = v[j] - mean; s2 += (v[j][0] * v[j][0] + v[j][1] * v[j][1]) + (v[j][2] * v[j][2] + v[j][3] * v[j][3]); }
    const float rstd = rsqrtf(wave_sum(s2) * (1.f / 1024.f) + LN_EPS);
    u32x2* o = (u32x2*)h2row + lane;
#pragma unroll
    for (int j = 0; j < 4; ++j) {
        const int ci = lane + 64 * j;
        const f32x4 x1 = v[j] * rstd * ((const f32x4*)g)[ci] + ((const f32x4*)bta)[ci];
        zr[64 * j] = x1;
        const f32x4 hh = x1 * (((const f32x4*)sc2)[ci] + 1.0f) + ((const f32x4*)sh2)[ci];
        u32x2 w; w.x = pk2(hh[0], hh[1]); w.y = pk2(hh[2], hh[3]); o[64 * j] = w;
    }
}
__device__ __forceinline__ void ln2_row(float* orow, const bf16_t* frow, const float* g, const float* bta, const float* gt2, int lane) {
    f32x4* zr = (f32x4*)orow + lane; const u32x2* fr = (const u32x2*)frow + lane; f32x4 v[4]; float s = 0.f;
#pragma unroll
    for (int j = 0; j < 4; ++j) { const u32x2 w = fr[64 * j]; const f32x4 f = (f32x4){bflo(w.x), bfhi(w.x), bflo(w.y), bfhi(w.y)};
        v[j] = zr[64 * j] * ALPHA + (((const f32x4*)gt2)[lane + 64 * j] + 1.0f) * f; s += (v[j][0] + v[j][1]) + (v[j][2] + v[j][3]); }
    const float mean = wave_sum(s) * (1.f / 1024.f); float s2 = 0.f;
#pragma unroll
    for (int j = 0; j < 4; ++j) { v[j] = v[j] - mean; s2 += (v[j][0] * v[j][0] + v[j][1] * v[j][1]) + (v[j][2] * v[j][2] + v[j][3] * v[j][3]); }
    const float rstd = rsqrtf(wave_sum(s2) * (1.f / 1024.f) + LN_EPS);
#pragma unroll
    for (int j = 0; j < 4; ++j) { const int ci = lane + 64 * j; zr[64 * j] = v[j] * rstd * ((const f32x4*)g)[ci] + ((const f32x4*)bta)[ci]; }
}

__device__ __forceinline__ void gla_phase(const Params& p, LAS unsigned char* lds, int bh, bool nostore) {
    const int tid = threadIdx.x, lane = tid & 63, wave = __builtin_amdgcn_readfirstlane(tid >> 6), fr = lane & 15, g = lane >> 4;
    const int b = bh >> 2, h = bh & 3;
    const bf16_t* qg = (const bf16_t*)(p.ws + WS_BIG(1)); const bf16_t* kg = qg + (size_t)NTOK * 512; const bf16_t* vg = (const bf16_t*)(p.ws + WS_BIG(2));
    bf16_t* gr = (bf16_t*)(p.ws + WS_BIG(3)); const float* gag = (const float*)(p.ws + WS_GA);
    LAS bf16_t* KdT = (LAS bf16_t*)lds;
    LAS bf16_t* VT = (LAS bf16_t*)(lds + 18432);
    LAS bf16_t* ST = (LAS bf16_t*)lds;
    LAS bf16_t* QS = (LAS bf16_t*)(lds + 69632);
    LAS float* DEC = (LAS float*)(lds + 87040);
    LAS float* PART = (LAS float*)(lds + 87552);
    LAS float* GAC = (LAS float*)(lds + 89600);
    LAS float* SS = (LAS float*)(lds + 93696);
    const int dk = tid & 127, tq = tid >> 7;
    float w2[16];
#pragma unroll
    for (int r = 0; r < 16; ++r) w2[r] = p.in[I_WGA2][r * 512 + h * 128 + dk];
    const float bias = p.in[I_BGA][h * 128 + dk];
    const int rg = wave & 3, ch = wave >> 2;
    float gnv[8];
#pragma unroll
    for (int nt = 0; nt < 8; ++nt) gnv[nt] = p.in[I_GGN][128 * ch + 16 * nt + fr];
    f32x4 st[8][2];
#pragma unroll
    for (int mt = 0; mt < 8; ++mt) { st[mt][0] = (f32x4){0.f, 0.f, 0.f, 0.f}; st[mt][1] = (f32x4){0.f, 0.f, 0.f, 0.f}; }
    const int dvp = tid & 127, tq4 = tid >> 7;
    bf16_t kraw[16]; unsigned vraw[16]; u32x4 qraw[2]; f32x4 garaw = (f32x4){0.f, 0.f, 0.f, 0.f};
#define GLA_LOAD(n_) do { const int tk_ = b * 2048 + (n_) * 64; \
        if (tid < 256) garaw = *(const f32x4*)(gag + (size_t)(tk_ + (tid >> 2)) * 16 + (tid & 3) * 4); \
        _Pragma("unroll") for (int j = 0; j < 16; ++j) kraw[j] = kg[(size_t)(tk_ + 16 * tq + j) * 512 + h * 128 + dk]; \
        _Pragma("unroll") for (int j = 0; j < 16; ++j) vraw[j] = *(const unsigned*)(vg + (size_t)(tk_ + 16 * tq4 + j) * 1024 + h * 256 + 2 * dvp); \
        _Pragma("unroll") for (int i = 0; i < 2; ++i) { const int id = tid + 512 * i; qraw[i] = *(const u32x4*)(qg + (size_t)(tk_ + (id >> 4)) * 512 + h * 128 + (id & 15) * 8); } } while (0)
    GLA_LOAD(0);
    for (int n = 0; n < 32; ++n) {
        const int tok0 = b * 2048 + n * 64;
        if (tid < 256) *(LAS f32x4*)(GAC + tid * 4) = garaw;
        __syncthreads();
        float cs[16]; float run = 0.f;
#pragma unroll
        for (int j = 0; j < 16; ++j) {
            const LAS f32x4* gp = (const LAS f32x4*)(GAC + (16 * tq + j) * 16);
            float d = bias;
#pragma unroll
            for (int r4 = 0; r4 < 4; ++r4) { const f32x4 gv = gp[r4]; d += gv[0] * w2[4 * r4] + gv[1] * w2[4 * r4 + 1] + gv[2] * w2[4 * r4 + 2] + gv[3] * w2[4 * r4 + 3]; }
            const float ls = fminf(d, 0.f) - __logf(1.0f + __expf(-fabsf(d)));
            run += ls * (1.0f / 16.0f); cs[j] = run;
        }
        PART[tq * 128 + dk] = run;
        __syncthreads();
        {
            const float p0 = PART[dk], p1 = PART[128 + dk], p2 = PART[256 + dk], p3 = PART[384 + dk];
            const float total = (p0 + p1) + (p2 + p3);
            const float off = tq == 0 ? 0.f : tq == 1 ? p0 : tq == 2 ? (p0 + p1) : (p0 + p1) + p2;
            if (tq == 0) DEC[dk] = __expf(total);
            unsigned kd[8];
#pragma unroll
            for (int j = 0; j < 8; ++j) kd[j] = pk2(bf2f(kraw[2 * j]) * __expf(total - (off + cs[2 * j])), bf2f(kraw[2 * j + 1]) * __expf(total - (off + cs[2 * j + 1])));
            LAS u32x4* kdst = (LAS u32x4*)(KdT + dk * 72 + 16 * tq);
            kdst[0] = (u32x4){kd[0], kd[1], kd[2], kd[3]}; kdst[1] = (u32x4){kd[4], kd[5], kd[6], kd[7]};
            unsigned v0[8], v1[8];
#pragma unroll
            for (int j = 0; j < 8; ++j) { v0[j] = (vraw[2 * j] & 0xffffu) | (vraw[2 * j + 1] << 16); v1[j] = (vraw[2 * j] >> 16) | (vraw[2 * j + 1] & 0xffff0000u); }
            LAS u32x4* vd0 = (LAS u32x4*)(VT + (2 * dvp) * 72 + 16 * tq4); LAS u32x4* vd1 = (LAS u32x4*)(VT + (2 * dvp + 1) * 72 + 16 * tq4);
            vd0[0] = (u32x4){v0[0], v0[1], v0[2], v0[3]}; vd0[1] = (u32x4){v0[4], v0[5], v0[6], v0[7]};
            vd1[0] = (u32x4){v1[0], v1[1], v1[2], v1[3]}; vd1[1] = (u32x4){v1[4], v1[5], v1[6], v1[7]};
#pragma unroll
            for (int i = 0; i < 2; ++i) { const int id = tid + 512 * i; *(LAS u32x4*)(QS + (id >> 4) * 136 + (id & 15) * 8) = qraw[i]; }
        }
        if (n + 1 < 32) GLA_LOAD(n + 1);
        __syncthreads();
#pragma unroll
        for (int mt = 0; mt < 8; ++mt) { const f32x4 d4 = *(const LAS f32x4*)(DEC + 16 * mt + 4 * g); st[mt][0] *= d4; st[mt][1] *= d4; }
#pragma unroll
        for (int ks = 0; ks < 2; ++ks) {
            bf16x8 bfr[2];
#pragma unroll
            for (int nt = 0; nt < 2; ++nt) bfr[nt] = *(const LAS bf16x8*)(VT + (32 * wave + 16 * nt + fr) * 72 + 32 * ks + 8 * g);
#pragma unroll
            for (int mt = 0; mt < 8; ++mt) {
                const bf16x8 a = *(const LAS bf16x8*)(KdT + (16 * mt + fr) * 72 + 32 * ks + 8 * g);
                st[mt][0] = __builtin_amdgcn_mfma_f32_16x16x32_bf16(a, bfr[0], st[mt][0], 0, 0, 0);
                st[mt][1] = __builtin_amdgcn_mfma_f32_16x16x32_bf16(a, bfr[1], st[mt][1], 0, 0, 0);
            }
        }
        __syncthreads();
#pragma unroll
        for (int mt = 0; mt < 8; ++mt)
#pragma unroll
            for (int nt = 0; nt < 2; ++nt) { u32x2 w; w.x = pk2(st[mt][nt][0], st[mt][nt][1]); w.y = pk2(st[mt][nt][2], st[mt][nt][3]);
                *(LAS u32x2*)(ST + (32 * wave + 16 * nt + fr) * 136 + 16 * mt + 4 * g) = w; }
        __syncthreads();
        f32x4 o[8];
#pragma unroll
        for (int nt = 0; nt < 8; ++nt) o[nt] = (f32x4){0.f, 0.f, 0.f, 0.f};
#pragma unroll
        for (int ks = 0; ks < 4; ++ks) {
            const bf16x8 a = *(const LAS bf16x8*)(QS + (16 * rg + fr) * 136 + 32 * ks + 8 * g);
#pragma unroll
            for (int nt = 0; nt < 8; ++nt) { const bf16x8 bb = *(const LAS bf16x8*)(ST + (128 * ch + 16 * nt + fr) * 136 + 32 * ks + 8 * g);
                o[nt] = __builtin_amdgcn_mfma_f32_16x16x32_bf16(a, bb, o[nt], 0, 0, 0); }
        }
        {
            f32x4 s2 = (f32x4){0.f, 0.f, 0.f, 0.f};
#pragma unroll
            for (int nt = 0; nt < 8; ++nt) s2 += o[nt] * o[nt];
#pragma unroll
            for (int r = 0; r < 4; ++r) { float s = s2[r]; s += __shfl_xor(s, 1); s += __shfl_xor(s, 2); s += __shfl_xor(s, 4); s += __shfl_xor(s, 8); if (fr == 0) SS[(16 * rg + 4 * g + r) * 2 + ch] = s; }
        }
        __syncthreads();
#pragma unroll
        for (int r = 0; r < 4; ++r) {
            const int t = 16 * rg + 4 * g + r;
            const float rstd = rsqrtf((SS[t * 2] + SS[t * 2 + 1]) * (1.0f / 256.0f) + RMS_EPS);
            bf16_t* grow = gr + (size_t)(tok0 + t) * 1024 + h * 256 + 128 * ch + fr;
#pragma unroll
#if defined(GLA_DBG) && GLA_DBG == 1
            for (int nt = 0; nt < 8; ++nt) grow[16 * nt] = f2bf(o[nt][r]);
#elif defined(GLA_DBG) && GLA_DBG == 2
            for (int nt = 0; nt < 8; ++nt) grow[16 * nt] = f2bf(rstd);
#else
            for (int nt = 0; nt < 8; ++nt) { const bf16_t y = f2bf(o[nt][r] * rstd * gnv[nt] * bf2f(grow[16 * nt])); if (!nostore) grow[16 * nt] = y; }
#endif
        }
    }
#undef GLA_LOAD
    __syncthreads();
}

__device__ __forceinline__ float xor16_max(float v) { const auto r = __builtin_amdgcn_permlane16_swap(__float_as_uint(v), __float_as_uint(v), false, false); return fmaxf(__uint_as_float(r[0]), __uint_as_float(r[1])); }
__device__ __forceinline__ float xor32_max(float v) { const auto r = __builtin_amdgcn_permlane32_swap(__float_as_uint(v), __float_as_uint(v), false, false); return fmaxf(__uint_as_float(r[0]), __uint_as_float(r[1])); }
__device__ __forceinline__ float xor16_sum(float v) { const auto r = __builtin_amdgcn_permlane16_swap(__float_as_uint(v), __float_as_uint(v), false, false); return __uint_as_float(r[0]) + __uint_as_float(r[1]); }
__device__ __forceinline__ float xor32_sum(float v) { const auto r = __builtin_amdgcn_permlane32_swap(__float_as_uint(v), __float_as_uint(v), false, false); return __uint_as_float(r[0]) + __uint_as_float(r[1]); }
constexpr int ATT_BUF = 43008, ATT_VOFF = 24576;
__device__ __forceinline__ void attn_phase(const Params& p, LAS unsigned char* lds, int bh) {
    const int tid = threadIdx.x, lane = tid & 63, wave = __builtin_amdgcn_readfirstlane(tid >> 6), fr = lane & 15, g = lane >> 4;
    const int b = bh >> 3, h = bh & 7;
    const bf16_t* qm = (const bf16_t*)p.out; const bf16_t* kn = (const bf16_t*)(p.ws + WS_BIG(0)); const bf16_t* vm = (const bf16_t*)(p.ws + WS_BIG(7));
    const bf16_t* kr = (const bf16_t*)(p.ws + WS_KR); bf16_t* ob = (bf16_t*)(p.ws + WS_BIG(1));
    const int kp = tid & 31, dvc = tid >> 5;
    unsigned koff[3]; bool krope[3];
#pragma unroll
    for (int j = 0; j < 3; ++j) { const int L = (8 * j + wave) * 64 + lane, key = L / 24, sl = L % 24, c = (sl & ~7) | ((sl & 7) ^ (key & 7));
        krope[j] = c >= 16; koff[j] = krope[j] ? (unsigned)(key * 128 + 16 * (c - 16)) : (unsigned)(key * 2048 + h * 256 + 16 * c); }
    for (int qb = 0; qb < 8; ++qb) {
        const int q0 = b * 2048 + 256 * qb + 32 * wave;
        bf16x8 qf[2][6];
#pragma unroll
        for (int nt = 0; nt < 2; ++nt)
#pragma unroll
            for (int ks = 0; ks < 6; ++ks) qf[nt][ks] = *(const bf16x8*)(qm + (size_t)(q0 + 16 * nt + fr) * 1536 + h * 192 + 32 * ks + 8 * g);
        f32x4 O[8][2];
#pragma unroll
        for (int mt = 0; mt < 8; ++mt) { O[mt][0] = (f32x4){0.f, 0.f, 0.f, 0.f}; O[mt][1] = (f32x4){0.f, 0.f, 0.f, 0.f}; }
        float m_run[2] = {-1e30f, -1e30f}, l_part[2] = {0.f, 0.f};
        const int ntile = 4 * qb + 4, my_last = 4 * qb + (wave >> 1);
        u32x4 vreg[2];
#define ATT_PREFETCH(kt, buf) do { const int tk0 = b * 2048 + 64 * (kt); const char* knb = (const char*)(kn + (size_t)tk0 * 1024); const char* krb = (const char*)(kr + (size_t)tk0 * 64); \
            _Pragma("unroll") for (int j = 0; j < 3; ++j) __builtin_amdgcn_global_load_lds((const unsigned*)((krope[j] ? krb : knb) + koff[j]), (LAS unsigned*)(lds + (buf) * ATT_BUF + (8 * j + wave) * 1024), 16, 0, 0); \
            vreg[0] = *(const u32x4*)(vm + (size_t)(tk0 + 2 * kp) * 1024 + h * 128 + 8 * dvc); vreg[1] = *(const u32x4*)(vm + (size_t)(tk0 + 2 * kp + 1) * 1024 + h * 128 + 8 * dvc); } while (0)
#define ATT_WRITE(buf) do { LAS unsigned* VTw = (LAS unsigned*)(lds + (buf) * ATT_BUF + ATT_VOFF); \
            _Pragma("unroll") for (int i = 0; i < 4; ++i) { const unsigned a_ = vreg[0][i], b_ = vreg[1][i]; \
                VTw[(8 * dvc + 2 * i) * 36 + kp] = (a_ & 0xffffu) | (b_ << 16); VTw[(8 * dvc + 2 * i + 1) * 36 + kp] = (a_ >> 16) | (b_ & 0xffff0000u); } \
            asm volatile("s_waitcnt vmcnt(0)" ::: "memory"); } while (0)
        __syncthreads();
        ATT_PREFETCH(0, 0);
        ATT_WRITE(0);
        __syncthreads();
        for (int kt = 0; kt < ntile; ++kt) {
            if (kt + 1 < ntile) ATT_PREFETCH(kt + 1, (kt + 1) & 1);
            if (kt <= my_last) {
                const LAS unsigned char* KS = lds + (kt & 1) * ATT_BUF; const LAS unsigned* VT = (const LAS unsigned*)(lds + (kt & 1) * ATT_BUF + ATT_VOFF);
                f32x4 s[4][2];
#pragma unroll
                for (int mt = 0; mt < 4; ++mt) { s[mt][0] = (f32x4){0.f, 0.f, 0.f, 0.f}; s[mt][1] = (f32x4){0.f, 0.f, 0.f, 0.f}; }
                {
                    bf16x8 ka[2][4];
                    const LAS unsigned char* kb0 = KS + fr * 384 + 16 * (g ^ (fr & 7));
                    const LAS unsigned char* kb1 = KS + fr * 384 + 16 * ((4 + g) ^ (fr & 7));
#pragma unroll
                    for (int mt = 0; mt < 4; ++mt) ka[0][mt] = *(const LAS bf16x8*)(kb0 + mt * 6144);
#pragma unroll
                    for (int ks = 0; ks < 6; ++ks) {
                        if (ks < 5) {
#pragma unroll
                            for (int mt = 0; mt < 4; ++mt) ka[(ks + 1) & 1][mt] = *(const LAS bf16x8*)((((ks + 1) & 1) ? kb1 : kb0) + mt * 6144 + 128 * ((ks + 1) >> 1));
                            asm volatile("s_waitcnt lgkmcnt(4)" ::: "memory");
                        } else asm volatile("s_waitcnt lgkmcnt(0)" ::: "memory");
                        __builtin_amdgcn_sched_barrier(0);
#pragma unroll
                        for (int mt = 0; mt < 4; ++mt) {
                            s[mt][0] = __builtin_amdgcn_mfma_f32_16x16x32_bf16(ka[ks & 1][mt], qf[0][ks], s[mt][0], 0, 0, 0);
                            s[mt][1] = __builtin_amdgcn_mfma_f32_16x16x32_bf16(ka[ks & 1][mt], qf[1][ks], s[mt][1], 0, 0, 0);
                        }
                        __builtin_amdgcn_sched_barrier(0);
                    }
                }
                bf16x8 pf[2][2]; float al[2];
#pragma unroll
                for (int nt = 0; nt < 2; ++nt) {
                    float mx = fmaxf(fmaxf(s[0][nt][0], s[0][nt][1]), fmaxf(s[0][nt][2], s[0][nt][3]));
#pragma unroll
                    for (int mt = 1; mt < 4; ++mt) mx = fmaxf(mx, fmaxf(fmaxf(s[mt][nt][0], s[mt][nt][1]), fmaxf(s[mt][nt][2], s[mt][nt][3])));
                    mx = xor16_max(mx); mx = xor32_max(mx);
                    const float mn = fmaxf(m_run[nt], mx); al[nt] = __builtin_amdgcn_exp2f(m_run[nt] - mn); m_run[nt] = mn;
                    float rs = 0.f;
#pragma unroll
                    for (int mt = 0; mt < 4; ++mt)
#pragma unroll
                        for (int r = 0; r < 4; ++r) { const float e = __builtin_amdgcn_exp2f(s[mt][nt][r] - mn); s[mt][nt][r] = e; rs += e; }
                    l_part[nt] = l_part[nt] * al[nt] + rs;
#pragma unroll
                    for (int k2 = 0; k2 < 2; ++k2) {
                        u32x4 w; w.x = pk2(s[2 * k2][nt][0], s[2 * k2][nt][1]); w.y = pk2(s[2 * k2][nt][2], s[2 * k2][nt][3]);
                        w.z = pk2(s[2 * k2 + 1][nt][0], s[2 * k2 + 1][nt][1]); w.w = pk2(s[2 * k2 + 1][nt][2], s[2 * k2 + 1][nt][3]);
                        pf[nt][k2] = __builtin_bit_cast(bf16x8, w);
                    }
                }
                if (__any(al[0] != 1.0f || al[1] != 1.0f)) {
#pragma unroll
                    for (int mt = 0; mt < 8; ++mt) { O[mt][0] *= al[0]; O[mt][1] *= al[1]; }
                }
                {
                    u32x2 vf[2][2][2];
                    const LAS unsigned* vbase = VT + fr * 36 + 2 * g;
#pragma unroll
                    for (int k2 = 0; k2 < 2; ++k2) { vf[0][k2][0] = *(const LAS u32x2*)(vbase + 16 * k2); vf[0][k2][1] = *(const LAS u32x2*)(vbase + 16 * k2 + 8); }
#pragma unroll
                    for (int mt = 0; mt < 8; ++mt) {
                        if (mt < 7) {
#pragma unroll
                            for (int k2 = 0; k2 < 2; ++k2) { vf[(mt + 1) & 1][k2][0] = *(const LAS u32x2*)(vbase + 16 * (mt + 1) * 36 + 16 * k2); vf[(mt + 1) & 1][k2][1] = *(const LAS u32x2*)(vbase + 16 * (mt + 1) * 36 + 16 * k2 + 8); }
                            asm volatile("s_waitcnt lgkmcnt(4)" ::: "memory");
                        } else asm volatile("s_waitcnt lgkmcnt(0)" ::: "memory");
                        __builtin_amdgcn_sched_barrier(0);
#pragma unroll
                        for (int k2 = 0; k2 < 2; ++k2) {
                            const u32x2 lo = vf[mt & 1][k2][0], hi = vf[mt & 1][k2][1];
                            const bf16x8 a = __builtin_bit_cast(bf16x8, ((u32x4){lo.x, lo.y, hi.x, hi.y}));
                            O[mt][0] = __builtin_amdgcn_mfma_f32_16x16x32_bf16(a, pf[0][k2], O[mt][0], 0, 0, 0);
                            O[mt][1] = __builtin_amdgcn_mfma_f32_16x16x32_bf16(a, pf[1][k2], O[mt][1], 0, 0, 0);
                        }
                        __builtin_amdgcn_sched_barrier(0);
                    }
                }
            }
            if (kt + 1 < ntile) ATT_WRITE((kt + 1) & 1);
            __syncthreads();
        }
#undef ATT_PREFETCH
#undef ATT_WRITE
#pragma unroll
        for (int nt = 0; nt < 2; ++nt) {
            float l = l_part[nt]; l = xor16_sum(l); l = xor32_sum(l);
            const float inv = 1.0f / l;
            bf16_t* orow = ob + (size_t)(q0 + 16 * nt + fr) * 1024 + h * 128 + 4 * g;
#pragma unroll
            for (int mt = 0; mt < 8; ++mt) { u32x2 w; w.x = pk2(O[mt][nt][0] * inv, O[mt][nt][1] * inv); w.y = pk2(O[mt][nt][2] * inv, O[mt][nt][3] * inv); *(u32x2*)(orow + 16 * mt) = w; }
        }
    }
    __syncthreads();
}

__device__ __forceinline__ unsigned dpp_umax_step_shr(unsigned v, int) { return v; }
__device__ __forceinline__ unsigned wave_umax(unsigned v) {
    unsigned t;
    t = (unsigned)__builtin_amdgcn_update_dpp(0, (int)v, 0x111, 0xf, 0xf, true); v = v > t ? v : t;
    t = (unsigned)__builtin_amdgcn_update_dpp(0, (int)v, 0x112, 0xf, 0xf, true); v = v > t ? v : t;
    t = (unsigned)__builtin_amdgcn_update_dpp(0, (int)v, 0x114, 0xf, 0xf, true); v = v > t ? v : t;
    t = (unsigned)__builtin_amdgcn_update_dpp(0, (int)v, 0x118, 0xf, 0xf, true); v = v > t ? v : t;
    t = (unsigned)__builtin_amdgcn_update_dpp(0, (int)v, 0x142, 0xa, 0xf, false); v = v > t ? v : t;
    t = (unsigned)__builtin_amdgcn_update_dpp(0, (int)v, 0x143, 0xc, 0xf, false); v = v > t ? v : t;
    return (unsigned)__builtin_amdgcn_readlane((int)v, 63);
}
template <int CTRL> __device__ __forceinline__ float dpp_f(float v) { return __builtin_bit_cast(float, __builtin_amdgcn_update_dpp(0, __builtin_bit_cast(int, v), CTRL, 0xf, 0xf, false)); }
template <int CTRL> __device__ __forceinline__ void top2_merge(float& t1, float& t2) { const float p1 = dpp_f<CTRL>(t1), p2 = dpp_f<CTRL>(t2); const float n1 = fmaxf(t1, p1), n2 = fmaxf(fminf(t1, p1), fmaxf(t2, p2)); t1 = n1; t2 = n2; }
template <int NR>
__device__ __forceinline__ void route_rows(const float* lrow, const float* brt, int* tidx, float* tw, LAS int* etab, int lane) {
    const f32x4 bb = *(const f32x4*)(brt + 4 * lane);
    float sc[NR][4], mv[NR][4], t1[NR], t2[NR];
#pragma unroll
    for (int q = 0; q < NR; ++q) {
        const f32x4 lg = *(const f32x4*)(lrow + q * 256 + 4 * lane);
#pragma unroll
        for (int i = 0; i < 4; ++i) { sc[q][i] = sigm(lg[i]); mv[q][i] = sc[q][i] + bb[i]; }
        t1[q] = fmaxf(fmaxf(mv[q][0], mv[q][1]), fmaxf(mv[q][2], mv[q][3]));
        const float a = fmaxf(mv[q][0], mv[q][1]), bq = fminf(mv[q][0], mv[q][1]), c = fmaxf(mv[q][2], mv[q][3]), d = fminf(mv[q][2], mv[q][3]); t2[q] = fmaxf(fminf(a, c), fmaxf(bq, d));
    }
#pragma unroll
    for (int q = 0; q < NR; ++q) top2_merge<0xB1>(t1[q], t2[q]);
#pragma unroll
    for (int q = 0; q < NR; ++q) top2_merge<0x4E>(t1[q], t2[q]);
#pragma unroll
    for (int q = 0; q < NR; ++q) top2_merge<0x141>(t1[q], t2[q]);
    const int mygrp = lane >> 3;
#pragma unroll
    for (int q = 0; q < NR; ++q) {
        const float gs = t1[q] + t2[q]; int rank = 0;
#pragma unroll
        for (int j = 0; j < 8; ++j) { const float o = __builtin_bit_cast(float, __builtin_amdgcn_readlane(__builtin_bit_cast(int, gs), 8 * j)); rank += (o > gs || (o == gs && j < mygrp)) ? 1 : 0; }
        if (rank >= 4) {
#pragma unroll
            for (int i = 0; i < 4; ++i) mv[q][i] = -3.0e38f;
        }
    }
    float wsel[NR], wsum[NR]; int esel[NR];
#pragma unroll
    for (int q = 0; q < NR; ++q) { wsel[q] = 0.f; wsum[q] = 0.f; esel[q] = 0; }
#pragma unroll
    for (int r = 0; r < 8; ++r) {
        unsigned v[NR];
#pragma unroll
        for (int q = 0; q < NR; ++q) {
            float bv = mv[q][0]; int bi = 0;
#pragma unroll
            for (int i = 1; i < 4; ++i) if (mv[q][i] > bv) { bv = mv[q][i]; bi = i; }
            unsigned u = __builtin_bit_cast(unsigned, bv); u = (u & 0x80000000u) ? ~u : (u | 0x80000000u);
            v[q] = (u & 0xFFFFFF00u) | (unsigned)(255 - (4 * lane + bi));
        }
#define RSTEP(ctrl, rm, bc) { unsigned t_[NR]; _Pragma("unroll") for (int q = 0; q < NR; ++q) t_[q] = (unsigned)__builtin_amdgcn_update_dpp(0, (int)v[q], ctrl, rm, 0xf, bc); _Pragma("unroll") for (int q = 0; q < NR; ++q) v[q] = v[q] > t_[q] ? v[q] : t_[q]; }
        RSTEP(0x111, 0xf, true) RSTEP(0x112, 0xf, true) RSTEP(0x114, 0xf, true) RSTEP(0x118, 0xf, true) RSTEP(0x142, 0xa, false) RSTEP(0x143, 0xc, false)
#undef RSTEP
#pragma unroll
        for (int q = 0; q < NR; ++q) {
            const unsigned km = (unsigned)__builtin_amdgcn_readlane((int)v[q], 63);
            const int e = 255 - (int)(km & 255u), ii = e & 3;
            const float cand = ii == 0 ? sc[q][0] : ii == 1 ? sc[q][1] : ii == 2 ? sc[q][2] : sc[q][3];
            const float sv = __builtin_bit_cast(float, __builtin_amdgcn_readlane(__builtin_bit_cast(int, cand), e >> 2));
#pragma unroll
            for (int i = 0; i < 4; ++i) mv[q][i] = (4 * lane + i == e) ? -3.0e38f : mv[q][i];
            wsum[q] += sv;
            if (lane == r) { wsel[q] = sv; esel[q] = e; }
        }
    }
    if (lane < 8) {
#pragma unroll
        for (int q = 0; q < NR; ++q) { tidx[q * 8 + lane] = esel[q]; tw[q * 8 + lane] = wsel[q] / wsum[q] * 2.5f; etab[q * 8 + lane] = esel[q]; }
    }
}

__global__ void __launch_bounds__(NTHR, 2) mk_fwd(Params p) {
    extern __shared__ __attribute__((aligned(16))) unsigned char lds_raw[];
    LAS unsigned char* lds = (LAS unsigned char*)lds_raw;
    int tid = threadIdx.x, lane = tid & 63; const int wave = __builtin_amdgcn_readfirstlane(tid >> 6);
#define FRESH_IDS() do { int _t = threadIdx.x; asm volatile("; fresh ids" : "+v"(_t)); tid = _t; lane = _t & 63; } while (0)
    const int c = blockIdx.x, G = gridDim.x;
    const int gw = c * 8 + wave, ngw = G * 8;
    unsigned char* ws = p.ws;
    volatile LAS unsigned* MISC = (volatile LAS unsigned*)(lds + LDS_MISC);
    for (int u = tid; u < (LDS_BYTES - LDS_MISC) / 4; u += NTHR) ((LAS unsigned*)(lds + LDS_MISC))[u] = 0u;
    __syncthreads();
    XcdBarrier bar; bar.bar = (unsigned*)(ws + WS_BAR); bar.x = 0; bar.st = nullptr;
#if MK_ONE_LAUNCH
    bar = xcd_barrier_post((unsigned*)(ws + WS_BAR), MISC + 8);
#endif
    const int lo = p.ph_lo, hi = p.ph_hi;
#ifndef PH_MASK
#define PH_MASK 0x1ffff
#endif
#define IN(k) (((PH_MASK >> (k)) & 1) && lo <= (k) && (k) < hi)
#define SEAM(k) do { if (IN(k) && IN((k) + 1)) xcd_barrier(bar); } while (0)

    if (IN(0)) { FRESH_IDS(); phase0(p, lds, gw, ngw, lane, wave); }
    SEAM(0);
    if (IN(1)) { FRESH_IDS(); phase1(p, gw, ngw, lane); }
    SEAM(1);
    if (IN(2)) { FRESH_IDS();
        pg8::Gemm g{(const bf16_t*)(ws + WS_BIG(0)), (const bf16_t*)(ws + WS_WIN), 1024, nullptr};
        pg8::StaticOrder S; S.init(NTOK, 13 * 256, G, c); S.remap = 1;
        EpiWin E; E.q = (bf16_t*)(ws + WS_BIG(1)); E.k = E.q + (size_t)NTOK * 512; E.v = (bf16_t*)(ws + WS_BIG(2)); E.gr = (bf16_t*)(ws + WS_BIG(3));
        E.cq = (bf16_t*)(ws + WS_BIG(4)); E.ckv = E.cq + (size_t)NTOK * 768; E.sa = (bf16_t*)(ws + WS_BIG(5)); E.sb = (bf16_t*)(ws + WS_BIG(6));
        E.kr = (bf16_t*)(ws + WS_KR); E.ga = (float*)(ws + WS_GA);
        E.rope = (const float*)((unsigned char*)p.out + 192 * MiB); E.f8 = 0; E.ascale = 1.0f;
        pg8::gemm_phase<EpiWin, pg8::StaticOrder, false>(lds, g, S, E);
        pg8::Gemm g8{(const bf16_t*)(ws + WS_BIG(7)), (const bf16_t*)(ws + WS_WIN8), 512, nullptr};
        pg8::StaticOrder S8; S8.init(NTOK, 12 * 256, G, c);
        E.f8 = 1; E.ascale = 1.0f / 32.0f;
        pg8::gemm_phase<EpiWin, pg8::StaticOrder, false, true>(lds, g8, S8, E);
    }
    SEAM(2);
    if (IN(3)) { FRESH_IDS();
#ifndef NO_GLA
        if (c < 128 && !(p.flags & 1)) gla_phase(p, lds, c, (p.flags & 2) != 0);
#endif
#ifndef NO_P3GEMM
        if (!(p.flags & 2)) { const int pm = c;
            {
                const bf16_t* cqb = (const bf16_t*)(ws + WS_BIG(4)); const bf16_t* ckvb = cqb + (size_t)NTOK * 768;
                float* cqss = (float*)(ws + WS_CQSS); float* ckvss = (float*)(ws + WS_CKVSS);
                for (int r = 0; r < 32; ++r) { const int row = pm * 256 + wave * 32 + r;
                    float s = 0.f;
#pragma unroll
                    for (int j = 0; j < 3; ++j) { const u32x2 w = *((const u32x2*)(cqb + (size_t)row * 768) + lane + 64 * j); const float a0 = bflo(w.x), a1 = bfhi(w.x), a2 = bflo(w.y), a3 = bfhi(w.y); s += (a0 * a0 + a1 * a1) + (a2 * a2 + a3 * a3); }
                    const u32x2 w = *((const u32x2*)(ckvb + (size_t)row * 256) + lane); const float a0 = bflo(w.x), a1 = bfhi(w.x), a2 = bflo(w.y), a3 = bfhi(w.y);
                    const float s1 = wave_sum(s), s2 = wave_sum((a0 * a0 + a1 * a1) + (a2 * a2 + a3 * a3));
                    if (lane == 0) { cqss[row] = s1; ckvss[row] = s2; } }
                if (c >= 128 && G == 256) {
                    for (int r = 0; r < 32; ++r) { const int row = (pm - 128) * 256 + wave * 32 + r;
                        float s = 0.f;
#pragma unroll
                        for (int j = 0; j < 3; ++j) { const u32x2 w = *((const u32x2*)(cqb + (size_t)row * 768) + lane + 64 * j); const float a0 = bflo(w.x), a1 = bfhi(w.x), a2 = bflo(w.y), a3 = bfhi(w.y); s += (a0 * a0 + a1 * a1) + (a2 * a2 + a3 * a3); }
                        const float s1 = wave_sum(s);
                        if (lane == 0) cqss[row] = s1; }
                }
                wg_global_sync();
            }
#ifndef NO_QF
            {
                constexpr int QSPLIT = 2;
                const bool glawg = (c < 128) && G == 256;
                EpiQF E{(bf16_t*)p.out, (const float*)(ws + WS_CQSS), (const float*)((unsigned char*)p.out + 192 * MiB)};
                pg8::Gemm g{(const bf16_t*)(ws + WS_BIG(4)), (const bf16_t*)(ws + WS_WUQ), 768, nullptr};
                if (!glawg && G == 256) { pg8::PanelOrder S{pm - 128, 6 - QSPLIT, QSPLIT}; pg8::gemm_phase<EpiQF, pg8::PanelOrder, false>(lds, g, S, E); }
                { pg8::PanelOrder S{pm, glawg ? QSPLIT : 6, 0}; pg8::gemm_phase<EpiQF, pg8::PanelOrder, false>(lds, g, S, E); }
            }
#endif
#ifndef NO_KV
            { const K256Store E{(bf16_t*)(ws + WS_BIG(0)), 1024, (const float*)(ws + WS_CKVSS), 1.0f / 256.0f, (bf16_t*)(ws + WS_BIG(7)), 1024, 0};
              gemm_k256(lds, (const bf16_t*)(ws + WS_BIG(4)) + (size_t)NTOK * 768 + (size_t)pm * 65536, (const bf16_t*)(ws + WS_WUKV), 32, pm * 256, E); }
#endif
        }
#endif
    }
    SEAM(3);
    if (IN(4)) { FRESH_IDS(); attn_phase(p, lds, c); }
    SEAM(4);
    if (IN(5)) { FRESH_IDS();
        LAS int* hist = (LAS int*)lds;
        { const int pm = c;
            bf16_t* Y = (bf16_t*)(ws + WS_BIG(2));
            { pg8::Gemm g{(const bf16_t*)(ws + WS_BIG(3)), (const bf16_t*)(ws + WS_WGLAO), 1024, nullptr}; pg8::PanelOrder S{pm, 4, 0};
              EpiGate<false> E{Y, (const unsigned char*)(ws + WS_BIG(5))}; pg8::gemm_phase<EpiGate<false>, pg8::PanelOrder, false>(lds, g, S, E); }
            { pg8::Gemm g{(const bf16_t*)(ws + WS_BIG(1)), (const bf16_t*)(ws + WS_WMLAO), 1024, nullptr}; pg8::PanelOrder S{pm, 4, 0};
              EpiGate<true> E{Y, (const unsigned char*)(ws + WS_BIG(6))}; pg8::gemm_phase<EpiGate<true>, pg8::PanelOrder, false>(lds, g, S, E); }
            wg_global_sync();
            { pg8::Gemm g{Y, (const bf16_t*)(ws + WS_WOUT), 1024, nullptr}; pg8::PanelOrder S{pm, 4, 0};
              EpiBf16 E{(bf16_t*)(ws + ((p.flags & 4096) ? WS_BIG(7) : WS_BIG(1))), 1024}; pg8::gemm_phase<EpiBf16, pg8::PanelOrder, false>(lds, g, S, E); }
            wg_global_sync();
            if (!(p.flags & 4)) {
                const int b = pm >> 3; const float* mod = (const float*)(ws + WS_MOD) + b * 6144;
                const bf16_t* mix = (const bf16_t*)(ws + ((p.flags & 4096) ? WS_BIG(7) : WS_BIG(1))); bf16_t* h2 = (bf16_t*)(ws + WS_BIG(4));
                f32x4 g1[4], gg[4], gb[4], s2v[4], h2v[4];
#pragma unroll
                for (int j = 0; j < 4; ++j) { const int ci = lane + 64 * j; g1[j] = ((const f32x4*)(mod + 2048))[ci] + 1.0f; gg[j] = ((const f32x4*)p.in[I_LN1G])[ci]; gb[j] = ((const f32x4*)p.in[I_LN1B])[ci];
                    s2v[j] = ((const f32x4*)(mod + 4096))[ci] + 1.0f; h2v[j] = ((const f32x4*)(mod + 3072))[ci]; }
                for (int r0 = 0; r0 < 32; r0 += 4) {
                    const int row0 = pm * 256 + wave * 32 + r0;
                    f32x4 v[4][4]; u32x2 mw[4][4];
#pragma unroll
                    for (int t = 0; t < 4; ++t)
#pragma unroll
                        for (int j = 0; j < 4; ++j) { v[t][j] = ((const f32x4*)(p.in[I_X] + (size_t)(row0 + t) * 1024))[lane + 64 * j]; mw[t][j] = ((const u32x2*)(mix + (size_t)(row0 + t) * 1024))[lane + 64 * j]; }
#pragma unroll
                    for (int t = 0; t < 4; ++t) {
                        float s = 0.f;
#pragma unroll
                        for (int j = 0; j < 4; ++j) { const u32x2 w = mw[t][j]; v[t][j] = v[t][j] * ALPHA + g1[j] * (f32x4){bflo(w.x), bfhi(w.x), bflo(w.y), bfhi(w.y)}; s += (v[t][j][0] + v[t][j][1]) + (v[t][j][2] + v[t][j][3]); }
                        const float mean = wave_sum(s) * (1.f / 1024.f); float q = 0.f;
#pragma unroll
                        for (int j = 0; j < 4; ++j) { v[t][j] = v[t][j] - mean; q += (v[t][j][0] * v[t][j][0] + v[t][j][1] * v[t][j][1]) + (v[t][j][2] * v[t][j][2] + v[t][j][3] * v[t][j][3]); }
                        const float rstd = rsqrtf(wave_sum(q) * (1.f / 1024.f) + LN_EPS);
#pragma unroll
                        for (int j = 0; j < 4; ++j) { const f32x4 x1 = v[t][j] * rstd * gg[j] + gb[j];
                            { u32x2 xw; xw.x = pk2(x1[0], x1[1]); xw.y = pk2(x1[2], x1[3]); ((u32x2*)(p.out + (size_t)(row0 + t) * 1024))[lane + 64 * j] = xw; }
                            const f32x4 hh = x1 * s2v[j] + h2v[j]; u32x2 w; w.x = pk2(hh[0], hh[1]); w.y = pk2(hh[2], hh[3]);
                            ((u32x2*)(h2 + (size_t)(row0 + t) * 1024))[lane + 64 * j] = w;
                            unsigned w8 = 0u; w8 = __builtin_amdgcn_cvt_pk_fp8_f32(hh[0], hh[1], w8, false); w8 = __builtin_amdgcn_cvt_pk_fp8_f32(hh[2], hh[3], w8, true);
                            ((unsigned*)(ws + WS_BIG(6) + 64 * MiB + (size_t)(row0 + t) * 1024))[lane + 64 * j] = w8; }
                    }
                }
            }
            wg_global_sync();
            { pg8::Gemm g{(const bf16_t*)(ws + WS_BIG(4)), (const bf16_t*)(ws + WS_WRT), 1024, nullptr}; pg8::PanelOrder S{pm, 1, 0};
              EpiF32 E{(float*)(ws + WS_BIG(0)), 256}; pg8::gemm_phase<EpiF32, pg8::PanelOrder, false>(lds, g, S, E); }
            { pg8::Gemm g{(const bf16_t*)(ws + WS_BIG(4)), (const bf16_t*)(ws + WS_WS13), 1024, nullptr}; pg8::PanelOrder S{pm, 2, 0};
              EpiGLU E{(bf16_t*)(ws + WS_BIG(0) + 64 * MiB), 1.0f, 0}; pg8::gemm_phase<EpiGLU, pg8::PanelOrder, false>(lds, g, S, E); }
            wg_global_sync();
            { const K256Store E{(bf16_t*)(ws + WS_BIG(7)), 1024, nullptr, 0.f, nullptr, 0, 0};
              gemm_k256(lds, (const bf16_t*)(ws + WS_BIG(0) + 64 * MiB) + (size_t)pm * 65536, (const bf16_t*)(ws + WS_WS2), 16, pm * 256, E); }
            if (!(p.flags & 8)) {
            LAS int* etab = (LAS int*)(lds + 1024);
            LAS int* lrk = (LAS int*)(lds + 1024 + 8192);
            __syncthreads();
            for (int r = 0; r < 32; r += 4) { const int rl = wave * 32 + r, row = pm * 256 + rl;
                route_rows<4>((const float*)(ws + WS_BIG(0)) + (size_t)row * 256, p.in[I_BRT], (int*)(ws + WS_TIDX) + row * 8, (float*)(ws + WS_TW) + row * 8, etab + rl * 8, lane); }
            __syncthreads();
            if (tid < 256) { int cnt = 0;
#pragma unroll 8
                for (int a2 = 0; a2 < 2048; ++a2) if (etab[a2] == tid) { lrk[a2] = cnt; ++cnt; }
                hist[tid] = cnt; }
            __syncthreads();
            if (tid < 256) ((int*)(ws + WS_CNTWG))[pm * 256 + tid] = hist[tid];
#pragma unroll
            for (int i = 0; i < 4; ++i) ((int*)(ws + WS_LRANK))[pm * 2048 + tid + 512 * i] = lrk[tid + 512 * i];
            __syncthreads();
            }
        }
    }
    SEAM(5);
    if (IN(6)) { FRESH_IDS();
        LAS int* pstart = (LAS int*)lds;
        LAS int* wbase = (LAS int*)(lds + 2048);
        LAS int* tot = (LAS int*)(lds + 4096);
        const int* cntwg = (const int*)(ws + WS_CNTWG);
        { const int pm = c;
            if (tid < 256) { int t = 0, bs = 0; for (int w = 0; w < 256; ++w) { const int v = cntwg[w * 256 + tid]; t += v; bs += (w < pm) ? v : 0; } tot[tid] = t; wbase[tid] = bs; }
            __syncthreads();
            if (tid == 0) { int run = 0; for (int e = 0; e < 256; ++e) { pstart[e] = run; run += (tot[e] + 255) & ~255; } pstart[256] = run; }
            __syncthreads();
            if (pm == 0 && tid <= 256) ((int*)(ws + WS_TAB))[tid] = pstart[tid];
            const int* tidx = (const int*)(ws + WS_TIDX); int* lrank = (int*)(ws + WS_LRANK);
            int* stok = (int*)(ws + WS_STOK);
#pragma unroll
            for (int i = 0; i < 4; ++i) { const int a = pm * 2048 + tid * 4 + i; const int e = tidx[a]; const int slot = pstart[e] + wbase[e] + lrank[a]; stok[slot] = a >> 3; ((int*)(ws + WS_SW))[a] = slot; }
            __syncthreads();
        }
        LAS unsigned* scr = (LAS unsigned*)(lds + 8192 + wave * 8448);
        bf16_t* e13 = (bf16_t*)(ws + WS_BIG(5)); bf16_t* e2 = (bf16_t*)(ws + WS_BIG(0));
        for (int it = gw; it < 256 * 192; it += ngw) {
            const int e = it / 192, r = it % 192;
            if (r < 128) tr_glu8_item(p.in[I_WE1] + (size_t)e * 262144, p.in[I_WE3] + (size_t)e * 262144, 1024, 256, (unsigned char*)e13 + (size_t)e * 524288, scr, r >> 3, r & 7, lane);
            else { const int r2 = r - 128; tr8_item(p.in[I_WE2] + (size_t)e * 262144, 256, 1024, (unsigned char*)e2 + (size_t)e * 262144, MapId{0}, scr, r2 >> 4, r2 & 15, lane); }
        }
    }
    SEAM(6);
    constexpr int GT = 1536, NGRP = 2;
    bf16_t* ffn = (bf16_t*)(ws + WS_BIG(7));
    unsigned char* out8 = ws + WS_BIG(1);
    bf16_t* hidscr = c < 192 ? (bf16_t*)(ws + WS_WIN) + (size_t)c * 65536 : (bf16_t*)(ws + WS_KR) + (size_t)(c - 192) * 65536;
    for (int grp = 0; grp < NGRP; ++grp) {
        const int phg = 7 + 2 * grp;
        if (IN(phg)) { FRESH_IDS();
            LAS int* pstart = (LAS int*)(lds + LDS_MISC + 256);
            for (int i = tid; i <= 256; i += NTHR) pstart[i] = ((const int*)(ws + WS_TAB))[i];
            __syncthreads();
            const int ntiles = pstart[256] >> 8;
            const int t1 = (grp + 1) * GT < ntiles ? (grp + 1) * GT : ntiles;
            for (int T = grp * GT + (c & 7) * 32 + (c >> 3); T < t1; T += G) {
                int e = 0; { int lo_ = 0, hi_ = 256; while (hi_ - lo_ > 1) { const int mid = (lo_ + hi_) >> 1; if ((pstart[mid] >> 8) <= T) lo_ = mid; else hi_ = mid; } e = lo_; }
                e = __builtin_amdgcn_readfirstlane(e);
                if (!(p.flags & 32)) { pg8::Gemm g{(const bf16_t*)(ws + WS_BIG(6) + 64 * MiB), (const bf16_t*)(ws + WS_BIG(5)) + (size_t)e * 262144, 512, (const int*)(ws + WS_STOK)}; pg8::PanelOrder S{T, 2, 0};
                  EpiGLU E{(bf16_t*)((unsigned char*)hidscr - (ptrdiff_t)T * 65536), 1.0f / 32.0f, 1}; pg8::gemm_phase<EpiGLU, pg8::PanelOrder, true, true>(lds, g, S, E); }
                wg_global_sync();
                if (!(p.flags & 64)) gemm_k256_f8(lds, (const unsigned char*)hidscr, ws + WS_BIG(0) + (size_t)e * 262144, 16, T * 256, out8 - (ptrdiff_t)grp * GT * 262144, 1024, 1.0f / 32.0f);
            }
        }
        SEAM(phg);
        if (IN(phg + 1)) { FRESH_IDS();
            const int s0 = grp * GT * 256, s1 = s0 + GT * 256;
            const int* slot_of = (const int*)(ws + WS_SW); const float* tw = (const float*)(ws + WS_TW);
            const bool fin = (grp == NGRP - 1);
#define F8_ACC(dst, w16, wk) do { const u32x4 w_ = (w16); const float k_ = (wk); _Pragma("unroll") for (int j_ = 0; j_ < 4; ++j_) { \
                const f32x2 lo_ = __builtin_amdgcn_cvt_pk_f32_fp8(w_[j_], false), hi_ = __builtin_amdgcn_cvt_pk_f32_fp8(w_[j_], true); \
                dst[j_] += (f32x4){lo_[0], lo_[1], hi_[0], hi_[1]} * k_; } } while (0)
            for (int m0 = gw * 4; m0 < NTOK; m0 += ngw * 4) {
                int sl = -1; float wv = 0.f;
                if (lane < 32) { sl = slot_of[m0 * 8 + lane]; wv = tw[m0 * 8 + lane] * (1.0f / F8_SCALE); }
                const bool hit = sl >= s0 && sl < s1;
                const unsigned long long bal = __ballot(hit);
                f32x4 a[4][4];
#pragma unroll
                for (int t = 0; t < 4; ++t) { const u32x4* fr4 = (const u32x4*)(ffn + (size_t)(m0 + t) * 1024) + 2 * lane; const u32x4 f0 = fr4[0], f1 = fr4[1];
                    unpack8(f0, a[t][0], a[t][1]); unpack8(f1, a[t][2], a[t][3]); }
                u32x4 rw[4][3]; float rwt[4][3];
#pragma unroll
                for (int t = 0; t < 4; ++t) {
                    unsigned mk = (unsigned)(bal >> (8 * t)) & 0xffu;
#pragma unroll
                    for (int q = 0; q < 3; ++q) {
                        const int k = mk ? __builtin_ctz(mk) : 0; const bool ok = mk != 0u; mk &= mk - 1u;
                        const int sk = __shfl(sl, 8 * t + k); rwt[t][q] = ok ? __shfl(wv, 8 * t + k) : 0.f;
                        u32x4 w = __builtin_nontemporal_load((const u32x4*)(out8 + (size_t)(ok ? sk - s0 : 0) * 1024) + lane); if (!ok) w = (u32x4){0u, 0u, 0u, 0u};
                        rw[t][q] = w;
                    }
                }
#pragma unroll
                for (int t = 0; t < 4; ++t) {
#pragma unroll
                    for (int q = 0; q < 3; ++q) F8_ACC(a[t], rw[t][q], rwt[t][q]);
                    unsigned mk = (unsigned)(bal >> (8 * t)) & 0xffu; mk &= mk - 1u; mk &= mk - 1u; mk &= mk - 1u;
                    while (mk) { const int k = __builtin_ctz(mk); mk &= mk - 1u; const int sk = __shfl(sl, 8 * t + k); const float wk = __shfl(wv, 8 * t + k);
                        const u32x4 w = __builtin_nontemporal_load((const u32x4*)(out8 + (size_t)(sk - s0) * 1024) + lane); F8_ACC(a[t], w, wk); }
                }
                if (!fin) {
#pragma unroll
                    for (int t = 0; t < 4; ++t) if (((bal >> (8 * t)) & 0xffull) != 0ull && !(p.flags & 16)) {
                        u32x4* fw4 = (u32x4*)(ffn + (size_t)(m0 + t) * 1024) + 2 * lane; fw4[0] = pack8(a[t][0], a[t][1]); fw4[1] = pack8(a[t][2], a[t][3]); }
                } else {
                    const int b = m0 >> 11; const float* gt2 = (const float*)(ws + WS_MOD) + b * 6144 + 5 * 1024;
                    f32x4 gv[4], lg[4], lb[4];
#pragma unroll
                    for (int j = 0; j < 4; ++j) { gv[j] = ((const f32x4*)gt2)[4 * lane + j] + 1.0f; lg[j] = ((const f32x4*)p.in[I_LN2G])[4 * lane + j]; lb[j] = ((const f32x4*)p.in[I_LN2B])[4 * lane + j]; }
                    f32x4 v[4][4];
#pragma unroll
                    for (int t = 0; t < 4; ++t)
#pragma unroll
                        for (int j = 0; j < 4; j += 2) { const u32x4 xw = ((const u32x4*)(p.out + (size_t)(m0 + t) * 1024))[2 * lane + (j >> 1)]; unpack8(xw, v[t][j], v[t][j + 1]); }
#pragma unroll
                    for (int t = 0; t < 4; ++t) {
                        float sacc = 0.f;
#pragma unroll
                        for (int j = 0; j < 4; ++j) { v[t][j] = v[t][j] * ALPHA + gv[j] * a[t][j]; sacc += (v[t][j][0] + v[t][j][1]) + (v[t][j][2] + v[t][j][3]); }
                        const float mean = wave_sum(sacc) * (1.f / 1024.f); float s2 = 0.f;
#pragma unroll
                        for (int j = 0; j < 4; ++j) { v[t][j] = v[t][j] - mean; s2 += (v[t][j][0] * v[t][j][0] + v[t][j][1] * v[t][j][1]) + (v[t][j][2] * v[t][j][2] + v[t][j][3] * v[t][j][3]); }
                        const float rstd = rsqrtf(wave_sum(s2) * (1.f / 1024.f) + LN_EPS);
#pragma unroll
                        for (int j = 0; j < 4; ++j) ((f32x4*)(p.out + (size_t)(m0 + t) * 1024))[4 * lane + j] = v[t][j] * rstd * lg[j] + lb[j];
                    }
                }
            }
#undef F8_ACC
        }
        if (grp < NGRP - 1) SEAM(phg + 1);
    }
}


__global__ void dump_bf16(const bf16_t* src, float* dst, size_t n) { for (size_t i = (size_t)blockIdx.x * blockDim.x + threadIdx.x; i < n; i += (size_t)gridDim.x * blockDim.x) dst[i] = bf2f(src[i]); }
extern "C" void kernel_launch(void* const* d_in, const int* in_sizes, int n_in, void* d_out, int out_size, void* d_ws, size_t ws_size, hipStream_t stream) {
    static int ready = 0;
    if (!ready) {
        if (n_in != 28 || out_size != NTOK * DM || ws_size < WS_END) { fprintf(stderr, "kernel_launch: unexpected problem (n_in %d out %d ws %zu need %zu)\n", n_in, out_size, ws_size, (size_t)WS_END); return; }
        if (hipFuncSetAttribute((const void*)mk_fwd, hipFuncAttributeMaxDynamicSharedMemorySize, LDS_BYTES) != hipSuccess) { fprintf(stderr, "kernel_launch: hipFuncSetAttribute failed\n"); return; }
        ready = 1;
    }
    (void)hipMemsetAsync((char*)d_ws + WS_CTL, 0, CTL_ZERO_BYTES, stream);
    Params p{};
    for (int i = 0; i < 28; ++i) p.in[i] = (const float*)d_in[i];
    p.out = (float*)d_out; p.ws = (unsigned char*)d_ws;
#if MK_ONE_LAUNCH
    p.ph_lo = 0; p.ph_hi = 11;
    hipLaunchKernelGGL(mk_fwd, dim3(NWG), dim3(NTHR), LDS_BYTES, stream, p);
#else
#ifndef DIAG_NPH
#define DIAG_NPH 11
#endif
#ifndef DIAG_REP_MASK
#define DIAG_REP_MASK 0
#endif
#ifndef DIAG_REP_FLAGS
#define DIAG_REP_FLAGS 1
#endif
    for (int k = 0; k < DIAG_NPH; ++k) { p.ph_lo = k; p.ph_hi = k + 1;
        if (((DIAG_REP_MASK >> k) & 1) && (DIAG_REP_FLAGS & ~31)) { p.flags = DIAG_REP_FLAGS; hipLaunchKernelGGL(mk_fwd, dim3(NWG), dim3(NTHR), LDS_BYTES, stream, p); }
        p.flags = 0; hipLaunchKernelGGL(mk_fwd, dim3(NWG), dim3(NTHR), LDS_BYTES, stream, p);
        if (((DIAG_REP_MASK >> k) & 1) && !(DIAG_REP_FLAGS & ~31)) { p.flags = DIAG_REP_FLAGS; hipLaunchKernelGGL(mk_fwd, dim3(NWG), dim3(NTHR), LDS_BYTES, stream, p); } }
#ifdef DIAG_DUMP
    hipLaunchKernelGGL(dump_bf16, dim3(2048), dim3(256), 0, stream, (const bf16_t*)((unsigned char*)d_ws + DIAG_DUMP), (float*)d_out, (size_t)NTOK * 1024);
#endif
#endif
}
```

```cpp
#include <hip/hip_runtime.h>
#include <cstdio>
#include <cstdint>

#ifndef MK_ONE_LAUNCH
#define MK_ONE_LAUNCH 1
#endif

#define GAS __attribute__((address_space(1)))
#define LAS __attribute__((address_space(3)))
typedef unsigned short bf16_t;
typedef short bf16x8 __attribute__((ext_vector_type(8)));
typedef short bf16x4 __attribute__((ext_vector_type(4)));
typedef float f32x4 __attribute__((ext_vector_type(4)));
typedef float f32x2 __attribute__((ext_vector_type(2)));
typedef unsigned u32x4 __attribute__((ext_vector_type(4)));
typedef unsigned u32x2 __attribute__((ext_vector_type(2)));

constexpr int NTOK = 65536, DM = 1024, SEQ = 2048, NB = 32;
constexpr int NWG = 256, NTHR = 512;
constexpr float LN_EPS = 1e-5f, RMS_EPS = 1e-6f;
constexpr float ALPHA = 1.189207115002721f;
constexpr float QSCALE = 0.07216878364870322f * 1.4426950408889634f;
constexpr int NSLOT = 589824;

constexpr size_t MiB = 1u << 20;
constexpr size_t WS_CTL = 0, CTL_ZERO_BYTES = 3 * MiB;
constexpr size_t WS_BAR = 16384;
constexpr size_t WS_MOD = 1 * MiB;
constexpr size_t WS_CQSS = 2 * MiB, WS_CKVSS = 2 * MiB + 256 * 1024;
constexpr size_t WS_TAB = 3 * MiB;
constexpr size_t WS_CNTWG = 3 * MiB + 64 * 1024;
constexpr size_t WS_WIN = 4 * MiB;
constexpr size_t WS_WGLAO = WS_WIN + 6400 * 1024 * 2;
constexpr size_t WS_WUQ = WS_WGLAO + 2 * MiB;
constexpr size_t WS_WUKV = WS_WUQ + 1536 * 768 * 2;
constexpr size_t WS_WMLAO = WS_WUKV + 1 * MiB;
constexpr size_t WS_WOUT = WS_WMLAO + 2 * MiB;
constexpr size_t WS_WRT = WS_WOUT + 2 * MiB;
constexpr size_t WS_WS13 = WS_WRT + 512 * 1024;
constexpr size_t WS_WS2 = WS_WS13 + 1 * MiB;
static_assert(WS_WS2 + 512 * 1024 <= 28 * MiB, "small weights");
constexpr size_t WS_TIDX = 28 * MiB, WS_TW = 30 * MiB, WS_LRANK = 32 * MiB, WS_STOK = 34 * MiB, WS_SW = 37 * MiB;
constexpr size_t WS_WIN8 = 52 * MiB;
constexpr size_t WS_KR = 40 * MiB;
constexpr size_t WS_GA = 48 * MiB;
constexpr size_t WS_BIG0 = 56 * MiB, BIGU = 128 * MiB;
#define WS_BIG(i) (WS_BIG0 + (size_t)(i) * BIGU)
constexpr size_t WS_END = WS_BIG0 + 8 * BIGU;

typedef __bf16 bf16v2_t __attribute__((ext_vector_type(2)));
__device__ __forceinline__ unsigned pk2(float lo, float hi) { const f32x2 v = {lo, hi}; const bf16v2_t r = __builtin_convertvector(v, bf16v2_t); return __builtin_bit_cast(unsigned, r); }
__device__ __forceinline__ float bflo(unsigned w) { return __uint_as_float(w << 16); }
__device__ __forceinline__ float bfhi(unsigned w) { return __uint_as_float(w & 0xffff0000u); }
__device__ __forceinline__ float bf2f(bf16_t b) { return __uint_as_float(((unsigned)b) << 16); }
__device__ __forceinline__ bf16_t f2bf(float f) { return (bf16_t)(pk2(f, 0.f) & 0xffffu); }
__device__ __forceinline__ float sigm(float x) { return __builtin_amdgcn_rcpf(1.0f + __expf(-x)); }
__device__ __forceinline__ float silu(float x) { return x * __builtin_amdgcn_rcpf(1.0f + __expf(-x)); }
__device__ __forceinline__ float wave_sum(float v) {
#pragma unroll
    for (int o = 1; o < 64; o <<= 1) v += __shfl_xor(v, o);
    return v;
}
#define LDS_WAIT() asm volatile("s_waitcnt lgkmcnt(0)" ::: "memory")
#define VM_WAIT() asm volatile("s_waitcnt vmcnt(0)" ::: "memory")

#define XB_TMO      128
#define XB_XCNT(j)  (256  + 64 * (j))
#define XB_XSUB(j)  (1280 + 64 * (j))
#define XB_XGEN(j)  (2304 + 64 * (j))
#define XB_TOP      3328
#define XB_TOPGEN   3392
#define XCD_BAR_WORDS 3456
#define XB_SPIN_CAP (1u << 18)
__device__ __forceinline__ unsigned xb_ld(unsigned* p)              { return __hip_atomic_load(p, __ATOMIC_RELAXED, __HIP_MEMORY_SCOPE_AGENT); }
__device__ __forceinline__ unsigned xb_add(unsigned* p, unsigned v) { return __hip_atomic_fetch_add(p, v, __ATOMIC_RELAXED, __HIP_MEMORY_SCOPE_AGENT); }
__device__ __forceinline__ unsigned xb_xcc_id() { return (unsigned)__builtin_amdgcn_s_getreg((3 << 11) | 20) & 0xFu; }
#define XB_SPIN(cond, bar) do { unsigned _sp = 0; while (cond) { __builtin_amdgcn_s_sleep(1); \
    if ((++_sp & 255u) == 0u) { if (xb_ld(&(bar)[XB_TMO])) break; if (_sp > XB_SPIN_CAP) { atomicAdd(&(bar)[XB_TMO], 1u); break; } } } } while (0)
struct XcdBarrier { unsigned* bar; unsigned x; volatile LAS unsigned* st; };
__device__ __forceinline__ XcdBarrier xcd_barrier_post(unsigned* bar, volatile LAS unsigned* st) {
    XcdBarrier b; b.bar = bar; b.x = xb_xcc_id(); b.st = st;
    if (threadIdx.x == 0) (void)xb_add(&bar[XB_XCNT(b.x)], 1u);
    return b;
}
__device__ __forceinline__ void xcd_barrier_complete(unsigned* bar, unsigned x, unsigned& nloc, unsigned& nx) {
    const unsigned G = gridDim.x * gridDim.y * gridDim.z;
    unsigned sum, cnt, mine, sp = 0u;
    for (;;) {
        sum = 0u; cnt = 0u; mine = 0u;
#pragma unroll
        for (unsigned j = 0; j < 16; ++j) { const unsigned c = xb_ld(&bar[XB_XCNT(j)]); sum += c; cnt += (c > 0u) ? 1u : 0u; mine = (j == x) ? c : mine; }
        if (sum == G) break;
        __builtin_amdgcn_s_sleep(1);
        if ((++sp & 255u) == 0u) { if (xb_ld(&bar[XB_TMO])) break; if (sp > XB_SPIN_CAP) { atomicAdd(&bar[XB_TMO], 1u); break; } }
    }
    nloc = mine > 0u ? mine : 1u; nx = cnt > 0u ? cnt : 1u;
}
__device__ __forceinline__ void xcd_barrier(const XcdBarrier& b) {
    asm volatile("s_waitcnt vmcnt(0)" ::: "memory");
    __syncthreads();
    if (threadIdx.x == 0) {
        unsigned* bar = b.bar;
        __builtin_amdgcn_s_waitcnt(0);
        unsigned nloc = b.st[0], nx = b.st[1];
        if (nloc == 0u) { xcd_barrier_complete(bar, b.x, nloc, nx); b.st[0] = nloc; b.st[1] = nx; }
        const unsigned old = xb_add(&bar[XB_XSUB(b.x)], 1u);
        const unsigned gen = old / nloc;
        if (old + 1u == (gen + 1u) * nloc) {
            __builtin_amdgcn_fence(__ATOMIC_RELEASE, "agent");
            asm volatile("s_waitcnt vmcnt(0)" ::: "memory");
            const unsigned og = xb_add(&bar[XB_TOP], 1u);
            const unsigned tg = og / nx;
            if (og + 1u == (tg + 1u) * nx) xb_add(&bar[XB_TOPGEN], 1u);
            else XB_SPIN(xb_ld(&bar[XB_TOPGEN]) == tg, bar);
            __builtin_amdgcn_fence(__ATOMIC_ACQUIRE, "agent");
            xb_add(&bar[XB_XGEN(b.x)], 1u);
            asm volatile("s_waitcnt vmcnt(0)" ::: "memory");
        } else {
            XB_SPIN(xb_ld(&bar[XB_XGEN(b.x)]) == gen, bar);
            __builtin_amdgcn_fence(__ATOMIC_ACQUIRE, "agent");
            asm volatile("s_waitcnt vmcnt(0)" ::: "memory");
        }
    }
    __syncthreads();
}
__device__ __forceinline__ void wg_global_sync() {
    asm volatile("s_waitcnt vmcnt(0)" ::: "memory");
    __syncthreads();
    if (threadIdx.x < 64) {
        __builtin_amdgcn_fence(__ATOMIC_ACQUIRE, "agent");
        asm volatile("s_waitcnt vmcnt(0)" ::: "memory");
    }
    __syncthreads();
}

namespace pg8 {
constexpr int BM = 256, BK = 64, HALF = 128, HTB = HALF * BK * 2, STAGE_BYTES = 8 * HTB;
__host__ __device__ __forceinline__ int lds_byte(int r, int c) { const int st = (r >> 4) * 2 + (c >> 5), rr = r & 15, cc = c & 31, ob = rr * 64 + cc * 2; return st * 1024 + (ob ^ (((ob >> 9) & 1) << 5)); }
__host__ __device__ __forceinline__ void stage_rc(int b, int& R, int& C) { const int st = b / 1024, sb = b % 1024, swz = sb ^ (((sb >> 9) & 1) << 5); R = (st >> 1) * 16 + swz / 64; C = (st & 1) * 32 + (swz % 64) / 2; }
__host__ __device__ __forceinline__ int perm32(int rho) { const int n = rho >> 4, i = rho & 15; return 8 * (i >> 2) + 4 * n + (i & 3); }
struct Unit { int pm, pn; };
struct Gemm { const bf16_t* A; const bf16_t* Bt; int K; const int* rowidx; };
struct StaticOrder {
    int nM, nN, nwg, G, c, remap;
    __device__ void init(int M, int N, int G_, int c_) { nM = M / BM; nN = N / BM; nwg = nM * nN; G = G_; c = c_; remap = 0; }
    __device__ bool next(int i, Unit& u) const {
        const long L = (long)i * G + c; if (L >= nwg) return false;
        int wgid = (int)L; { const int q = nwg / 8, r = nwg % 8, xcd = wgid % 8, off = wgid / 8; wgid = (xcd < r ? xcd * (q + 1) : r * (q + 1) + (xcd - r) * q) + off; }
        const int nig = 8 * nN, gid = wgid / nig, fm = gid * 8, gsz = (nM - fm) < 8 ? (nM - fm) : 8;
        u.pm = fm + ((wgid % nig) % gsz); u.pn = (wgid % nig) / gsz; if (remap) u.pn = u.pn < 8 ? u.pn : u.pn < 12 ? u.pn + 4 : 24; return true;
    }
};
struct PanelOrder {
    int pm, nN, pn0;
    __device__ bool next(int i, Unit& u) const { int nq = nN; asm volatile("; opaque nN" : "+s"(nq)); if (i >= nq) return false; int a = pm, b = pn0 + i; asm volatile("; opaque unit" : "+s"(a), "+s"(b)); u.pm = a; u.pn = b; return true; }
};

typedef int i32x8 __attribute__((ext_vector_type(8)));
template <class Epi, class Sched, bool GATHER, bool FP8 = false>
__device__ __forceinline__ void gemm_phase(LAS unsigned char* lds, const Gemm g, const Sched& S, const Epi& E) {
    int tid_ = threadIdx.x; asm volatile("; pg8 ids" : "+v"(tid_));
    const int tid = tid_, wid = __builtin_amdgcn_readfirstlane(tid >> 6), lane = tid & 63, wr = wid >> 2, wc = wid & 3, fr = lane & 15, fq = lane >> 4;
    int Kq = g.K; asm volatile("; opaque K" : "+s"(Kq));
    const int K = Kq, nt = K / BK;
    Unit cur, nxt; int ui = 0;
    if (!S.next(0, cur)) return;
    unsigned aoff[2][2], voffB[2];
#pragma unroll
    for (int i = 0; i < 2; ++i) { int R, C; stage_rc(tid * 16 + i * 8192, R, C); const int Rb = Epi::PERM ? ((R & ~31) + perm32(R & 31)) : R;
        voffB[i] = (unsigned)(Rb * K + C) * 2u;
#pragma unroll
        for (int h = 0; h < 2; ++h) {
            if (GATHER) { int t = g.rowidx[cur.pm * BM + h * HALF + R]; t = t < 0 ? 0 : t; aoff[h][i] = (unsigned)(t * K + C) * 2u; }
            else aoff[h][i] = (unsigned)((h * HALF + R) * K + C) * 2u;
        } }
    const size_t kstep = (size_t)(BK * 2);
    const size_t hstep = (size_t)HALF * K * 2;
    const size_t tstep = 2 * hstep;
    const unsigned ldsw = (unsigned)wid * 1024u;
    const int aoffl0 = lds_byte(wr * 64 + fr, fq * 8), aoffl1 = aoffl0 + 1024;
    const int boffl0 = lds_byte(wc * 32 + fr, fq * 8), boffl1 = boffl0 + 1024;
#define PG8_SA(b, h) (((b) * 2 + (h)) * HTB)
#define PG8_SB(b, h) ((4 + (b) * 2 + (h)) * HTB)
#define PG8_STAGE(bufoff, gbase, voff) do { _Pragma("unroll") for (int _i = 0; _i < 2; ++_i) \
        __builtin_amdgcn_global_load_lds((const unsigned*)((const char*)(gbase) + (voff)[_i]), (LAS unsigned*)(lds + (bufoff) + ldsw + _i * 8192), 16, 0, 0); } while (0)
#define PG8_STAGE_A(bufoff, gbase, h) PG8_STAGE(bufoff, gbase, aoff[h])
#define PG8_LDA(dst, b, h) do { _Pragma("unroll") for (int m = 0; m < 4; ++m) _Pragma("unroll") for (int k = 0; k < 2; ++k) dst[m][k] = *(const LAS bf16x8*)(lds + PG8_SA(b, h) + aoffl0 + m * 2048 + k * 1024); } while (0)
#define PG8_LDA8(dst, b, h) do { _Pragma("unroll") for (int m = 0; m < 4; ++m) { const u32x4 x0_ = *(const LAS u32x4*)(lds + PG8_SA(b, h) + aoffl0 + m * 2048), x1_ = *(const LAS u32x4*)(lds + PG8_SA(b, h) + aoffl1 + m * 2048); dst[m] = __builtin_bit_cast(i32x8, __builtin_shufflevector(x0_, x1_, 0, 1, 2, 3, 4, 5, 6, 7)); } } while (0)
#define PG8_LDB(dst, b, h) do { _Pragma("unroll") for (int n = 0; n < 2; ++n) _Pragma("unroll") for (int k = 0; k < 2; ++k) dst[n][k] = *(const LAS bf16x8*)(lds + PG8_SB(b, h) + boffl0 + n * 2048 + k * 1024); } while (0)
#define PG8_LDB8(dst, b, h) do { _Pragma("unroll") for (int n = 0; n < 2; ++n) { const u32x4 x0_ = *(const LAS u32x4*)(lds + PG8_SB(b, h) + boffl0 + n * 2048), x1_ = *(const LAS u32x4*)(lds + PG8_SB(b, h) + boffl1 + n * 2048); dst[n] = __builtin_bit_cast(i32x8, __builtin_shufflevector(x0_, x1_, 0, 1, 2, 3, 4, 5, 6, 7)); } } while (0)
#define PG8_MMA(ai, bj, At, Bt) do { __builtin_amdgcn_s_setprio(1); _Pragma("unroll") for (int m = 0; m < 4; ++m) _Pragma("unroll") for (int n = 0; n < 2; ++n) _Pragma("unroll") for (int k = 0; k < 2; ++k) \
        acc[ai][bj][m][n] = __builtin_amdgcn_mfma_f32_16x16x32_bf16(Bt[n][k], At[m][k], acc[ai][bj][m][n], 0, 0, 0); __builtin_amdgcn_s_setprio(0); } while (0)
#define PG8_MMA8(ai, bj, At, Bt) do { __builtin_amdgcn_s_setprio(1); _Pragma("unroll") for (int m = 0; m < 4; ++m) _Pragma("unroll") for (int n = 0; n < 2; ++n) \
        asm volatile("v_mfma_f32_16x16x128_f8f6f4 %0, %1, %2, %0" : "+v"(acc[ai][bj][m][n]) : "v"(Bt[n]), "v"(At[m])); __builtin_amdgcn_s_setprio(0); } while (0)
#define PG8_WAIT_V(n) asm volatile("s_waitcnt vmcnt(" #n ")" ::: "memory")
#define PG8_WAIT_L(n) asm volatile("s_waitcnt lgkmcnt(" #n ")" ::: "memory")
#define PG8_BAR __builtin_amdgcn_s_barrier()
#define PG8_SCHED __builtin_amdgcn_sched_barrier(0)
    f32x4 acc[2][2][4][2];
#pragma unroll
    for (int a = 0; a < 2; ++a)
#pragma unroll
        for (int b = 0; b < 2; ++b)
#pragma unroll
            for (int m = 0; m < 4; ++m)
#pragma unroll
                for (int n = 0; n < 2; ++n) acc[a][b][m][n] = (f32x4){0.f, 0.f, 0.f, 0.f};
    bf16x8 At[4][2], B0[2][2], B1[2][2]; i32x8 At8[4], B08[2], B18[2];
    const char* cA = (const char*)g.A + (GATHER ? (size_t)0 : (size_t)cur.pm * tstep); const char* cB = (const char*)g.Bt + (size_t)cur.pn * tstep;
    if (GATHER) PG8_WAIT_V(0);
    PG8_STAGE(PG8_SB(0, 0), cB, voffB); PG8_STAGE_A(PG8_SA(0, 0), cA, 0); PG8_STAGE(PG8_SB(0, 1), cB + hstep, voffB); PG8_STAGE_A(PG8_SA(0, 1), cA, 1);
    if (wr == 1) PG8_BAR;
    PG8_WAIT_V(4); PG8_BAR;
    PG8_STAGE(PG8_SB(1, 0), cB + kstep, voffB); PG8_STAGE_A(PG8_SA(1, 0), cA + kstep, 0); PG8_STAGE(PG8_SB(1, 1), cB + hstep + kstep, voffB);
    PG8_WAIT_V(6); PG8_BAR;
    for (;;) {
        const bool has_next = S.next(ui + 1, nxt);
        const char* nA = has_next ? (const char*)g.A + (GATHER ? (size_t)0 : (size_t)nxt.pm * tstep) : cA; const char* nB = has_next ? (const char*)g.Bt + (size_t)nxt.pn * tstep : cB;
        for (int t = 0; t < nt; t += 2) {
            const bool last = (t == nt - 2);
            const char* a1 = cA + (size_t)(t + 1) * kstep;
            const char* a2 = last ? nA : cA + (size_t)(t + 2) * kstep; const char* b2 = last ? nB : cB + (size_t)(t + 2) * kstep;
            const char* a3 = a2 + kstep; const char* b3 = b2 + kstep;
            if constexpr (FP8) {
            PG8_LDB8(B08, 0, 0); PG8_SCHED; PG8_LDA8(At8, 0, 0); PG8_STAGE_A(PG8_SA(1, 1), a1, 1);
            PG8_WAIT_L(8); PG8_BAR; PG8_WAIT_L(0); PG8_MMA8(0, 0, At8, B08); PG8_BAR; PG8_SCHED;
            PG8_LDB8(B18, 0, 1); PG8_STAGE(PG8_SB(0, 0), b2, voffB);
            PG8_BAR; PG8_WAIT_L(0); PG8_MMA8(0, 1, At8, B18); PG8_BAR;
            PG8_LDA8(At8, 0, 1); PG8_STAGE_A(PG8_SA(0, 0), a2, 0);
            PG8_BAR; PG8_WAIT_L(0); PG8_MMA8(1, 0, At8, B08); PG8_BAR; PG8_SCHED;
            PG8_STAGE(PG8_SB(0, 1), b2 + hstep, voffB);
            PG8_WAIT_V(6); PG8_BAR; PG8_MMA8(1, 1, At8, B18); PG8_BAR;
            PG8_LDB8(B08, 1, 0); PG8_SCHED; PG8_LDA8(At8, 1, 0); PG8_STAGE_A(PG8_SA(0, 1), a2, 1);
            PG8_WAIT_L(8); PG8_BAR; PG8_WAIT_L(0); PG8_MMA8(0, 0, At8, B08); PG8_BAR; PG8_SCHED;
            PG8_LDB8(B18, 1, 1); PG8_STAGE(PG8_SB(1, 0), b3, voffB);
            PG8_BAR; PG8_WAIT_L(0); PG8_MMA8(0, 1, At8, B18); PG8_BAR;
            PG8_LDA8(At8, 1, 1); PG8_STAGE_A(PG8_SA(1, 0), a3, 0);
            PG8_BAR; PG8_WAIT_L(0); PG8_MMA8(1, 0, At8, B08); PG8_BAR; PG8_SCHED;
            PG8_STAGE(PG8_SB(1, 1), b3 + hstep, voffB);
            PG8_WAIT_V(6); PG8_BAR; PG8_MMA8(1, 1, At8, B18); PG8_BAR;
            } else {
            PG8_LDB(B0, 0, 0); PG8_SCHED; PG8_LDA(At, 0, 0); PG8_STAGE_A(PG8_SA(1, 1), a1, 1);
            PG8_WAIT_L(8); PG8_BAR; PG8_WAIT_L(0); PG8_MMA(0, 0, At, B0); PG8_BAR; PG8_SCHED;
            PG8_LDB(B1, 0, 1); PG8_STAGE(PG8_SB(0, 0), b2, voffB);
            PG8_BAR; PG8_WAIT_L(0); PG8_MMA(0, 1, At, B1); PG8_BAR;
            PG8_LDA(At, 0, 1); PG8_STAGE_A(PG8_SA(0, 0), a2, 0);
            PG8_BAR; PG8_WAIT_L(0); PG8_MMA(1, 0, At, B0); PG8_BAR; PG8_SCHED;
            PG8_STAGE(PG8_SB(0, 1), b2 + hstep, voffB);
            PG8_WAIT_V(6); PG8_BAR; PG8_MMA(1, 1, At, B1); PG8_BAR;
            PG8_LDB(B0, 1, 0); PG8_SCHED; PG8_LDA(At, 1, 0); PG8_STAGE_A(PG8_SA(0, 1), a2, 1);
            PG8_WAIT_L(8); PG8_BAR; PG8_WAIT_L(0); PG8_MMA(0, 0, At, B0); PG8_BAR; PG8_SCHED;
            PG8_LDB(B1, 1, 1); PG8_STAGE(PG8_SB(1, 0), b3, voffB);
            PG8_BAR; PG8_WAIT_L(0); PG8_MMA(0, 1, At, B1); PG8_BAR;
            PG8_LDA(At, 1, 1); PG8_STAGE_A(PG8_SA(1, 0), a3, 0);
            PG8_BAR; PG8_WAIT_L(0); PG8_MMA(1, 0, At, B0); PG8_BAR; PG8_SCHED;
            PG8_STAGE(PG8_SB(1, 1), b3 + hstep, voffB);
            PG8_WAIT_V(6); PG8_BAR; PG8_MMA(1, 1, At, B1); PG8_BAR;
            }
        }
        if constexpr (FP8) asm volatile("s_nop 15\n\ts_nop 15\n\ts_nop 15\n\ts_nop 15" ::: "memory");
        E(acc, cur, wr, wc, fr, fq);
        if (!has_next) break;
#pragma unroll
        for (int a = 0; a < 2; ++a)
#pragma unroll
            for (int b = 0; b < 2; ++b)
#pragma unroll
                for (int m = 0; m < 4; ++m)
#pragma unroll
                    for (int n = 0; n < 2; ++n) acc[a][b][m][n] = (f32x4){0.f, 0.f, 0.f, 0.f};
        cur = nxt; cA = nA; cB = nB; ++ui;
    }
    PG8_WAIT_V(0);
    if (wr == 0) PG8_BAR;
    PG8_BAR;
#undef PG8_SA
#undef PG8_SB
#undef PG8_STAGE
#undef PG8_STAGE_A
#undef PG8_LDA
#undef PG8_LDB
#undef PG8_MMA
#undef PG8_MMA8
#undef PG8_LDA8
#undef PG8_LDB8
#undef PG8_WAIT_V
#undef PG8_WAIT_L
#undef PG8_BAR
#undef PG8_SCHED
}
}
using pg8::Unit;
typedef f32x4 AccT[2][2][4][2];

typedef float f32x16 __attribute__((ext_vector_type(16)));
#ifndef K256_DIST
#define K256_DIST 2
#endif
constexpr int K256_BUF = 32768, K256_NB = 3, K256_SCR_OFF = K256_NB * K256_BUF, K256_SCR_WAVE = 4608;
struct K256Store {
    bf16_t* O; int ld; const float* rs; float rs_mul; bf16_t* O2; int split; int fp8;
};
constexpr float F8_SCALE = 16.0f;
__device__ __forceinline__ void gemm_k256(LAS unsigned char* lds, const bf16_t* A, const bf16_t* Bt, int nchunks, int row0, const K256Store& E) {
    int tid_ = threadIdx.x; asm volatile("; k256 ids" : "+v"(tid_));
    const int tid = tid_, lane = tid & 63, wave = __builtin_amdgcn_readfirstlane(tid >> 6), r = lane & 31, h = lane >> 5;
    bf16x8 af[16];
    { const bf16_t* arow = A + (size_t)(32 * wave + r) * 256 + 8 * h;
#pragma unroll
      for (int s = 0; s < 16; ++s) af[s] = *(const bf16x8*)(arow + 16 * s); }
    float rscale = 1.0f;
    if (E.rs) rscale = rsqrtf(E.rs[row0 + 32 * wave + r] * E.rs_mul + RMS_EPS);
    unsigned foff[4];
#pragma unroll
    for (int q = 0; q < 4; ++q) { const int n = 2 * (4 * wave + q) + (lane >> 5); foff[q] = (unsigned)(n * 256 + (((lane & 31) ^ (n & 15)) << 3)) * 2u; }
#define K256_FILL(chunk, buf) do { const char* _src = (const char*)Bt + (size_t)(chunk) * (64 * 256 * 2); _Pragma("unroll") for (int q = 0; q < 4; ++q) \
        __builtin_amdgcn_global_load_lds((const unsigned*)(_src + foff[q]), (LAS unsigned*)(lds + (buf) * K256_BUF + (4 * wave + q) * 1024), 16, 0, 0); } while (0)
    K256_FILL(0, 0);
    if (K256_DIST == 2 && nchunks > 1) K256_FILL(1, 1);
    const int boff = (r * 32) * 16;
    LAS unsigned char* scr = lds + K256_SCR_OFF + wave * K256_SCR_WAVE;
    for (int i = 0; i < nchunks; ++i) {
        {
            const int ns = E.fp8 ? 2 : 4;
            const int yo = K256_DIST == 2 ? ns * ((i >= 2 ? 1 : 0) + (i >= 1 ? 1 : 0)) + (i + 1 < nchunks ? 4 : 0) : ns * (i >= 1 ? 1 : 0);
            if (yo >= 12) asm volatile("s_waitcnt vmcnt(12)" ::: "memory"); else if (yo >= 8) asm volatile("s_waitcnt vmcnt(8)" ::: "memory");
            else if (yo >= 6) asm volatile("s_waitcnt vmcnt(6)" ::: "memory"); else if (yo >= 4) asm volatile("s_waitcnt vmcnt(4)" ::: "memory");
            else if (yo >= 2) asm volatile("s_waitcnt vmcnt(2)" ::: "memory"); else asm volatile("s_waitcnt vmcnt(0)" ::: "memory");
        }
        __builtin_amdgcn_s_barrier(); asm volatile("" ::: "memory");
        if (i + K256_DIST < nchunks) K256_FILL(i + K256_DIST, (i + K256_DIST) % K256_NB);
        const LAS unsigned char* bb = lds + (i % K256_NB) * K256_BUF + boff;
        f32x16 acc0, acc1;
#pragma unroll
        for (int j = 0; j < 16; ++j) { acc0[j] = 0.f; acc1[j] = 0.f; }
        {
            bf16x8 bq[3][2];
#define K256_LDB(s_) do { const int co_ = (((2 * (s_) + h) ^ (r & 15)) << 4); bq[(s_) % 3][0] = *(const LAS bf16x8*)(bb + co_); bq[(s_) % 3][1] = *(const LAS bf16x8*)(bb + 32 * 512 + co_); } while (0)
            K256_LDB(0); K256_LDB(1);
#pragma unroll
            for (int s = 0; s < 16; ++s) {
                if (s + 2 < 16) K256_LDB(s + 2);
                acc0 = __builtin_amdgcn_mfma_f32_32x32x16_bf16(bq[s % 3][0], af[s], acc0, 0, 0, 0);
                acc1 = __builtin_amdgcn_mfma_f32_32x32x16_bf16(bq[s % 3][1], af[s], acc1, 0, 0, 0);
            }
            __builtin_amdgcn_sched_group_barrier(0x100, 4, 0);
#pragma unroll
            for (int s = 0; s < 16; ++s) { if (s + 2 < 16) __builtin_amdgcn_sched_group_barrier(0x100, 2, 0); __builtin_amdgcn_sched_group_barrier(0x008, 2, 0); }
#undef K256_LDB
        }
        if (E.fp8) {
#pragma unroll
            for (int g = 0; g < 4; ++g) {
                unsigned d0 = 0u, d1 = 0u;
                d0 = __builtin_amdgcn_cvt_pk_fp8_f32(acc0[4 * g] * F8_SCALE, acc0[4 * g + 1] * F8_SCALE, d0, false); d0 = __builtin_amdgcn_cvt_pk_fp8_f32(acc0[4 * g + 2] * F8_SCALE, acc0[4 * g + 3] * F8_SCALE, d0, true);
                d1 = __builtin_amdgcn_cvt_pk_fp8_f32(acc1[4 * g] * F8_SCALE, acc1[4 * g + 1] * F8_SCALE, d1, false); d1 = __builtin_amdgcn_cvt_pk_fp8_f32(acc1[4 * g + 2] * F8_SCALE, acc1[4 * g + 3] * F8_SCALE, d1, true);
                *(LAS unsigned*)(scr + r * 80 + 8 * g + 4 * h) = d0; *(LAS unsigned*)(scr + r * 80 + 32 + 8 * g + 4 * h) = d1;
            }
            asm volatile("s_waitcnt lgkmcnt(0)" ::: "memory");
            unsigned char* ob8 = (unsigned char*)E.O;
#pragma unroll
            for (int pq = 0; pq < 2; ++pq) { const int rr = (lane >> 2) + 16 * pq;
                const u32x4 v = *(const LAS u32x4*)(scr + rr * 80 + (lane & 3) * 16);
                __builtin_nontemporal_store(v, (u32x4*)(ob8 + (size_t)(row0 + 32 * wave + rr) * E.ld + i * 64 + (lane & 3) * 16)); }
        } else {
#pragma unroll
        for (int g = 0; g < 4; ++g) {
            u32x2 w0, w1;
            w0.x = pk2(acc0[4 * g] * rscale, acc0[4 * g + 1] * rscale); w0.y = pk2(acc0[4 * g + 2] * rscale, acc0[4 * g + 3] * rscale);
            w1.x = pk2(acc1[4 * g] * rscale, acc1[4 * g + 1] * rscale); w1.y = pk2(acc1[4 * g + 2] * rscale, acc1[4 * g + 3] * rscale);
            *(LAS u32x2*)(scr + r * 144 + (8 * g + 4 * h) * 2) = w0; *(LAS u32x2*)(scr + r * 144 + 64 + (8 * g + 4 * h) * 2) = w1;
        }
        asm volatile("s_waitcnt lgkmcnt(0)" ::: "memory");
        int col = i * 64 + (lane & 7) * 8; bf16_t* ob = E.O;
        if (E.O2 && col >= E.split) { col -= E.split; ob = E.O2; }
#pragma unroll
        for (int pq = 0; pq < 4; ++pq) { const int rr = (lane >> 3) + 8 * pq;
            const u32x4 v = *(const LAS u32x4*)(scr + rr * 144 + (lane & 7) * 16);
            *(u32x4*)(ob + (size_t)(row0 + 32 * wave + rr) * E.ld + col) = v; }
        }
    }
#undef K256_FILL
    asm volatile("s_waitcnt vmcnt(0) lgkmcnt(0)" ::: "memory");
    __builtin_amdgcn_s_barrier(); asm volatile("" ::: "memory");
}


typedef int i32x8k __attribute__((ext_vector_type(8)));
constexpr int K8_BUF = 32768, K8_SCR_OFF = 3 * K8_BUF;
__device__ __forceinline__ void gemm_k256_f8(LAS unsigned char* lds, const unsigned char* A8, const unsigned char* Bt8, int nchunks  , int row0, unsigned char* O8, int ld, float oscale) {
    int tid_ = threadIdx.x; asm volatile("; k256f8 ids" : "+v"(tid_));
    const int tid = tid_, lane = tid & 63, wave = __builtin_amdgcn_readfirstlane(tid >> 6), r = lane & 31, h = lane >> 5;
    i32x8k af[4];
    { const unsigned char* arow = A8 + (size_t)(32 * wave + r) * 256 + 32 * h;
#pragma unroll
      for (int s = 0; s < 4; ++s) { const u32x4 x0 = *(const u32x4*)(arow + 64 * s), x1 = *(const u32x4*)(arow + 64 * s + 16); af[s] = __builtin_bit_cast(i32x8k, __builtin_shufflevector(x0, x1, 0, 1, 2, 3, 4, 5, 6, 7)); } }
    unsigned foff[4];
#pragma unroll
    for (int q = 0; q < 4; ++q) { const int n = 4 * (4 * wave + q) + (lane >> 4); foff[q] = (unsigned)(n * 256 + (((lane & 15) ^ (n & 15)) << 4)); }
#define K8_FILL(chunk, buf) do { const unsigned char* _src = Bt8 + (size_t)(chunk) * (128 * 256); _Pragma("unroll") for (int q = 0; q < 4; ++q) \
        __builtin_amdgcn_global_load_lds((const unsigned*)(_src + foff[q]), (LAS unsigned*)(lds + (buf) * K8_BUF + (4 * wave + q) * 1024), 16, 0, 0); } while (0)
    K8_FILL(0, 0);
    if (nchunks > 1) K8_FILL(1, 1);
    LAS unsigned char* scr = lds + K8_SCR_OFF + wave * 4608;
    const float osc = F8_SCALE * oscale;
    for (int i = 0; i < nchunks; ++i) {
        {
            const int yo = 4 * ((i >= 2 ? 1 : 0) + (i >= 1 ? 1 : 0) + (i + 1 < nchunks ? 1 : 0));
            if (yo >= 12) asm volatile("s_waitcnt vmcnt(12)" ::: "memory"); else if (yo >= 8) asm volatile("s_waitcnt vmcnt(8)" ::: "memory");
            else if (yo >= 4) asm volatile("s_waitcnt vmcnt(4)" ::: "memory"); else asm volatile("s_waitcnt vmcnt(0)" ::: "memory");
        }
        __builtin_amdgcn_s_barrier(); asm volatile("" ::: "memory");
        if (i + 2 < nchunks) K8_FILL(i + 2, (i + 2) % 3);
        const LAS unsigned char* bb = lds + (i % 3) * K8_BUF + r * 256;
        f32x16 acc[4];
#pragma unroll
        for (int nt = 0; nt < 4; ++nt)
#pragma unroll
            for (int j = 0; j < 16; ++j) acc[nt][j] = 0.f;
        i32x8k bq[2][4];
#define K8_LDB(s_) do { const int c0_ = ((4 * (s_) + 2 * h) ^ (r & 15)) << 4, c1_ = ((4 * (s_) + 2 * h + 1) ^ (r & 15)) << 4; _Pragma("unroll") for (int nt = 0; nt < 4; ++nt) { \
            const u32x4 p0_ = *(const LAS u32x4*)(bb + nt * 32 * 256 + c0_), p1_ = *(const LAS u32x4*)(bb + nt * 32 * 256 + c1_); \
            bq[(s_) & 1][nt] = __builtin_bit_cast(i32x8k, __builtin_shufflevector(p0_, p1_, 0, 1, 2, 3, 4, 5, 6, 7)); } } while (0)
        K8_LDB(0);
#pragma unroll
        for (int s = 0; s < 4; ++s) {
            if (s + 1 < 4) K8_LDB(s + 1);
#pragma unroll
            for (int nt = 0; nt < 4; ++nt) acc[nt] = __builtin_amdgcn_mfma_scale_f32_32x32x64_f8f6f4(bq[s & 1][nt], af[s], acc[nt], 0, 0, 0, 0, 0, 0);
        }
#undef K8_LDB
#pragma unroll
        for (int nt = 0; nt < 4; ++nt)
#pragma unroll
            for (int g = 0; g < 4; ++g) {
                unsigned d0 = 0u;
                d0 = __builtin_amdgcn_cvt_pk_fp8_f32(acc[nt][4 * g] * osc, acc[nt][4 * g + 1] * osc, d0, false); d0 = __builtin_amdgcn_cvt_pk_fp8_f32(acc[nt][4 * g + 2] * osc, acc[nt][4 * g + 3] * osc, d0, true);
                *(LAS unsigned*)(scr + r * 144 + 32 * nt + 8 * g + 4 * h) = d0;
            }
        asm volatile("s_waitcnt lgkmcnt(0)" ::: "memory");
#pragma unroll
        for (int pq = 0; pq < 4; ++pq) { const int rr = (lane >> 3) + 8 * pq;
            const u32x4 v = *(const LAS u32x4*)(scr + rr * 144 + (lane & 7) * 16);
            __builtin_nontemporal_store(v, (u32x4*)(O8 + (size_t)(row0 + 32 * wave + rr) * ld + i * 128 + (lane & 7) * 16)); }
    }
#undef K8_FILL
    asm volatile("s_waitcnt vmcnt(0) lgkmcnt(0)" ::: "memory");
    __builtin_amdgcn_s_barrier(); asm volatile("" ::: "memory");
}

__device__ __forceinline__ u32x4 pack8(const f32x4 a, const f32x4 b) { u32x4 w; w.x = pk2(a[0], a[1]); w.y = pk2(a[2], a[3]); w.z = pk2(b[0], b[1]); w.w = pk2(b[2], b[3]); return w; }
__device__ __forceinline__ void unpack8(const u32x4 w, f32x4& a, f32x4& b) { a = (f32x4){bflo(w.x), bfhi(w.x), bflo(w.y), bfhi(w.y)}; b = (f32x4){bflo(w.z), bfhi(w.z), bflo(w.w), bfhi(w.w)}; }

struct EpiWin {
    static constexpr bool PERM = true;
    bf16_t *q, *k, *v, *gr, *cq, *ckv, *sa, *sb, *kr; float* ga; const float* rope; int f8; float ascale;
    __device__ __forceinline__ void operator()(const AccT& acc, const Unit& u, int wr, int wc, int fr, int fq) const {
        const int pn = f8 ? (u.pn < 4 ? 8 + u.pn : 12 + u.pn) : u.pn, row0 = u.pm * 256 + wr * 64 + fr, lc0 = wc * 32 + 8 * fq;
        if (pn < 24) {
            bf16_t* dst; int ld, cb, mode = 0;
            if (pn < 2) { dst = q; ld = 512; cb = pn * 256; mode = 1; }
            else if (pn < 4) { dst = k; ld = 512; cb = (pn - 2) * 256; }
            else if (pn < 8) { dst = v; ld = 1024; cb = (pn - 4) * 256; }
            else if (pn < 12) { dst = gr; ld = 1024; cb = (pn - 8) * 256; mode = 2; }
            else if (pn < 15) { dst = cq; ld = 768; cb = (pn - 12) * 256; }
            else if (pn < 16) { dst = ckv; ld = 256; cb = 0; }
            else if (pn < 20) { dst = sa; ld = 512; cb = (pn - 16) * 128; mode = 3; }
            else { dst = sb; ld = 512; cb = (pn - 20) * 128; mode = 3; }
#pragma unroll
            for (int ai = 0; ai < 2; ++ai)
#pragma unroll
                for (int m = 0; m < 4; ++m) {
                    const int row = row0 + ai * 128 + m * 16;
#pragma unroll
                    for (int bj = 0; bj < 2; ++bj) {
                        f32x4 v0 = acc[ai][bj][m][0] * ascale, v1 = acc[ai][bj][m][1] * ascale;
                        if (mode == 1) { v0 *= 0.08838834764831845f; v1 *= 0.08838834764831845f; }
                        else if (mode == 2) {
#pragma unroll
                            for (int j = 0; j < 4; ++j) { v0[j] = silu(v0[j]); v1[j] = silu(v1[j]); } }
                        else if (mode == 3) {
#pragma unroll
                            for (int j = 0; j < 4; ++j) { v0[j] = sigm(v0[j]); v1[j] = sigm(v1[j]); } }
                        if (mode == 3) {
                            unsigned d0 = 0u, d1 = 0u;
#pragma unroll
                            for (int j = 0; j < 4; ++j) { d0 = __builtin_amdgcn_cvt_pk_u8_f32(v0[j] * 255.0f, j, d0); d1 = __builtin_amdgcn_cvt_pk_u8_f32(v1[j] * 255.0f, j, d1); }
                            *(u32x2*)((unsigned char*)dst + (size_t)row * 1024 + (size_t)cb * 2 + bj * 128 + lc0) = (u32x2){d0, d1};
                        } else
                        *(u32x4*)(dst + (size_t)row * ld + cb + bj * 128 + lc0) = pack8(v0, v1);
                    }
                }
        } else {
#pragma unroll
            for (int ai = 0; ai < 2; ++ai)
#pragma unroll
                for (int m = 0; m < 4; ++m) {
                    const int row = row0 + ai * 128 + m * 16;
#pragma unroll
                    for (int bj = 0; bj < 2; ++bj) {
                        const int col = bj * 128 + lc0; const f32x4 v0 = acc[ai][bj][m][0], v1 = acc[ai][bj][m][1];
                        if (col < 64) {
                            const int j = col >> 3;
                            const f32x4 cs = *(const f32x4*)(rope + (size_t)row * 64 + 4 * j), sn = *(const f32x4*)(rope + (size_t)row * 64 + 32 + 4 * j);
                            const f32x4 o1 = v0 * cs - v1 * sn, o2 = v1 * cs + v0 * sn;
                            u32x2 w1, w2; w1.x = pk2(o1[0], o1[1]); w1.y = pk2(o1[2], o1[3]); w2.x = pk2(o2[0], o2[1]); w2.y = pk2(o2[2], o2[3]);
                            *(u32x2*)(kr + (size_t)row * 64 + 4 * j) = w1; *(u32x2*)(kr + (size_t)row * 64 + 32 + 4 * j) = w2;
                        } else if (col < 80) {
                            *(f32x4*)(ga + (size_t)row * 16 + (col - 64)) = v0; *(f32x4*)(ga + (size_t)row * 16 + (col - 64) + 4) = v1;
                        }
                    }
                }
        }
    }
};
struct EpiQF {
    static constexpr bool PERM = true;
    bf16_t* qm; const float* cq_ss; const float* rope;
    __device__ __forceinline__ void operator()(const AccT& acc, const Unit& u, int wr, int wc, int fr, int fq) const {
        const int row0 = u.pm * 256 + wr * 64 + fr, lc0 = wc * 32 + 8 * fq;
        int colb[2], headb[2], jb[2]; bool ropeb[2];
#pragma unroll
        for (int bj = 0; bj < 2; ++bj) { colb[bj] = u.pn * 256 + bj * 128 + lc0; headb[bj] = colb[bj] / 192; const int within = colb[bj] - headb[bj] * 192; ropeb[bj] = within >= 128; jb[bj] = ropeb[bj] ? (within - 128) >> 3 : 0; }
#pragma unroll
        for (int ai = 0; ai < 2; ++ai) {
            float rsv[4]; f32x4 cs[4][2], sn[4][2];
#pragma unroll
            for (int m = 0; m < 4; ++m) { const int row = row0 + ai * 128 + m * 16; rsv[m] = cq_ss[row];
#pragma unroll
                for (int bj = 0; bj < 2; ++bj) if (ropeb[bj]) { cs[m][bj] = *(const f32x4*)(rope + (size_t)row * 64 + 4 * jb[bj]); sn[m][bj] = *(const f32x4*)(rope + (size_t)row * 64 + 32 + 4 * jb[bj]); } }
#pragma unroll
            for (int m = 0; m < 4; ++m) {
                const int row = row0 + ai * 128 + m * 16;
                const float rs = rsqrtf(rsv[m] * (1.0f / 768.0f) + RMS_EPS) * QSCALE;
#pragma unroll
                for (int bj = 0; bj < 2; ++bj) {
                    const f32x4 v0 = acc[ai][bj][m][0] * rs, v1 = acc[ai][bj][m][1] * rs;
                    if (!ropeb[bj]) *(u32x4*)(qm + (size_t)row * 1536 + colb[bj]) = pack8(v0, v1);
                    else {
                        const f32x4 o1 = v0 * cs[m][bj] - v1 * sn[m][bj], o2 = v1 * cs[m][bj] + v0 * sn[m][bj];
                        u32x2 w1, w2; w1.x = pk2(o1[0], o1[1]); w1.y = pk2(o1[2], o1[3]); w2.x = pk2(o2[0], o2[1]); w2.y = pk2(o2[2], o2[3]);
                        bf16_t* p = qm + (size_t)row * 1536 + headb[bj] * 192 + 128 + 4 * jb[bj];
                        *(u32x2*)p = w1; *(u32x2*)(p + 32) = w2;
                    }
                }
            }
        }
    }
};
struct EpiKV {
    static constexpr bool PERM = true;
    bf16_t *kn, *vm; const float* ckv_ss;
    __device__ __forceinline__ void operator()(const AccT& acc, const Unit& u, int wr, int wc, int fr, int fq) const {
        const int row0 = u.pm * 256 + wr * 64 + fr, lc0 = wc * 32 + 8 * fq;
        bf16_t* dst = u.pn < 4 ? kn : vm; const int cb = (u.pn & 3) * 256;
#pragma unroll
        for (int ai = 0; ai < 2; ++ai)
#pragma unroll
            for (int m = 0; m < 4; ++m) {
                const int row = row0 + ai * 128 + m * 16;
                const float rs = rsqrtf(ckv_ss[row] * (1.0f / 256.0f) + RMS_EPS);
#pragma unroll
                for (int bj = 0; bj < 2; ++bj)
                    *(u32x4*)(dst + (size_t)row * 1024 + cb + bj * 128 + lc0) = pack8(acc[ai][bj][m][0] * rs, acc[ai][bj][m][1] * rs);
            }
    }
};
template <bool ADD> struct EpiGate {
    static constexpr bool PERM = true;
    bf16_t* Y; const unsigned char* gate;
    __device__ __forceinline__ void operator()(const AccT& acc, const Unit& u, int wr, int wc, int fr, int fq) const {
        const int row0 = u.pm * 256 + wr * 64 + fr, lc0 = u.pn * 256 + wc * 32 + 8 * fq;
#pragma unroll
        for (int ai = 0; ai < 2; ++ai) {
            u32x2 gq[4][2]; u32x4 yq[4][2];
#pragma unroll
            for (int m = 0; m < 4; ++m)
#pragma unroll
                for (int bj = 0; bj < 2; ++bj) { const size_t o = (size_t)(row0 + ai * 128 + m * 16) * 1024 + lc0 + bj * 128; gq[m][bj] = *(const u32x2*)(gate + o); if (ADD) yq[m][bj] = *(const u32x4*)(Y + o); }
#pragma unroll
            for (int m = 0; m < 4; ++m)
#pragma unroll
                for (int bj = 0; bj < 2; ++bj) {
                    const size_t o = (size_t)(row0 + ai * 128 + m * 16) * 1024 + lc0 + bj * 128;
                    const unsigned ga_ = gq[m][bj].x, gb_ = gq[m][bj].y; const float k255 = 1.0f / 255.0f;
                    const f32x4 g0 = (f32x4){(float)(ga_ & 255u), (float)((ga_ >> 8) & 255u), (float)((ga_ >> 16) & 255u), (float)(ga_ >> 24)} * k255;
                    const f32x4 g1 = (f32x4){(float)(gb_ & 255u), (float)((gb_ >> 8) & 255u), (float)((gb_ >> 16) & 255u), (float)(gb_ >> 24)} * k255;
                    f32x4 v0 = acc[ai][bj][m][0] * g0, v1 = acc[ai][bj][m][1] * g1;
                    if (ADD) { f32x4 y0, y1; unpack8(yq[m][bj], y0, y1); v0 += y0; v1 += y1; }
                    *(u32x4*)(Y + o) = pack8(v0, v1);
                }
        }
    }
};
struct EpiZ {
    static constexpr bool PERM = false;
    float* z; const float* x; const float* mod;
    __device__ __forceinline__ void operator()(const AccT& acc, const Unit& u, int wr, int wc, int fr, int fq) const {
        const int row0 = u.pm * 256 + wr * 64 + fr, col0 = u.pn * 256 + wc * 32 + 4 * fq;
        const float* g = mod + (size_t)(u.pm >> 3) * 6144 + 2048;
        f32x4 gv[2][2];
#pragma unroll
        for (int bj = 0; bj < 2; ++bj)
#pragma unroll
            for (int n = 0; n < 2; ++n) gv[bj][n] = *(const f32x4*)(g + col0 + bj * 128 + n * 16) + 1.0f;
#pragma unroll
        for (int ai = 0; ai < 2; ++ai)
#pragma unroll
            for (int m = 0; m < 4; ++m) {
                const size_t ro = (size_t)(row0 + ai * 128 + m * 16) * 1024 + col0;
#pragma unroll
                for (int bj = 0; bj < 2; ++bj)
#pragma unroll
                    for (int n = 0; n < 2; ++n) { const size_t o = ro + bj * 128 + n * 16; *(f32x4*)(z + o) = *(const f32x4*)(x + o) * ALPHA + gv[bj][n] * acc[ai][bj][m][n]; }
            }
    }
};
struct EpiF32 {
    static constexpr bool PERM = false;
    float* C; int ldc;
    __device__ __forceinline__ void operator()(const AccT& acc, const Unit& u, int wr, int wc, int fr, int fq) const {
        const int row0 = u.pm * 256 + wr * 64 + fr, col0 = u.pn * 256 + wc * 32 + 4 * fq;
#pragma unroll
        for (int ai = 0; ai < 2; ++ai)
#pragma unroll
            for (int m = 0; m < 4; ++m) { float* rowp = C + (size_t)(row0 + ai * 128 + m * 16) * ldc + col0;
#pragma unroll
                for (int bj = 0; bj < 2; ++bj)
#pragma unroll
                    for (int n = 0; n < 2; ++n) *(f32x4*)(rowp + bj * 128 + n * 16) = acc[ai][bj][m][n]; }
    }
};
struct EpiGLU {
    static constexpr bool PERM = true;
    bf16_t* hid; float scale; int f8;
    __device__ __forceinline__ void operator()(const AccT& acc, const Unit& u, int wr, int wc, int fr, int fq) const {
        const int row0 = u.pm * 256 + wr * 64 + fr, lc0 = u.pn * 256 + wc * 32 + 8 * fq;
#pragma unroll
        for (int ai = 0; ai < 2; ++ai)
#pragma unroll
            for (int m = 0; m < 4; ++m) {
                const int row = row0 + ai * 128 + m * 16;
#pragma unroll
                for (int bj = 0; bj < 2; ++bj) {
                    const f32x4 gg = acc[ai][bj][m][0] * scale, uu = acc[ai][bj][m][1] * scale;
                    const float h0 = silu(gg[0]) * uu[0], h1 = silu(gg[1]) * uu[1], h2_ = silu(gg[2]) * uu[2], h3 = silu(gg[3]) * uu[3];
                    if (f8) { unsigned d = 0u; d = __builtin_amdgcn_cvt_pk_fp8_f32(h0, h1, d, false); d = __builtin_amdgcn_cvt_pk_fp8_f32(h2_, h3, d, true);
                        *(unsigned*)((unsigned char*)hid + (size_t)row * 256 + ((lc0 + bj * 128) >> 1)) = d; }
                    else { u32x2 w; w.x = pk2(h0, h1); w.y = pk2(h2_, h3); *(u32x2*)(hid + (size_t)row * 256 + ((lc0 + bj * 128) >> 1)) = w; }
                }
            }
    }
};
struct EpiBf16 {
    static constexpr bool PERM = true;
    bf16_t* O; int ld;
    __device__ __forceinline__ void operator()(const AccT& acc, const Unit& u, int wr, int wc, int fr, int fq) const {
        const int row0 = u.pm * 256 + wr * 64 + fr, lc0 = u.pn * 256 + wc * 32 + 8 * fq;
#pragma unroll
        for (int ai = 0; ai < 2; ++ai)
#pragma unroll
            for (int m = 0; m < 4; ++m) {
                const int row = row0 + ai * 128 + m * 16;
#pragma unroll
                for (int bj = 0; bj < 2; ++bj) *(u32x4*)(O + (size_t)row * ld + lc0 + bj * 128) = pack8(acc[ai][bj][m][0], acc[ai][bj][m][1]);
            }
    }
};
typedef __bf16 bf16v2 __attribute__((ext_vector_type(2)));
__device__ __forceinline__ void atom_pk_bf16(bf16_t* p, unsigned w) {
    asm volatile("global_atomic_pk_add_bf16 %0, %1, off" :: "v"(p), "v"(w) : "memory");
}
struct EpiAtom {
    static constexpr bool PERM = true;
    bf16_t* accb; const int* slot_tok; const float* slot_w;
    __device__ __forceinline__ void operator()(const AccT& acc, const Unit& u, int wr, int wc, int fr, int fq) const {
        const int row0 = u.pm * 256 + wr * 64 + fr, lc0 = u.pn * 256 + wc * 32 + 8 * fq;
#pragma unroll
        for (int ai = 0; ai < 2; ++ai)
#pragma unroll
            for (int m = 0; m < 4; ++m) {
                const int slot = row0 + ai * 128 + m * 16;
                const int tok = slot_tok[slot];
                if (tok >= 0) {
                    const float w = slot_w[slot];
#pragma unroll
                    for (int bj = 0; bj < 2; ++bj) {
                        const u32x4 pw = pack8(acc[ai][bj][m][0] * w, acc[ai][bj][m][1] * w);
                        bf16_t* p = accb + (size_t)tok * 1024 + lc0 + bj * 128;
                        atom_pk_bf16(p, pw.x); atom_pk_bf16(p + 2, pw.y); atom_pk_bf16(p + 4, pw.z); atom_pk_bf16(p + 6, pw.w);
                    }
                }
            }
    }
};

struct Params { const float* in[28]; float* out; unsigned char* ws; int ph_lo, ph_hi, flags, pad; };
enum { I_X = 0, I_C, I_POS, I_WADA, I_BADA, I_WIN, I_WGA2, I_BGA, I_GGN, I_WGLAO, I_GCQ, I_WUQ, I_GCKV, I_WUKV, I_WMLAO, I_WOUT, I_LN1G, I_LN1B, I_WRT, I_BRT, I_WE1, I_WE3, I_WE2, I_WS1, I_WS3, I_WS2, I_LN2G, I_LN2B };
constexpr int LDS_STAGE = 131072, LDS_BYTES = 147456, LDS_MISC = LDS_BYTES - 2048;

template <class Map>
__device__ __forceinline__ void tr_item(const float* W, int K, int Nsrc, bf16_t* WT, const Map& map, const float* kscale, LAS unsigned* scr, int kb, int nb, int lane) {
    const int k0 = 64 * kb, n0 = 64 * nb;
    const int sc = map(n0 + lane);
#pragma unroll 8
    for (int kp = 0; kp < 32; ++kp) {
        float a = 0.f, b = 0.f;
        if (sc >= 0) { a = W[(size_t)(k0 + 2 * kp) * Nsrc + sc]; b = W[(size_t)(k0 + 2 * kp + 1) * Nsrc + sc]; }
        if (kscale) { a *= kscale[k0 + 2 * kp]; b *= kscale[k0 + 2 * kp + 1]; }
        scr[kp * 65 + lane] = pk2(a, b);
    }
    LDS_WAIT(); asm volatile("" ::: "memory");
#pragma unroll
    for (int j = 0; j < 8; ++j) { const int id = lane + 64 * j, n = id >> 3, c = id & 7;
        u32x4 o; o.x = scr[(4 * c + 0) * 65 + n]; o.y = scr[(4 * c + 1) * 65 + n]; o.z = scr[(4 * c + 2) * 65 + n]; o.w = scr[(4 * c + 3) * 65 + n];
        *(u32x4*)(WT + (size_t)(n0 + n) * K + k0 + 8 * c) = o; }
    LDS_WAIT(); asm volatile("" ::: "memory");
}
struct MapId { int off; __device__ __forceinline__ int operator()(int n) const { return off + n; } };
struct MapWin {
    __device__ __forceinline__ int operator()(int n) const {
        if (n < 3072) return n;
        if (n < 3840) return 3088 + (n - 3072);
        if (n < 4096) return 3856 + (n - 3840);
        if (n < 6144) return 4176 + (n - 4096);
        const int t = n - 6144;
        if (t < 64) { const int j = t >> 3, i = t & 7; return 4112 + (i < 4 ? 4 * j + i : 32 + 4 * j + (i - 4)); }
        if (t < 80) return 3072 + (t - 64);
        return -1;
    }
};
struct MapUq { __device__ __forceinline__ int operator()(int n) const { const int h = n / 192, w = n - h * 192; if (w < 128) return n; const int t = w - 128, j = t >> 3, i = t & 7; return h * 192 + 128 + (i < 4 ? 4 * j + i : 32 + 4 * j + (i - 4)); } };
struct MapUkv { __device__ __forceinline__ int operator()(int n) const { const int part = n >> 10, r = n & 1023, h = r >> 7, d = r & 127; return h * 256 + part * 128 + d; } };
struct MapGlu { int coff; __device__ __forceinline__ int operator()(int n) const { return coff + ((n >> 3) << 2) + (n & 3); } };
__device__ __forceinline__ void tr_glu_item(const float* W1, const float* W3, int K, int Nsrc, bf16_t* WT, LAS unsigned* scr, int kb, int nb, int lane) {
    const int k0 = 64 * kb, n0 = 64 * nb, n = n0 + lane;
    const float* W = (n & 4) ? W3 : W1; const int sc = ((n >> 3) << 2) + (n & 3);
#pragma unroll 8
    for (int kp = 0; kp < 32; ++kp) scr[kp * 65 + lane] = pk2(W[(size_t)(k0 + 2 * kp) * Nsrc + sc], W[(size_t)(k0 + 2 * kp + 1) * Nsrc + sc]);
    LDS_WAIT(); asm volatile("" ::: "memory");
#pragma unroll
    for (int j = 0; j < 8; ++j) { const int id = lane + 64 * j, nn = id >> 3, c = id & 7;
        u32x4 o; o.x = scr[(4 * c + 0) * 65 + nn]; o.y = scr[(4 * c + 1) * 65 + nn]; o.z = scr[(4 * c + 2) * 65 + nn]; o.w = scr[(4 * c + 3) * 65 + nn];
        *(u32x4*)(WT + (size_t)(n0 + nn) * K + k0 + 8 * c) = o; }
    LDS_WAIT(); asm volatile("" ::: "memory");
}


__device__ __forceinline__ void tr_glu8_item(const float* W1, const float* W3, int K, int Nsrc, unsigned char* WT, LAS unsigned* scr, int kb, int nb, int lane) {
    const int k0 = 64 * kb, n0 = 64 * nb, n = n0 + lane;
    const float* W = (n & 4) ? W3 : W1; const int sc = ((n >> 3) << 2) + (n & 3);
#pragma unroll 4
    for (int kq = 0; kq < 16; ++kq) { const float* wp = W + (size_t)(k0 + 4 * kq) * Nsrc + sc;
        unsigned d = 0u; d = __builtin_amdgcn_cvt_pk_fp8_f32(wp[0] * 32.0f, wp[Nsrc] * 32.0f, d, false); d = __builtin_amdgcn_cvt_pk_fp8_f32(wp[2 * (size_t)Nsrc] * 32.0f, wp[3 * (size_t)Nsrc] * 32.0f, d, true);
        scr[kq * 65 + lane] = d; }
    LDS_WAIT(); asm volatile("" ::: "memory");
#pragma unroll
    for (int j = 0; j < 4; ++j) { const int id = lane + 64 * j, nn = id >> 2, c = id & 3;
        u32x4 o; o.x = scr[(4 * c + 0) * 65 + nn]; o.y = scr[(4 * c + 1) * 65 + nn]; o.z = scr[(4 * c + 2) * 65 + nn]; o.w = scr[(4 * c + 3) * 65 + nn];
        *(u32x4*)(WT + (size_t)(n0 + nn) * K + k0 + 16 * c) = o; }
    LDS_WAIT(); asm volatile("" ::: "memory");
}

template <class Map>
__device__ __forceinline__ void tr8_item(const float* W, int K, int Nsrc, unsigned char* WT, const Map& map, LAS unsigned* scr, int kb, int nb, int lane) {
    const int k0 = 64 * kb, n0 = 64 * nb; const int sc = map(n0 + lane);
#pragma unroll 4
    for (int kq = 0; kq < 16; ++kq) { const float* wp = W + (size_t)(k0 + 4 * kq) * Nsrc + sc;
        unsigned d = 0u; d = __builtin_amdgcn_cvt_pk_fp8_f32(wp[0] * 32.0f, wp[Nsrc] * 32.0f, d, false); d = __builtin_amdgcn_cvt_pk_fp8_f32(wp[2 * (size_t)Nsrc] * 32.0f, wp[3 * (size_t)Nsrc] * 32.0f, d, true);
        scr[kq * 65 + lane] = d; }
    LDS_WAIT(); asm volatile("" ::: "memory");
#pragma unroll
    for (int j = 0; j < 4; ++j) { const int id = lane + 64 * j, nn = id >> 2, c = id & 3;
        u32x4 o; o.x = scr[(4 * c + 0) * 65 + nn]; o.y = scr[(4 * c + 1) * 65 + nn]; o.z = scr[(4 * c + 2) * 65 + nn]; o.w = scr[(4 * c + 3) * 65 + nn];
        *(u32x4*)(WT + (size_t)(n0 + nn) * K + k0 + 16 * c) = o; }
    LDS_WAIT(); asm volatile("" ::: "memory");
}

struct MapWin8 { __device__ __forceinline__ int operator()(int n) const { return n < 1024 ? 2048 + n : 4176 + (n - 1024); } };
__device__ __forceinline__ void phase0(const Params& p, LAS unsigned char* lds, int gw, int ngw, int lane, int wave) {
    unsigned char* ws = p.ws;
    {
        const int cb = blockIdx.x, tid = threadIdx.x;
        if (cb < 96) {
            const float* c = p.in[I_C]; const float* wada = p.in[I_WADA]; const float* bada = p.in[I_BADA]; float* mod = (float*)(ws + WS_MOD);
            LAS float* tab = (LAS float*)lds;
            for (int i = tid; i < 32 * 1024 / 4; i += NTHR) { const f32x4 v = ((const f32x4*)c)[i]; f32x4 o; o[0] = silu(v[0]); o[1] = silu(v[1]); o[2] = silu(v[2]); o[3] = silu(v[3]); ((LAS f32x4*)tab)[i] = o; }
            __syncthreads();
            float acc[32];
#pragma unroll
            for (int b = 0; b < 32; ++b) acc[b] = 0.f;
            const int col = cb * 64 + lane;
            for (int k4 = 0; k4 < 32; ++k4) {
                const int k = wave * 128 + k4 * 4;
                float w[4];
#pragma unroll
                for (int q = 0; q < 4; ++q) w[q] = wada[(size_t)(k + q) * 6144 + col];
#pragma unroll
                for (int b = 0; b < 32; ++b) { const f32x4 t = *(const LAS f32x4*)(tab + b * 1024 + k); acc[b] += t[0] * w[0] + t[1] * w[1] + t[2] * w[2] + t[3] * w[3]; }
            }
            __syncthreads();
            LAS float* part = (LAS float*)lds;
#pragma unroll
            for (int b = 0; b < 32; ++b) part[(wave * 32 + b) * 64 + lane] = acc[b];
            __syncthreads();
#pragma unroll
            for (int i = 0; i < 4; ++i) { const int o = tid + 512 * i, b = o >> 6, l = o & 63; float sum = 0.f;
#pragma unroll
                for (int w8 = 0; w8 < 8; ++w8) sum += part[(w8 * 32 + b) * 64 + l];
                mod[b * 6144 + cb * 64 + l] = sum + bada[cb * 64 + l]; }
            __syncthreads();
        }
    }
    LAS unsigned* scr = (LAS unsigned*)(lds + wave * 8448);
    constexpr int T_WIN = 16 * 100, T_GLAO = 16 * 16, T_UQ = 12 * 24, T_UKV = 4 * 32, T_MLAO = 256, T_OUT = 256, T_RT = 16 * 4, T_S13 = 16 * 8, T_S2 = 4 * 16, T_WIN8 = 16 * 48;
    constexpr int T_ALL = T_WIN + T_GLAO + T_UQ + T_UKV + T_MLAO + T_OUT + T_RT + T_S13 + T_S2 + T_WIN8;
    for (int it = gw; it < T_ALL; it += ngw) {
        int r = it;
        if (r < T_WIN) { tr_item(p.in[I_WIN], 1024, 6224, (bf16_t*)(ws + WS_WIN), MapWin{}, nullptr, scr, r / 100, r % 100, lane); continue; } r -= T_WIN;
        if (r < T_GLAO) { tr_item(p.in[I_WGLAO], 1024, 1024, (bf16_t*)(ws + WS_WGLAO), MapId{0}, nullptr, scr, r / 16, r % 16, lane); continue; } r -= T_GLAO;
        if (r < T_UQ) { tr_item(p.in[I_WUQ], 768, 1536, (bf16_t*)(ws + WS_WUQ), MapUq{}, p.in[I_GCQ], scr, r / 24, r % 24, lane); continue; } r -= T_UQ;
        if (r < T_UKV) { tr_item(p.in[I_WUKV], 256, 2048, (bf16_t*)(ws + WS_WUKV), MapUkv{}, p.in[I_GCKV], scr, r / 32, r % 32, lane); continue; } r -= T_UKV;
        if (r < T_MLAO) { tr_item(p.in[I_WMLAO], 1024, 1024, (bf16_t*)(ws + WS_WMLAO), MapId{0}, nullptr, scr, r / 16, r % 16, lane); continue; } r -= T_MLAO;
        if (r < T_OUT) { tr_item(p.in[I_WOUT], 1024, 1024, (bf16_t*)(ws + WS_WOUT), MapId{0}, nullptr, scr, r / 16, r % 16, lane); continue; } r -= T_OUT;
        if (r < T_RT) { tr_item(p.in[I_WRT], 1024, 256, (bf16_t*)(ws + WS_WRT), MapId{0}, nullptr, scr, r / 4, r % 4, lane); continue; } r -= T_RT;
        if (r < T_S13) { tr_glu_item(p.in[I_WS1], p.in[I_WS3], 1024, 256, (bf16_t*)(ws + WS_WS13), scr, r / 8, r % 8, lane); continue; } r -= T_S13;
        if (r < T_S2) { tr_item(p.in[I_WS2], 256, 1024, (bf16_t*)(ws + WS_WS2), MapId{0}, nullptr, scr, r / 16, r % 16, lane); continue; } r -= T_S2;
        tr8_item(p.in[I_WIN], 1024, 6224, ws + WS_WIN8, MapWin8{}, scr, r / 48, r % 48, lane);
    }
    { int* st = (int*)(ws + WS_STOK); for (int i = gw * 64 + lane; i < NSLOT; i += ngw * 64) st[i] = -1; }
}

__device__ __forceinline__ void phase1(const Params& p, int gw, int ngw, int lane) {
    const float* x = p.in[I_X]; const float* mod = (const float*)(p.ws + WS_MOD); bf16_t* h = (bf16_t*)(p.ws + WS_BIG(0));
    const int* pos = (const int*)p.in[I_POS]; float* rope = (float*)((unsigned char*)p.out + 192 * MiB);
    const float invf = exp2f(-(float)(lane & 31) * (13.287712379549449f / 32.0f));
    for (int m = gw; m < NTOK; m += ngw) {
        const int b = m >> 11; const float* sh = mod + b * 6144; const float* sc = sh + 1024;
        const f32x4* xr = (const f32x4*)(x + (size_t)m * 1024) + lane;
        u32x2* o = (u32x2*)(h + (size_t)m * 1024) + lane;
#pragma unroll
        for (int j = 0; j < 4; ++j) { const f32x4 v = xr[64 * j], s = *((const f32x4*)sc + lane + 64 * j) + 1.0f, t = *((const f32x4*)sh + lane + 64 * j);
            const f32x4 r = v * s + t; u32x2 w; w.x = pk2(r[0], r[1]); w.y = pk2(r[2], r[3]); o[64 * j] = w;
            unsigned w8 = 0u; w8 = __builtin_amdgcn_cvt_pk_fp8_f32(r[0], r[1], w8, false); w8 = __builtin_amdgcn_cvt_pk_fp8_f32(r[2], r[3], w8, true);
            ((unsigned*)(p.ws + WS_BIG(7) + (size_t)m * 1024))[lane + 64 * j] = w8; }
        const float ang = (float)pos[m] * invf;
        rope[(size_t)m * 64 + lane] = lane < 32 ? cosf(ang) : sinf(ang);
    }
}

__device__ __forceinline__ void ln1_row(float* zrow, bf16_t* h2row, const float* g, const float* bta, const float* sh2, const float* sc2, int lane) {
    f32x4* zr = (f32x4*)zrow + lane; f32x4 v[4]; float s = 0.f;
#pragma unroll
    for (int j = 0; j < 4; ++j) { v[j] = zr[64 * j]; s += (v[j][0] + v[j][1]) + (v[j][2] + v[j][3]); }
    const float mean = wave_sum(s) * (1.f / 1024.f); float s2 = 0.f;
#pragma unroll
    for (int j = 0; j < 4; ++j) { v[j] = v[j] - mean; s2 += (v[j][0] * v[j][0] + v[j][1] * v[j][1]) + (v[j][2] * v[j][2] + v[j][3] * v[j][3]); }
    const float rstd = rsqrtf(wave_sum(s2) * (1.f / 1024.f) + LN_EPS);
    u32x2* o = (u32x2*)h2row + lane;
#pragma unroll
    for (int j = 0; j < 4; ++j) {
        const int ci = lane + 64 * j;
        const f32x4 x1 = v[j] * rstd * ((const f32x4*)g)[ci] + ((const f32x4*)bta)[ci];
        zr[64 * j] = x1;
        const f32x4 hh = x1 * (((const f32x4*)sc2)[ci] + 1.0f) + ((const f32x4*)sh2)[ci];
        u32x2 w; w.x = pk2(hh[0], hh[1]); w.y = pk2(hh[2], hh[3]); o[64 * j] = w;
    }
}
__device__ __forceinline__ void ln2_row(float* orow, const bf16_t* frow, const float* g, const float* bta, const float* gt2, int lane) {
    f32x4* zr = (f32x4*)orow + lane; const u32x2* fr = (const u32x2*)frow + lane; f32x4 v[4]; float s = 0.f;
#pragma unroll
    for (int j = 0; j < 4; ++j) { const u32x2 w = fr[64 * j]; const f32x4 f = (f32x4){bflo(w.x), bfhi(w.x), bflo(w.y), bfhi(w.y)};
        v[j] = zr[64 * j] * ALPHA + (((const f32x4*)gt2)[lane + 64 * j] + 1.0f) * f; s += (v[j][0] + v[j][1]) + (v[j][2] + v[j][3]); }
    const float mean = wave_sum(s) * (1.f / 1024.f); float s2 = 0.f;
#pragma unroll
    for (int j = 0; j < 4; ++j) { v[j] = v[j] - mean; s2 += (v[j][0] * v[j][0] + v[j][1] * v[j][1]) + (v[j][2] * v[j][2] + v[j][3] * v[j][3]); }
    const float rstd = rsqrtf(wave_sum(s2) * (1.f / 1024.f) + LN_EPS);
#pragma unroll
    for (int j = 0; j < 4; ++j) { const int ci = lane + 64 * j; zr[64 * j] = v[j] * rstd * ((const f32x4*)g)[ci] + ((const f32x4*)bta)[ci]; }
}

__device__ __forceinline__ void gla_phase(const Params& p, LAS unsigned char* lds, int bh, bool nostore) {
    const int tid = threadIdx.x, lane = tid & 63, wave = __builtin_amdgcn_readfirstlane(tid >> 6), fr = lane & 15, g = lane >> 4;
    const int b = bh >> 2, h = bh & 3;
    const bf16_t* qg = (const bf16_t*)(p.ws + WS_BIG(1)); const bf16_t* kg = qg + (size_t)NTOK * 512; const bf16_t* vg = (const bf16_t*)(p.ws + WS_BIG(2));
    bf16_t* gr = (bf16_t*)(p.ws + WS_BIG(3)); const float* gag = (const float*)(p.ws + WS_GA);
    LAS bf16_t* KdT = (LAS bf16_t*)lds;
    LAS bf16_t* VT = (LAS bf16_t*)(lds + 18432);
    LAS bf16_t* ST = (LAS bf16_t*)lds;
    LAS bf16_t* QS = (LAS bf16_t*)(lds + 69632);
    LAS float* DEC = (LAS float*)(lds + 87040);
    LAS float* PART = (LAS float*)(lds + 87552);
    LAS float* GAC = (LAS float*)(lds + 89600);
    LAS float* SS = (LAS float*)(lds + 93696);
    const int dk = tid & 127, tq = tid >> 7;
    float w2[16];
#pragma unroll
    for (int r = 0; r < 16; ++r) w2[r] = p.in[I_WGA2][r * 512 + h * 128 + dk];
    const float bias = p.in[I_BGA][h * 128 + dk];
    const int rg = wave & 3, ch = wave >> 2;
    float gnv[8];
#pragma unroll
    for (int nt = 0; nt < 8; ++nt) gnv[nt] = p.in[I_GGN][128 * ch + 16 * nt + fr];
    f32x4 st[8][2];
#pragma unroll
    for (int mt = 0; mt < 8; ++mt) { st[mt][0] = (f32x4){0.f, 0.f, 0.f, 0.f}; st[mt][1] = (f32x4){0.f, 0.f, 0.f, 0.f}; }
    const int dvp = tid & 127, tq4 = tid >> 7;
    bf16_t kraw[16]; unsigned vraw[16]; u32x4 qraw[2]; f32x4 garaw = (f32x4){0.f, 0.f, 0.f, 0.f};
#define GLA_LOAD(n_) do { const int tk_ = b * 2048 + (n_) * 64; \
        if (tid < 256) garaw = *(const f32x4*)(gag + (size_t)(tk_ + (tid >> 2)) * 16 + (tid & 3) * 4); \
        _Pragma("unroll") for (int j = 0; j < 16; ++j) kraw[j] = kg[(size_t)(tk_ + 16 * tq + j) * 512 + h * 128 + dk]; \
        _Pragma("unroll") for (int j = 0; j < 16; ++j) vraw[j] = *(const unsigned*)(vg + (size_t)(tk_ + 16 * tq4 + j) * 1024 + h * 256 + 2 * dvp); \
        _Pragma("unroll") for (int i = 0; i < 2; ++i) { const int id = tid + 512 * i; qraw[i] = *(const u32x4*)(qg + (size_t)(tk_ + (id >> 4)) * 512 + h * 128 + (id & 15) * 8); } } while (0)
    GLA_LOAD(0);
    for (int n = 0; n < 32; ++n) {
        const int tok0 = b * 2048 + n * 64;
        if (tid < 256) *(LAS f32x4*)(GAC + tid * 4) = garaw;
        __syncthreads();
        float cs[16]; float run = 0.f;
#pragma unroll
        for (int j = 0; j < 16; ++j) {
            const LAS f32x4* gp = (const LAS f32x4*)(GAC + (16 * tq + j) * 16);
            float d = bias;
#pragma unroll
            for (int r4 = 0; r4 < 4; ++r4) { const f32x4 gv = gp[r4]; d += gv[0] * w2[4 * r4] + gv[1] * w2[4 * r4 + 1] + gv[2] * w2[4 * r4 + 2] + gv[3] * w2[4 * r4 + 3]; }
            const float ls = fminf(d, 0.f) - __logf(1.0f + __expf(-fabsf(d)));
            run += ls * (1.0f / 16.0f); cs[j] = run;
        }
        PART[tq * 128 + dk] = run;
        __syncthreads();
        {
            const float p0 = PART[dk], p1 = PART[128 + dk], p2 = PART[256 + dk], p3 = PART[384 + dk];
            const float total = (p0 + p1) + (p2 + p3);
            const float off = tq == 0 ? 0.f : tq == 1 ? p0 : tq == 2 ? (p0 + p1) : (p0 + p1) + p2;
            if (tq == 0) DEC[dk] = __expf(total);
            unsigned kd[8];
#pragma unroll
            for (int j = 0; j < 8; ++j) kd[j] = pk2(bf2f(kraw[2 * j]) * __expf(total - (off + cs[2 * j])), bf2f(kraw[2 * j + 1]) * __expf(total - (off + cs[2 * j + 1])));
            LAS u32x4* kdst = (LAS u32x4*)(KdT + dk * 72 + 16 * tq);
            kdst[0] = (u32x4){kd[0], kd[1], kd[2], kd[3]}; kdst[1] = (u32x4){kd[4], kd[5], kd[6], kd[7]};
            unsigned v0[8], v1[8];
#pragma unroll
            for (int j = 0; j < 8; ++j) { v0[j] = (vraw[2 * j] & 0xffffu) | (vraw[2 * j + 1] << 16); v1[j] = (vraw[2 * j] >> 16) | (vraw[2 * j + 1] & 0xffff0000u); }
            LAS u32x4* vd0 = (LAS u32x4*)(VT + (2 * dvp) * 72 + 16 * tq4); LAS u32x4* vd1 = (LAS u32x4*)(VT + (2 * dvp + 1) * 72 + 16 * tq4);
            vd0[0] = (u32x4){v0[0], v0[1], v0[2], v0[3]}; vd0[1] = (u32x4){v0[4], v0[5], v0[6], v0[7]};
            vd1[0] = (u32x4){v1[0], v1[1], v1[2], v1[3]}; vd1[1] = (u32x4){v1[4], v1[5], v1[6], v1[7]};
#pragma unroll
            for (int i = 0; i < 2; ++i) { const int id = tid + 512 * i; *(LAS u32x4*)(QS + (id >> 4) * 136 + (id & 15) * 8) = qraw[i]; }
        }
        if (n + 1 < 32) GLA_LOAD(n + 1);
        __syncthreads();
#pragma unroll
        for (int mt = 0; mt < 8; ++mt) { const f32x4 d4 = *(const LAS f32x4*)(DEC + 16 * mt + 4 * g); st[mt][0] *= d4; st[mt][1] *= d4; }
#pragma unroll
        for (int ks = 0; ks < 2; ++ks) {
            bf16x8 bfr[2];
#pragma unroll
            for (int nt = 0; nt < 2; ++nt) bfr[nt] = *(const LAS bf16x8*)(VT + (32 * wave + 16 * nt + fr) * 72 + 32 * ks + 8 * g);
#pragma unroll
            for (int mt = 0; mt < 8; ++mt) {
                const bf16x8 a = *(const LAS bf16x8*)(KdT + (16 * mt + fr) * 72 + 32 * ks + 8 * g);
                st[mt][0] = __builtin_amdgcn_mfma_f32_16x16x32_bf16(a, bfr[0], st[mt][0], 0, 0, 0);
                st[mt][1] = __builtin_amdgcn_mfma_f32_16x16x32_bf16(a, bfr[1], st[mt][1], 0, 0, 0);
            }
        }
        __syncthreads();
#pragma unroll
        for (int mt = 0; mt < 8; ++mt)
#pragma unroll
            for (int nt = 0; nt < 2; ++nt) { u32x2 w; w.x = pk2(st[mt][nt][0], st[mt][nt][1]); w.y = pk2(st[mt][nt][2], st[mt][nt][3]);
                *(LAS u32x2*)(ST + (32 * wave + 16 * nt + fr) * 136 + 16 * mt + 4 * g) = w; }
        __syncthreads();
        f32x4 o[8];
#pragma unroll
        for (int nt = 0; nt < 8; ++nt) o[nt] = (f32x4){0.f, 0.f, 0.f, 0.f};
#pragma unroll
        for (int ks = 0; ks < 4; ++ks) {
            const bf16x8 a = *(const LAS bf16x8*)(QS + (16 * rg + fr) * 136 + 32 * ks + 8 * g);
#pragma unroll
            for (int nt = 0; nt < 8; ++nt) { const bf16x8 bb = *(const LAS bf16x8*)(ST + (128 * ch + 16 * nt + fr) * 136 + 32 * ks + 8 * g);
                o[nt] = __builtin_amdgcn_mfma_f32_16x16x32_bf16(a, bb, o[nt], 0, 0, 0); }
        }
        {
            f32x4 s2 = (f32x4){0.f, 0.f, 0.f, 0.f};
#pragma unroll
            for (int nt = 0; nt < 8; ++nt) s2 += o[nt] * o[nt];
#pragma unroll
            for (int r = 0; r < 4; ++r) { float s = s2[r]; s += __shfl_xor(s, 1); s += __shfl_xor(s, 2); s += __shfl_xor(s, 4); s += __shfl_xor(s, 8); if (fr == 0) SS[(16 * rg + 4 * g + r) * 2 + ch] = s; }
        }
        __syncthreads();
#pragma unroll
        for (int r = 0; r < 4; ++r) {
            const int t = 16 * rg + 4 * g + r;
            const float rstd = rsqrtf((SS[t * 2] + SS[t * 2 + 1]) * (1.0f / 256.0f) + RMS_EPS);
            bf16_t* grow = gr + (size_t)(tok0 + t) * 1024 + h * 256 + 128 * ch + fr;
#pragma unroll
#if defined(GLA_DBG) && GLA_DBG == 1
            for (int nt = 0; nt < 8; ++nt) grow[16 * nt] = f2bf(o[nt][r]);
#elif defined(GLA_DBG) && GLA_DBG == 2
            for (int nt = 0; nt < 8; ++nt) grow[16 * nt] = f2bf(rstd);
#else
            for (int nt = 0; nt < 8; ++nt) { const bf16_t y = f2bf(o[nt][r] * rstd * gnv[nt] * bf2f(grow[16 * nt])); if (!nostore) grow[16 * nt] = y; }
#endif
        }
    }
#undef GLA_LOAD
    __syncthreads();
}

__device__ __forceinline__ float xor16_max(float v) { const auto r = __builtin_amdgcn_permlane16_swap(__float_as_uint(v), __float_as_uint(v), false, false); return fmaxf(__uint_as_float(r[0]), __uint_as_float(r[1])); }
__device__ __forceinline__ float xor32_max(float v) { const auto r = __builtin_amdgcn_permlane32_swap(__float_as_uint(v), __float_as_uint(v), false, false); return fmaxf(__uint_as_float(r[0]), __uint_as_float(r[1])); }
__device__ __forceinline__ float xor16_sum(float v) { const auto r = __builtin_amdgcn_permlane16_swap(__float_as_uint(v), __float_as_uint(v), false, false); return __uint_as_float(r[0]) + __uint_as_float(r[1]); }
__device__ __forceinline__ float xor32_sum(float v) { const auto r = __builtin_amdgcn_permlane32_swap(__float_as_uint(v), __float_as_uint(v), false, false); return __uint_as_float(r[0]) + __uint_as_float(r[1]); }
constexpr int ATT_BUF = 43008, ATT_VOFF = 24576;
__device__ __forceinline__ void attn_phase(const Params& p, LAS unsigned char* lds, int bh) {
    const int tid = threadIdx.x, lane = tid & 63, wave = __builtin_amdgcn_readfirstlane(tid >> 6), fr = lane & 15, g = lane >> 4;
    const int b = bh >> 3, h = bh & 7;
    const bf16_t* qm = (const bf16_t*)p.out; const bf16_t* kn = (const bf16_t*)(p.ws + WS_BIG(0)); const bf16_t* vm = (const bf16_t*)(p.ws + WS_BIG(7));
    const bf16_t* kr = (const bf16_t*)(p.ws + WS_KR); bf16_t* ob = (bf16_t*)(p.ws + WS_BIG(1));
    const int kp = tid & 31, dvc = tid >> 5;
    unsigned koff[3]; bool krope[3];
#pragma unroll
    for (int j = 0; j < 3; ++j) { const int L = (8 * j + wave) * 64 + lane, key = L / 24, sl = L % 24, c = (sl & ~7) | ((sl & 7) ^ (key & 7));
        krope[j] = c >= 16; koff[j] = krope[j] ? (unsigned)(key * 128 + 16 * (c - 16)) : (unsigned)(key * 2048 + h * 256 + 16 * c); }
    for (int qb = 0; qb < 8; ++qb) {
        const int q0 = b * 2048 + 256 * qb + 32 * wave;
        bf16x8 qf[2][6];
#pragma unroll
        for (int nt = 0; nt < 2; ++nt)
#pragma unroll
            for (int ks = 0; ks < 6; ++ks) qf[nt][ks] = *(const bf16x8*)(qm + (size_t)(q0 + 16 * nt + fr) * 1536 + h * 192 + 32 * ks + 8 * g);
        f32x4 O[8][2];
#pragma unroll
        for (int mt = 0; mt < 8; ++mt) { O[mt][0] = (f32x4){0.f, 0.f, 0.f, 0.f}; O[mt][1] = (f32x4){0.f, 0.f, 0.f, 0.f}; }
        float m_run[2] = {-1e30f, -1e30f}, l_part[2] = {0.f, 0.f};
        const int ntile = 4 * qb + 4, my_last = 4 * qb + (wave >> 1);
        u32x4 vreg[2];
#define ATT_PREFETCH(kt, buf) do { const int tk0 = b * 2048 + 64 * (kt); const char* knb = (const char*)(kn + (size_t)tk0 * 1024); const char* krb = (const char*)(kr + (size_t)tk0 * 64); \
            _Pragma("unroll") for (int j = 0; j < 3; ++j) __builtin_amdgcn_global_load_lds((const unsigned*)((krope[j] ? krb : knb) + koff[j]), (LAS unsigned*)(lds + (buf) * ATT_BUF + (8 * j + wave) * 1024), 16, 0, 0); \
            vreg[0] = *(const u32x4*)(vm + (size_t)(tk0 + 2 * kp) * 1024 + h * 128 + 8 * dvc); vreg[1] = *(const u32x4*)(vm + (size_t)(tk0 + 2 * kp + 1) * 1024 + h * 128 + 8 * dvc); } while (0)
#define ATT_WRITE(buf) do { LAS unsigned* VTw = (LAS unsigned*)(lds + (buf) * ATT_BUF + ATT_VOFF); \
            _Pragma("unroll") for (int i = 0; i < 4; ++i) { const unsigned a_ = vreg[0][i], b_ = vreg[1][i]; \
                VTw[(8 * dvc + 2 * i) * 36 + kp] = (a_ & 0xffffu) | (b_ << 16); VTw[(8 * dvc + 2 * i + 1) * 36 + kp] = (a_ >> 16) | (b_ & 0xffff0000u); } \
            asm volatile("s_waitcnt vmcnt(0)" ::: "memory"); } while (0)
        __syncthreads();
        ATT_PREFETCH(0, 0);
        ATT_WRITE(0);
        __syncthreads();
        for (int kt = 0; kt < ntile; ++kt) {
            if (kt + 1 < ntile) ATT_PREFETCH(kt + 1, (kt + 1) & 1);
            if (kt <= my_last) {
                const LAS unsigned char* KS = lds + (kt & 1) * ATT_BUF; const LAS unsigned* VT = (const LAS unsigned*)(lds + (kt & 1) * ATT_BUF + ATT_VOFF);
                f32x4 s[4][2];
#pragma unroll
                for (int mt = 0; mt < 4; ++mt) { s[mt][0] = (f32x4){0.f, 0.f, 0.f, 0.f}; s[mt][1] = (f32x4){0.f, 0.f, 0.f, 0.f}; }
                {
                    bf16x8 ka[2][4];
                    const LAS unsigned char* kb0 = KS + fr * 384 + 16 * (g ^ (fr & 7));
                    const LAS unsigned char* kb1 = KS + fr * 384 + 16 * ((4 + g) ^ (fr & 7));
#pragma unroll
                    for (int mt = 0; mt < 4; ++mt) ka[0][mt] = *(const LAS bf16x8*)(kb0 + mt * 6144);
#pragma unroll
                    for (int ks = 0; ks < 6; ++ks) {
                        if (ks < 5) {
#pragma unroll
                            for (int mt = 0; mt < 4; ++mt) ka[(ks + 1) & 1][mt] = *(const LAS bf16x8*)((((ks + 1) & 1) ? kb1 : kb0) + mt * 6144 + 128 * ((ks + 1) >> 1));
                            asm volatile("s_waitcnt lgkmcnt(4)" ::: "memory");
                        } else asm volatile("s_waitcnt lgkmcnt(0)" ::: "memory");
                        __builtin_amdgcn_sched_barrier(0);
#pragma unroll
                        for (int mt = 0; mt < 4; ++mt) {
                            s[mt][0] = __builtin_amdgcn_mfma_f32_16x16x32_bf16(ka[ks & 1][mt], qf[0][ks], s[mt][0], 0, 0, 0);
                            s[mt][1] = __builtin_amdgcn_mfma_f32_16x16x32_bf16(ka[ks & 1][mt], qf[1][ks], s[mt][1], 0, 0, 0);
                        }
                        __builtin_amdgcn_sched_barrier(0);
                    }
                }
                bf16x8 pf[2][2]; float al[2];
#pragma unroll
                for (int nt = 0; nt < 2; ++nt) {
                    float mx = fmaxf(fmaxf(s[0][nt][0], s[0][nt][1]), fmaxf(s[0][nt][2], s[0][nt][3]));
#pragma unroll
                    for (int mt = 1; mt < 4; ++mt) mx = fmaxf(mx, fmaxf(fmaxf(s[mt][nt][0], s[mt][nt][1]), fmaxf(s[mt][nt][2], s[mt][nt][3])));
                    mx = xor16_max(mx); mx = xor32_max(mx);
                    const float mn = fmaxf(m_run[nt], mx); al[nt] = __builtin_amdgcn_exp2f(m_run[nt] - mn); m_run[nt] = mn;
                    float rs = 0.f;
#pragma unroll
                    for (int mt = 0; mt < 4; ++mt)
#pragma unroll
                        for (int r = 0; r < 4; ++r) { const float e = __builtin_amdgcn_exp2f(s[mt][nt][r] - mn); s[mt][nt][r] = e; rs += e; }
                    l_part[nt] = l_part[nt] * al[nt] + rs;
#pragma unroll
                    for (int k2 = 0; k2 < 2; ++k2) {
                        u32x4 w; w.x = pk2(s[2 * k2][nt][0], s[2 * k2][nt][1]); w.y = pk2(s[2 * k2][nt][2], s[2 * k2][nt][3]);
                        w.z = pk2(s[2 * k2 + 1][nt][0], s[2 * k2 + 1][nt][1]); w.w = pk2(s[2 * k2 + 1][nt][2], s[2 * k2 + 1][nt][3]);
                        pf[nt][k2] = __builtin_bit_cast(bf16x8, w);
                    }
                }
                if (__any(al[0] != 1.0f || al[1] != 1.0f)) {
#pragma unroll
                    for (int mt = 0; mt < 8; ++mt) { O[mt][0] *= al[0]; O[mt][1] *= al[1]; }
                }
                {
                    u32x2 vf[2][2][2];
                    const LAS unsigned* vbase = VT + fr * 36 + 2 * g;
#pragma unroll
                    for (int k2 = 0; k2 < 2; ++k2) { vf[0][k2][0] = *(const LAS u32x2*)(vbase + 16 * k2); vf[0][k2][1] = *(const LAS u32x2*)(vbase + 16 * k2 + 8); }
#pragma unroll
                    for (int mt = 0; mt < 8; ++mt) {
                        if (mt < 7) {
#pragma unroll
                            for (int k2 = 0; k2 < 2; ++k2) { vf[(mt + 1) & 1][k2][0] = *(const LAS u32x2*)(vbase + 16 * (mt + 1) * 36 + 16 * k2); vf[(mt + 1) & 1][k2][1] = *(const LAS u32x2*)(vbase + 16 * (mt + 1) * 36 + 16 * k2 + 8); }
                            asm volatile("s_waitcnt lgkmcnt(4)" ::: "memory");
                        } else asm volatile("s_waitcnt lgkmcnt(0)" ::: "memory");
                        __builtin_amdgcn_sched_barrier(0);
#pragma unroll
                        for (int k2 = 0; k2 < 2; ++k2) {
                            const u32x2 lo = vf[mt & 1][k2][0], hi = vf[mt & 1][k2][1];
                            const bf16x8 a = __builtin_bit_cast(bf16x8, ((u32x4){lo.x, lo.y, hi.x, hi.y}));
                            O[mt][0] = __builtin_amdgcn_mfma_f32_16x16x32_bf16(a, pf[0][k2], O[mt][0], 0, 0, 0);
                            O[mt][1] = __builtin_amdgcn_mfma_f32_16x16x32_bf16(a, pf[1][k2], O[mt][1], 0, 0, 0);
                        }
                        __builtin_amdgcn_sched_barrier(0);
                    }
                }
            }
            if (kt + 1 < ntile) ATT_WRITE((kt + 1) & 1);
            __syncthreads();
        }
#undef ATT_PREFETCH
#undef ATT_WRITE
#pragma unroll
        for (int nt = 0; nt < 2; ++nt) {
            float l = l_part[nt]; l = xor16_sum(l); l = xor32_sum(l);
            const float inv = 1.0f / l;
            bf16_t* orow = ob + (size_t)(q0 + 16 * nt + fr) * 1024 + h * 128 + 4 * g;
#pragma unroll
            for (int mt = 0; mt < 8; ++mt) { u32x2 w; w.x = pk2(O[mt][nt][0] * inv, O[mt][nt][1] * inv); w.y = pk2(O[mt][nt][2] * inv, O[mt][nt][3] * inv); *(u32x2*)(orow + 16 * mt) = w; }
        }
    }
    __syncthreads();
}

__device__ __forceinline__ unsigned dpp_umax_step_shr(unsigned v, int) { return v; }
__device__ __forceinline__ unsigned wave_umax(unsigned v) {
    unsigned t;
    t = (unsigned)__builtin_amdgcn_update_dpp(0, (int)v, 0x111, 0xf, 0xf, true); v = v > t ? v : t;
    t = (unsigned)__builtin_amdgcn_update_dpp(0, (int)v, 0x112, 0xf, 0xf, true); v = v > t ? v : t;
    t = (unsigned)__builtin_amdgcn_update_dpp(0, (int)v, 0x114, 0xf, 0xf, true); v = v > t ? v : t;
    t = (unsigned)__builtin_amdgcn_update_dpp(0, (int)v, 0x118, 0xf, 0xf, true); v = v > t ? v : t;
    t = (unsigned)__builtin_amdgcn_update_dpp(0, (int)v, 0x142, 0xa, 0xf, false); v = v > t ? v : t;
    t = (unsigned)__builtin_amdgcn_update_dpp(0, (int)v, 0x143, 0xc, 0xf, false); v = v > t ? v : t;
    return (unsigned)__builtin_amdgcn_readlane((int)v, 63);
}
template <int CTRL> __device__ __forceinline__ float dpp_f(float v) { return __builtin_bit_cast(float, __builtin_amdgcn_update_dpp(0, __builtin_bit_cast(int, v), CTRL, 0xf, 0xf, false)); }
template <int CTRL> __device__ __forceinline__ void top2_merge(float& t1, float& t2) { const float p1 = dpp_f<CTRL>(t1), p2 = dpp_f<CTRL>(t2); const float n1 = fmaxf(t1, p1), n2 = fmaxf(fminf(t1, p1), fmaxf(t2, p2)); t1 = n1; t2 = n2; }
__device__ __forceinline__ void route_row2(const float* lrow, const float* brt, int* tidx, float* tw, LAS int* etab, int lane) {
    const f32x4 bb = *(const f32x4*)(brt + 4 * lane);
    float sc[2][4], mv[2][4], t1[2], t2[2];
#pragma unroll
    for (int q = 0; q < 2; ++q) {
        const f32x4 lg = *(const f32x4*)(lrow + q * 256 + 4 * lane);
#pragma unroll
        for (int i = 0; i < 4; ++i) { sc[q][i] = sigm(lg[i]); mv[q][i] = sc[q][i] + bb[i]; }
        t1[q] = fmaxf(fmaxf(mv[q][0], mv[q][1]), fmaxf(mv[q][2], mv[q][3]));
        const float a = fmaxf(mv[q][0], mv[q][1]), bq = fminf(mv[q][0], mv[q][1]), c = fmaxf(mv[q][2], mv[q][3]), d = fminf(mv[q][2], mv[q][3]); t2[q] = fmaxf(fminf(a, c), fmaxf(bq, d));
    }
    top2_merge<0xB1>(t1[0], t2[0]); top2_merge<0xB1>(t1[1], t2[1]);
    top2_merge<0x4E>(t1[0], t2[0]); top2_merge<0x4E>(t1[1], t2[1]);
    top2_merge<0x141>(t1[0], t2[0]); top2_merge<0x141>(t1[1], t2[1]);
    const int mygrp = lane >> 3;
#pragma unroll
    for (int q = 0; q < 2; ++q) {
        const float gs = t1[q] + t2[q]; int rank = 0;
#pragma unroll
        for (int j = 0; j < 8; ++j) { const float o = __builtin_bit_cast(float, __builtin_amdgcn_readlane(__builtin_bit_cast(int, gs), 8 * j)); rank += (o > gs || (o == gs && j < mygrp)) ? 1 : 0; }
        if (rank >= 4) {
#pragma unroll
            for (int i = 0; i < 4; ++i) mv[q][i] = -3.0e38f;
        }
    }
    float wsel[2] = {0.f, 0.f}, wsum[2] = {0.f, 0.f}; int esel[2] = {0, 0};
#pragma unroll
    for (int r = 0; r < 8; ++r) {
        unsigned key[2];
#pragma unroll
        for (int q = 0; q < 2; ++q) {
            float bv = mv[q][0]; int bi = 0;
#pragma unroll
            for (int i = 1; i < 4; ++i) if (mv[q][i] > bv) { bv = mv[q][i]; bi = i; }
            unsigned u = __builtin_bit_cast(unsigned, bv); u = (u & 0x80000000u) ? ~u : (u | 0x80000000u);
            key[q] = (u & 0xFFFFFF00u) | (unsigned)(255 - (4 * lane + bi));
        }
        unsigned v0 = key[0], v1 = key[1], t0, t1_;
#define RSTEP(ctrl, rm, bc) t0 = (unsigned)__builtin_amdgcn_update_dpp(0, (int)v0, ctrl, rm, 0xf, bc); t1_ = (unsigned)__builtin_amdgcn_update_dpp(0, (int)v1, ctrl, rm, 0xf, bc); v0 = v0 > t0 ? v0 : t0; v1 = v1 > t1_ ? v1 : t1_;
        RSTEP(0x111, 0xf, true) RSTEP(0x112, 0xf, true) RSTEP(0x114, 0xf, true) RSTEP(0x118, 0xf, true) RSTEP(0x142, 0xa, false) RSTEP(0x143, 0xc, false)
#undef RSTEP
        const unsigned km[2] = {(unsigned)__builtin_amdgcn_readlane((int)v0, 63), (unsigned)__builtin_amdgcn_readlane((int)v1, 63)};
#pragma unroll
        for (int q = 0; q < 2; ++q) {
            const int e = 255 - (int)(km[q] & 255u), ii = e & 3;
            const float cand = ii == 0 ? sc[q][0] : ii == 1 ? sc[q][1] : ii == 2 ? sc[q][2] : sc[q][3];
            const float sv = __builtin_bit_cast(float, __builtin_amdgcn_readlane(__builtin_bit_cast(int, cand), e >> 2));
#pragma unroll
            for (int i = 0; i < 4; ++i) mv[q][i] = (4 * lane + i == e) ? -3.0e38f : mv[q][i];
            wsum[q] += sv;
            if (lane == r) { wsel[q] = sv; esel[q] = e; }
        }
    }
    if (lane < 8) {
#pragma unroll
        for (int q = 0; q < 2; ++q) { tidx[q * 8 + lane] = esel[q]; tw[q * 8 + lane] = wsel[q] / wsum[q] * 2.5f; etab[q * 8 + lane] = esel[q]; }
    }
}

__global__ void __launch_bounds__(NTHR, 2) mk_fwd(Params p) {
    extern __shared__ __attribute__((aligned(16))) unsigned char lds_raw[];
    LAS unsigned char* lds = (LAS unsigned char*)lds_raw;
    int tid = threadIdx.x, lane = tid & 63; const int wave = __builtin_amdgcn_readfirstlane(tid >> 6);
#define FRESH_IDS() do { int _t = threadIdx.x; asm volatile("; fresh ids" : "+v"(_t)); tid = _t; lane = _t & 63; } while (0)
    const int c = blockIdx.x, G = gridDim.x;
    const int gw = c * 8 + wave, ngw = G * 8;
    unsigned char* ws = p.ws;
    volatile LAS unsigned* MISC = (volatile LAS unsigned*)(lds + LDS_MISC);
    for (int u = tid; u < (LDS_BYTES - LDS_MISC) / 4; u += NTHR) ((LAS unsigned*)(lds + LDS_MISC))[u] = 0u;
    __syncthreads();
    XcdBarrier bar; bar.bar = (unsigned*)(ws + WS_BAR); bar.x = 0; bar.st = nullptr;
#if MK_ONE_LAUNCH
    bar = xcd_barrier_post((unsigned*)(ws + WS_BAR), MISC + 8);
#endif
    const int lo = p.ph_lo, hi = p.ph_hi;
#ifndef PH_MASK
#define PH_MASK 0x1ffff
#endif
#define IN(k) (((PH_MASK >> (k)) & 1) && lo <= (k) && (k) < hi)
#define SEAM(k) do { if (IN(k) && IN((k) + 1)) xcd_barrier(bar); } while (0)

    if (IN(0)) { FRESH_IDS(); phase0(p, lds, gw, ngw, lane, wave); }
    SEAM(0);
    if (IN(1)) { FRESH_IDS(); phase1(p, gw, ngw, lane); }
    SEAM(1);
    if (IN(2)) { FRESH_IDS();
        pg8::Gemm g{(const bf16_t*)(ws + WS_BIG(0)), (const bf16_t*)(ws + WS_WIN), 1024, nullptr};
        pg8::StaticOrder S; S.init(NTOK, 13 * 256, G, c); S.remap = 1;
        EpiWin E; E.q = (bf16_t*)(ws + WS_BIG(1)); E.k = E.q + (size_t)NTOK * 512; E.v = (bf16_t*)(ws + WS_BIG(2)); E.gr = (bf16_t*)(ws + WS_BIG(3));
        E.cq = (bf16_t*)(ws + WS_BIG(4)); E.ckv = E.cq + (size_t)NTOK * 768; E.sa = (bf16_t*)(ws + WS_BIG(5)); E.sb = (bf16_t*)(ws + WS_BIG(6));
        E.kr = (bf16_t*)(ws + WS_KR); E.ga = (float*)(ws + WS_GA);
        E.rope = (const float*)((unsigned char*)p.out + 192 * MiB); E.f8 = 0; E.ascale = 1.0f;
        pg8::gemm_phase<EpiWin, pg8::StaticOrder, false>(lds, g, S, E);
        pg8::Gemm g8{(const bf16_t*)(ws + WS_BIG(7)), (const bf16_t*)(ws + WS_WIN8), 512, nullptr};
        pg8::StaticOrder S8; S8.init(NTOK, 12 * 256, G, c);
        E.f8 = 1; E.ascale = 1.0f / 32.0f;
        pg8::gemm_phase<EpiWin, pg8::StaticOrder, false, true>(lds, g8, S8, E);
    }
    SEAM(2);
    if (IN(3)) { FRESH_IDS();
#ifndef NO_GLA
        if (c < 128 && !(p.flags & 1)) gla_phase(p, lds, c, (p.flags & 2) != 0);
#endif
#ifndef NO_P3GEMM
        if (!(p.flags & 2)) { const int pm = c;
            {
                const bf16_t* cqb = (const bf16_t*)(ws + WS_BIG(4)); const bf16_t* ckvb = cqb + (size_t)NTOK * 768;
                float* cqss = (float*)(ws + WS_CQSS); float* ckvss = (float*)(ws + WS_CKVSS);
                for (int r = 0; r < 32; ++r) { const int row = pm * 256 + wave * 32 + r;
                    float s = 0.f;
#pragma unroll
                    for (int j = 0; j < 3; ++j) { const u32x2 w = *((const u32x2*)(cqb + (size_t)row * 768) + lane + 64 * j); const float a0 = bflo(w.x), a1 = bfhi(w.x), a2 = bflo(w.y), a3 = bfhi(w.y); s += (a0 * a0 + a1 * a1) + (a2 * a2 + a3 * a3); }
                    const u32x2 w = *((const u32x2*)(ckvb + (size_t)row * 256) + lane); const float a0 = bflo(w.x), a1 = bfhi(w.x), a2 = bflo(w.y), a3 = bfhi(w.y);
                    const float s1 = wave_sum(s), s2 = wave_sum((a0 * a0 + a1 * a1) + (a2 * a2 + a3 * a3));
                    if (lane == 0) { cqss[row] = s1; ckvss[row] = s2; } }
                if (c >= 128 && G == 256) {
                    for (int r = 0; r < 32; ++r) { const int row = (pm - 128) * 256 + wave * 32 + r;
                        float s = 0.f;
#pragma unroll
                        for (int j = 0; j < 3; ++j) { const u32x2 w = *((const u32x2*)(cqb + (size_t)row * 768) + lane + 64 * j); const float a0 = bflo(w.x), a1 = bfhi(w.x), a2 = bflo(w.y), a3 = bfhi(w.y); s += (a0 * a0 + a1 * a1) + (a2 * a2 + a3 * a3); }
                        const float s1 = wave_sum(s);
                        if (lane == 0) cqss[row] = s1; }
                }
                wg_global_sync();
            }
#ifndef NO_QF
            {
                constexpr int QSPLIT = 2;
                const bool glawg = (c < 128) && G == 256;
                EpiQF E{(bf16_t*)p.out, (const float*)(ws + WS_CQSS), (const float*)((unsigned char*)p.out + 192 * MiB)};
                pg8::Gemm g{(const bf16_t*)(ws + WS_BIG(4)), (const bf16_t*)(ws + WS_WUQ), 768, nullptr};
                if (!glawg && G == 256) { pg8::PanelOrder S{pm - 128, 6 - QSPLIT, QSPLIT}; pg8::gemm_phase<EpiQF, pg8::PanelOrder, false>(lds, g, S, E); }
                { pg8::PanelOrder S{pm, glawg ? QSPLIT : 6, 0}; pg8::gemm_phase<EpiQF, pg8::PanelOrder, false>(lds, g, S, E); }
            }
#endif
#ifndef NO_KV
            { const K256Store E{(bf16_t*)(ws + WS_BIG(0)), 1024, (const float*)(ws + WS_CKVSS), 1.0f / 256.0f, (bf16_t*)(ws + WS_BIG(7)), 1024, 0};
              gemm_k256(lds, (const bf16_t*)(ws + WS_BIG(4)) + (size_t)NTOK * 768 + (size_t)pm * 65536, (const bf16_t*)(ws + WS_WUKV), 32, pm * 256, E); }
#endif
        }
#endif
    }
    SEAM(3);
    if (IN(4)) { FRESH_IDS(); attn_phase(p, lds, c); }
    SEAM(4);
    if (IN(5)) { FRESH_IDS();
        LAS int* hist = (LAS int*)lds;
        { const int pm = c;
            bf16_t* Y = (bf16_t*)(ws + WS_BIG(2));
            { pg8::Gemm g{(const bf16_t*)(ws + WS_BIG(3)), (const bf16_t*)(ws + WS_WGLAO), 1024, nullptr}; pg8::PanelOrder S{pm, 4, 0};
              EpiGate<false> E{Y, (const unsigned char*)(ws + WS_BIG(5))}; pg8::gemm_phase<EpiGate<false>, pg8::PanelOrder, false>(lds, g, S, E); }
            { pg8::Gemm g{(const bf16_t*)(ws + WS_BIG(1)), (const bf16_t*)(ws + WS_WMLAO), 1024, nullptr}; pg8::PanelOrder S{pm, 4, 0};
              EpiGate<true> E{Y, (const unsigned char*)(ws + WS_BIG(6))}; pg8::gemm_phase<EpiGate<true>, pg8::PanelOrder, false>(lds, g, S, E); }
            wg_global_sync();
            { pg8::Gemm g{Y, (const bf16_t*)(ws + WS_WOUT), 1024, nullptr}; pg8::PanelOrder S{pm, 4, 0};
              EpiBf16 E{(bf16_t*)(ws + ((p.flags & 4096) ? WS_BIG(7) : WS_BIG(1))), 1024}; pg8::gemm_phase<EpiBf16, pg8::PanelOrder, false>(lds, g, S, E); }
            wg_global_sync();
            if (!(p.flags & 4)) {
                const int b = pm >> 3; const float* mod = (const float*)(ws + WS_MOD) + b * 6144;
                const bf16_t* mix = (const bf16_t*)(ws + ((p.flags & 4096) ? WS_BIG(7) : WS_BIG(1))); bf16_t* h2 = (bf16_t*)(ws + WS_BIG(4));
                f32x4 g1[4], gg[4], gb[4], s2v[4], h2v[4];
#pragma unroll
                for (int j = 0; j < 4; ++j) { const int ci = lane + 64 * j; g1[j] = ((const f32x4*)(mod + 2048))[ci] + 1.0f; gg[j] = ((const f32x4*)p.in[I_LN1G])[ci]; gb[j] = ((const f32x4*)p.in[I_LN1B])[ci];
                    s2v[j] = ((const f32x4*)(mod + 4096))[ci] + 1.0f; h2v[j] = ((const f32x4*)(mod + 3072))[ci]; }
                for (int r0 = 0; r0 < 32; r0 += 4) {
                    const int row0 = pm * 256 + wave * 32 + r0;
                    f32x4 v[4][4]; u32x2 mw[4][4];
#pragma unroll
                    for (int t = 0; t < 4; ++t)
#pragma unroll
                        for (int j = 0; j < 4; ++j) { v[t][j] = ((const f32x4*)(p.in[I_X] + (size_t)(row0 + t) * 1024))[lane + 64 * j]; mw[t][j] = ((const u32x2*)(mix + (size_t)(row0 + t) * 1024))[lane + 64 * j]; }
#pragma unroll
                    for (int t = 0; t < 4; ++t) {
                        float s = 0.f;
#pragma unroll
                        for (int j = 0; j < 4; ++j) { const u32x2 w = mw[t][j]; v[t][j] = v[t][j] * ALPHA + g1[j] * (f32x4){bflo(w.x), bfhi(w.x), bflo(w.y), bfhi(w.y)}; s += (v[t][j][0] + v[t][j][1]) + (v[t][j][2] + v[t][j][3]); }
                        const float mean = wave_sum(s) * (1.f / 1024.f); float q = 0.f;
#pragma unroll
                        for (int j = 0; j < 4; ++j) { v[t][j] = v[t][j] - mean; q += (v[t][j][0] * v[t][j][0] + v[t][j][1] * v[t][j][1]) + (v[t][j][2] * v[t][j][2] + v[t][j][3] * v[t][j][3]); }
                        const float rstd = rsqrtf(wave_sum(q) * (1.f / 1024.f) + LN_EPS);
#pragma unroll
                        for (int j = 0; j < 4; ++j) { const f32x4 x1 = v[t][j] * rstd * gg[j] + gb[j];
                            { u32x2 xw; xw.x = pk2(x1[0], x1[1]); xw.y = pk2(x1[2], x1[3]); ((u32x2*)(p.out + (size_t)(row0 + t) * 1024))[lane + 64 * j] = xw; }
                            const f32x4 hh = x1 * s2v[j] + h2v[j]; u32x2 w; w.x = pk2(hh[0], hh[1]); w.y = pk2(hh[2], hh[3]);
                            ((u32x2*)(h2 + (size_t)(row0 + t) * 1024))[lane + 64 * j] = w;
                            unsigned w8 = 0u; w8 = __builtin_amdgcn_cvt_pk_fp8_f32(hh[0], hh[1], w8, false); w8 = __builtin_amdgcn_cvt_pk_fp8_f32(hh[2], hh[3], w8, true);
                            ((unsigned*)(ws + WS_BIG(6) + 64 * MiB + (size_t)(row0 + t) * 1024))[lane + 64 * j] = w8; }
                    }
                }
            }
            wg_global_sync();
            { pg8::Gemm g{(const bf16_t*)(ws + WS_BIG(4)), (const bf16_t*)(ws + WS_WRT), 1024, nullptr}; pg8::PanelOrder S{pm, 1, 0};
              EpiF32 E{(float*)(ws + WS_BIG(0)), 256}; pg8::gemm_phase<EpiF32, pg8::PanelOrder, false>(lds, g, S, E); }
            { pg8::Gemm g{(const bf16_t*)(ws + WS_BIG(4)), (const bf16_t*)(ws + WS_WS13), 1024, nullptr}; pg8::PanelOrder S{pm, 2, 0};
              EpiGLU E{(bf16_t*)(ws + WS_BIG(0) + 64 * MiB), 1.0f, 0}; pg8::gemm_phase<EpiGLU, pg8::PanelOrder, false>(lds, g, S, E); }
            wg_global_sync();
            { const K256Store E{(bf16_t*)(ws + WS_BIG(7)), 1024, nullptr, 0.f, nullptr, 0, 0};
              gemm_k256(lds, (const bf16_t*)(ws + WS_BIG(0) + 64 * MiB) + (size_t)pm * 65536, (const bf16_t*)(ws + WS_WS2), 16, pm * 256, E); }
            if (!(p.flags & 8)) {
            LAS int* etab = (LAS int*)(lds + 1024);
            LAS int* lrk = (LAS int*)(lds + 1024 + 8192);
            __syncthreads();
            for (int r = 0; r < 32; r += 2) { const int rl = wave * 32 + r, row = pm * 256 + rl;
                route_row2((const float*)(ws + WS_BIG(0)) + (size_t)row * 256, p.in[I_BRT], (int*)(ws + WS_TIDX) + row * 8, (float*)(ws + WS_TW) + row * 8, etab + rl * 8, lane); }
            __syncthreads();
            if (tid < 256) { int cnt = 0;
#pragma unroll 8
                for (int a2 = 0; a2 < 2048; ++a2) if (etab[a2] == tid) { lrk[a2] = cnt; ++cnt; }
                hist[tid] = cnt; }
            __syncthreads();
            if (tid < 256) ((int*)(ws + WS_CNTWG))[pm * 256 + tid] = hist[tid];
#pragma unroll
            for (int i = 0; i < 4; ++i) ((int*)(ws + WS_LRANK))[pm * 2048 + tid + 512 * i] = lrk[tid + 512 * i];
            __syncthreads();
            }
        }
    }
    SEAM(5);
    if (IN(6)) { FRESH_IDS();
        LAS int* pstart = (LAS int*)lds;
        LAS int* wbase = (LAS int*)(lds + 2048);
        LAS int* tot = (LAS int*)(lds + 4096);
        const int* cntwg = (const int*)(ws + WS_CNTWG);
        { const int pm = c;
            if (tid < 256) { int t = 0, bs = 0; for (int w = 0; w < 256; ++w) { const int v = cntwg[w * 256 + tid]; t += v; bs += (w < pm) ? v : 0; } tot[tid] = t; wbase[tid] = bs; }
            __syncthreads();
            if (tid == 0) { int run = 0; for (int e = 0; e < 256; ++e) { pstart[e] = run; run += (tot[e] + 255) & ~255; } pstart[256] = run; }
            __syncthreads();
            if (pm == 0 && tid <= 256) ((int*)(ws + WS_TAB))[tid] = pstart[tid];
            const int* tidx = (const int*)(ws + WS_TIDX); int* lrank = (int*)(ws + WS_LRANK);
            int* stok = (int*)(ws + WS_STOK);
#pragma unroll
            for (int i = 0; i < 4; ++i) { const int a = pm * 2048 + tid * 4 + i; const int e = tidx[a]; const int slot = pstart[e] + wbase[e] + lrank[a]; stok[slot] = a >> 3; ((int*)(ws + WS_SW))[a] = slot; }
            __syncthreads();
        }
        LAS unsigned* scr = (LAS unsigned*)(lds + 8192 + wave * 8448);
        bf16_t* e13 = (bf16_t*)(ws + WS_BIG(5)); bf16_t* e2 = (bf16_t*)(ws + WS_BIG(0));
        for (int it = gw; it < 256 * 192; it += ngw) {
            const int e = it / 192, r = it % 192;
            if (r < 128) tr_glu8_item(p.in[I_WE1] + (size_t)e * 262144, p.in[I_WE3] + (size_t)e * 262144, 1024, 256, (unsigned char*)e13 + (size_t)e * 524288, scr, r >> 3, r & 7, lane);
            else { const int r2 = r - 128; tr8_item(p.in[I_WE2] + (size_t)e * 262144, 256, 1024, (unsigned char*)e2 + (size_t)e * 262144, MapId{0}, scr, r2 >> 4, r2 & 15, lane); }
        }
    }
    SEAM(6);
    constexpr int GT = 1536, NGRP = 2;
    bf16_t* ffn = (bf16_t*)(ws + WS_BIG(7));
    unsigned char* out8 = ws + WS_BIG(1);
    bf16_t* hidscr = c < 192 ? (bf16_t*)(ws + WS_WIN) + (size_t)c * 65536 : (bf16_t*)(ws + WS_KR) + (size_t)(c - 192) * 65536;
    for (int grp = 0; grp < NGRP; ++grp) {
        const int phg = 7 + 2 * grp;
        if (IN(phg)) { FRESH_IDS();
            LAS int* pstart = (LAS int*)(lds + LDS_MISC + 256);
            for (int i = tid; i <= 256; i += NTHR) pstart[i] = ((const int*)(ws + WS_TAB))[i];
            __syncthreads();
            const int ntiles = pstart[256] >> 8;
            const int t1 = (grp + 1) * GT < ntiles ? (grp + 1) * GT : ntiles;
            for (int T = grp * GT + (c & 7) * 32 + (c >> 3); T < t1; T += G) {
                int e = 0; { int lo_ = 0, hi_ = 256; while (hi_ - lo_ > 1) { const int mid = (lo_ + hi_) >> 1; if ((pstart[mid] >> 8) <= T) lo_ = mid; else hi_ = mid; } e = lo_; }
                e = __builtin_amdgcn_readfirstlane(e);
                if (!(p.flags & 32)) { pg8::Gemm g{(const bf16_t*)(ws + WS_BIG(6) + 64 * MiB), (const bf16_t*)(ws + WS_BIG(5)) + (size_t)e * 262144, 512, (const int*)(ws + WS_STOK)}; pg8::PanelOrder S{T, 2, 0};
                  EpiGLU E{(bf16_t*)((unsigned char*)hidscr - (ptrdiff_t)T * 65536), 1.0f / 32.0f, 1}; pg8::gemm_phase<EpiGLU, pg8::PanelOrder, true, true>(lds, g, S, E); }
                wg_global_sync();
                if (!(p.flags & 64)) gemm_k256_f8(lds, (const unsigned char*)hidscr, ws + WS_BIG(0) + (size_t)e * 262144, 8, T * 256, out8 - (ptrdiff_t)grp * GT * 262144, 1024, 1.0f / 32.0f);
            }
        }
        SEAM(phg);
        if (IN(phg + 1)) { FRESH_IDS();
            const int s0 = grp * GT * 256, s1 = s0 + GT * 256;
            const int* slot_of = (const int*)(ws + WS_SW); const float* tw = (const float*)(ws + WS_TW);
            const bool fin = (grp == NGRP - 1);
#define F8_ACC(dst, w16, wk) do { const u32x4 w_ = (w16); const float k_ = (wk); _Pragma("unroll") for (int j_ = 0; j_ < 4; ++j_) { \
                const f32x2 lo_ = __builtin_amdgcn_cvt_pk_f32_fp8(w_[j_], false), hi_ = __builtin_amdgcn_cvt_pk_f32_fp8(w_[j_], true); \
                dst[j_] += (f32x4){lo_[0], lo_[1], hi_[0], hi_[1]} * k_; } } while (0)
            for (int m0 = gw * 4; m0 < NTOK; m0 += ngw * 4) {
                int sl = -1; float wv = 0.f;
                if (lane < 32) { sl = slot_of[m0 * 8 + lane]; wv = tw[m0 * 8 + lane] * (1.0f / F8_SCALE); }
                const bool hit = sl >= s0 && sl < s1;
                const unsigned long long bal = __ballot(hit);
                f32x4 a[4][4];
#pragma unroll
                for (int t = 0; t < 4; ++t) { const u32x4* fr4 = (const u32x4*)(ffn + (size_t)(m0 + t) * 1024) + 2 * lane; const u32x4 f0 = fr4[0], f1 = fr4[1];
                    unpack8(f0, a[t][0], a[t][1]); unpack8(f1, a[t][2], a[t][3]); }
                u32x4 rw[4][3]; float rwt[4][3];
#pragma unroll
                for (int t = 0; t < 4; ++t) {
                    unsigned mk = (unsigned)(bal >> (8 * t)) & 0xffu;
#pragma unroll
                    for (int q = 0; q < 3; ++q) {
                        const int k = mk ? __builtin_ctz(mk) : 0; const bool ok = mk != 0u; mk &= mk - 1u;
                        const int sk = __shfl(sl, 8 * t + k); rwt[t][q] = ok ? __shfl(wv, 8 * t + k) : 0.f;
                        u32x4 w = __builtin_nontemporal_load((const u32x4*)(out8 + (size_t)(ok ? sk - s0 : 0) * 1024) + lane); if (!ok) w = (u32x4){0u, 0u, 0u, 0u};
                        rw[t][q] = w;
                    }
                }
#pragma unroll
                for (int t = 0; t < 4; ++t) {
#pragma unroll
                    for (int q = 0; q < 3; ++q) F8_ACC(a[t], rw[t][q], rwt[t][q]);
                    unsigned mk = (unsigned)(bal >> (8 * t)) & 0xffu; mk &= mk - 1u; mk &= mk - 1u; mk &= mk - 1u;
                    while (mk) { const int k = __builtin_ctz(mk); mk &= mk - 1u; const int sk = __shfl(sl, 8 * t + k); const float wk = __shfl(wv, 8 * t + k);
                        const u32x4 w = __builtin_nontemporal_load((const u32x4*)(out8 + (size_t)(sk - s0) * 1024) + lane); F8_ACC(a[t], w, wk); }
                }
                if (!fin) {
#pragma unroll
                    for (int t = 0; t < 4; ++t) if (((bal >> (8 * t)) & 0xffull) != 0ull && !(p.flags & 16)) {
                        u32x4* fw4 = (u32x4*)(ffn + (size_t)(m0 + t) * 1024) + 2 * lane; fw4[0] = pack8(a[t][0], a[t][1]); fw4[1] = pack8(a[t][2], a[t][3]); }
                } else {
                    const int b = m0 >> 11; const float* gt2 = (const float*)(ws + WS_MOD) + b * 6144 + 5 * 1024;
                    f32x4 gv[4], lg[4], lb[4];
#pragma unroll
                    for (int j = 0; j < 4; ++j) { gv[j] = ((const f32x4*)gt2)[4 * lane + j] + 1.0f; lg[j] = ((const f32x4*)p.in[I_LN2G])[4 * lane + j]; lb[j] = ((const f32x4*)p.in[I_LN2B])[4 * lane + j]; }
                    f32x4 v[4][4];
#pragma unroll
                    for (int t = 0; t < 4; ++t)
#pragma unroll
                        for (int j = 0; j < 4; j += 2) { const u32x4 xw = ((const u32x4*)(p.out + (size_t)(m0 + t) * 1024))[2 * lane + (j >> 1)]; unpack8(xw, v[t][j], v[t][j + 1]); }
#pragma unroll
                    for (int t = 0; t < 4; ++t) {
                        float sacc = 0.f;
#pragma unroll
                        for (int j = 0; j < 4; ++j) { v[t][j] = v[t][j] * ALPHA + gv[j] * a[t][j]; sacc += (v[t][j][0] + v[t][j][1]) + (v[t][j][2] + v[t][j][3]); }
                        const float mean = wave_sum(sacc) * (1.f / 1024.f); float s2 = 0.f;
#pragma unroll
                        for (int j = 0; j < 4; ++j) { v[t][j] = v[t][j] - mean; s2 += (v[t][j][0] * v[t][j][0] + v[t][j][1] * v[t][j][1]) + (v[t][j][2] * v[t][j][2] + v[t][j][3] * v[t][j][3]); }
                        const float rstd = rsqrtf(wave_sum(s2) * (1.f / 1024.f) + LN_EPS);
#pragma unroll
                        for (int j = 0; j < 4; ++j) ((f32x4*)(p.out + (size_t)(m0 + t) * 1024))[4 * lane + j] = v[t][j] * rstd * lg[j] + lb[j];
                    }
                }
            }
#undef F8_ACC
        }
        if (grp < NGRP - 1) SEAM(phg + 1);
    }
}


__global__ void dump_bf16(const bf16_t* src, float* dst, size_t n) { for (size_t i = (size_t)blockIdx.x * blockDim.x + threadIdx.x; i < n; i += (size_t)gridDim.x * blockDim.x) dst[i] = bf2f(src[i]); }
extern "C" void kernel_launch(void* const* d_in, const int* in_sizes, int n_in, void* d_out, int out_size, void* d_ws, size_t ws_size, hipStream_t stream) {
    static int ready = 0;
    if (!ready) {
        if (n_in != 28 || out_size != NTOK * DM || ws_size < WS_END) { fprintf(stderr, "kernel_launch: unexpected problem (n_in %d out %d ws %zu need %zu)\n", n_in, out_size, ws_size, (size_t)WS_END); return; }
        if (hipFuncSetAttribute((const void*)mk_fwd, hipFuncAttributeMaxDynamicSharedMemorySize, LDS_BYTES) != hipSuccess) { fprintf(stderr, "kernel_launch: hipFuncSetAttribute failed\n"); return; }
        ready = 1;
    }
    (void)hipMemsetAsync((char*)d_ws + WS_CTL, 0, CTL_ZERO_BYTES, stream);
    Params p{};
    for (int i = 0; i < 28; ++i) p.in[i] = (const float*)d_in[i];
    p.out = (float*)d_out; p.ws = (unsigned char*)d_ws;
#if MK_ONE_LAUNCH
    p.ph_lo = 0; p.ph_hi = 11;
    hipLaunchKernelGGL(mk_fwd, dim3(NWG), dim3(NTHR), LDS_BYTES, stream, p);
#else
#ifndef DIAG_NPH
#define DIAG_NPH 11
#endif
#ifndef DIAG_REP_MASK
#define DIAG_REP_MASK 0
#endif
#ifndef DIAG_REP_FLAGS
#define DIAG_REP_FLAGS 1
#endif
    for (int k = 0; k < DIAG_NPH; ++k) { p.ph_lo = k; p.ph_hi = k + 1;
        if (((DIAG_REP_MASK >> k) & 1) && (DIAG_REP_FLAGS & ~31)) { p.flags = DIAG_REP_FLAGS; hipLaunchKernelGGL(mk_fwd, dim3(NWG), dim3(NTHR), LDS_BYTES, stream, p); }
        p.flags = 0; hipLaunchKernelGGL(mk_fwd, dim3(NWG), dim3(NTHR), LDS_BYTES, stream, p);
        if (((DIAG_REP_MASK >> k) & 1) && !(DIAG_REP_FLAGS & ~31)) { p.flags = DIAG_REP_FLAGS; hipLaunchKernelGGL(mk_fwd, dim3(NWG), dim3(NTHR), LDS_BYTES, stream, p); } }
#ifdef DIAG_DUMP
    hipLaunchKernelGGL(dump_bf16, dim3(2048), dim3(256), 0, stream, (const bf16_t*)((unsigned char*)d_ws + DIAG_DUMP), (float*)d_out, (size_t)NTOK * 1024);
#endif
#endif
}
```

```cpp
#include <hip/hip_runtime.h>
#include <cstdio>
#include <cstdint>

#ifndef MK_ONE_LAUNCH
#define MK_ONE_LAUNCH 1
#endif

#define GAS __attribute__((address_space(1)))
#define LAS __attribute__((address_space(3)))
typedef unsigned short bf16_t;
typedef short bf16x8 __attribute__((ext_vector_type(8)));
typedef short bf16x4 __attribute__((ext_vector_type(4)));
typedef float f32x4 __attribute__((ext_vector_type(4)));
typedef float f32x2 __attribute__((ext_vector_type(2)));
typedef unsigned u32x4 __attribute__((ext_vector_type(4)));
typedef unsigned u32x2 __attribute__((ext_vector_type(2)));

constexpr int NTOK = 65536, DM = 1024, SEQ = 2048, NB = 32;
constexpr int NWG = 256, NTHR = 512;
constexpr float LN_EPS = 1e-5f, RMS_EPS = 1e-6f;
constexpr float ALPHA = 1.189207115002721f;
constexpr float QSCALE = 0.07216878364870322f * 1.4426950408889634f;
constexpr int NSLOT = 589824;

constexpr size_t MiB = 1u << 20;
constexpr size_t WS_CTL = 0, CTL_ZERO_BYTES = 3 * MiB;
constexpr size_t WS_BAR = 16384;
constexpr size_t WS_MOD = 1 * MiB;
constexpr size_t WS_CQSS = 2 * MiB, WS_CKVSS = 2 * MiB + 256 * 1024;
constexpr size_t WS_TAB = 3 * MiB;
constexpr size_t WS_CNTWG = 3 * MiB + 64 * 1024;
constexpr size_t WS_WIN = 4 * MiB;
constexpr size_t WS_WGLAO = WS_WIN + 6400 * 1024 * 2;
constexpr size_t WS_WUQ = WS_WGLAO + 2 * MiB;
constexpr size_t WS_WUKV = WS_WUQ + 1536 * 768 * 2;
constexpr size_t WS_WMLAO = WS_WUKV + 1 * MiB;
constexpr size_t WS_WOUT = WS_WMLAO + 2 * MiB;
constexpr size_t WS_WRT = WS_WOUT + 2 * MiB;
constexpr size_t WS_WS13 = WS_WRT + 512 * 1024;
constexpr size_t WS_WS2 = WS_WS13 + 1 * MiB;
static_assert(WS_WS2 + 512 * 1024 <= 28 * MiB, "small weights");
constexpr size_t WS_TIDX = 28 * MiB, WS_TW = 30 * MiB, WS_LRANK = 32 * MiB, WS_STOK = 34 * MiB, WS_SW = 37 * MiB;
constexpr size_t WS_WIN8 = 52 * MiB;
constexpr size_t WS_KR = 40 * MiB;
constexpr size_t WS_GA = 48 * MiB;
constexpr size_t WS_BIG0 = 56 * MiB, BIGU = 128 * MiB;
#define WS_BIG(i) (WS_BIG0 + (size_t)(i) * BIGU)
constexpr size_t WS_END = WS_BIG0 + 8 * BIGU;

typedef __bf16 bf16v2_t __attribute__((ext_vector_type(2)));
__device__ __forceinline__ unsigned pk2(float lo, float hi) { const f32x2 v = {lo, hi}; const bf16v2_t r = __builtin_convertvector(v, bf16v2_t); return __builtin_bit_cast(unsigned, r); }
__device__ __forceinline__ float bflo(unsigned w) { return __uint_as_float(w << 16); }
__device__ __forceinline__ float bfhi(unsigned w) { return __uint_as_float(w & 0xffff0000u); }
__device__ __forceinline__ float bf2f(bf16_t b) { return __uint_as_float(((unsigned)b) << 16); }
__device__ __forceinline__ bf16_t f2bf(float f) { return (bf16_t)(pk2(f, 0.f) & 0xffffu); }
__device__ __forceinline__ float sigm(float x) { return __builtin_amdgcn_rcpf(1.0f + __expf(-x)); }
__device__ __forceinline__ float silu(float x) { return x * __builtin_amdgcn_rcpf(1.0f + __expf(-x)); }
__device__ __forceinline__ float wave_sum(float v) {
#pragma unroll
    for (int o = 1; o < 64; o <<= 1) v += __shfl_xor(v, o);
    return v;
}
#define LDS_WAIT() asm volatile("s_waitcnt lgkmcnt(0)" ::: "memory")
#define VM_WAIT() asm volatile("s_waitcnt vmcnt(0)" ::: "memory")

#define XB_TMO      128
#define XB_XCNT(j)  (256  + 64 * (j))
#define XB_XSUB(j)  (1280 + 64 * (j))
#define XB_XGEN(j)  (2304 + 64 * (j))
#define XB_TOP      3328
#define XB_TOPGEN   3392
#define XCD_BAR_WORDS 3456
#define XB_SPIN_CAP (1u << 18)
__device__ __forceinline__ unsigned xb_ld(unsigned* p)              { return __hip_atomic_load(p, __ATOMIC_RELAXED, __HIP_MEMORY_SCOPE_AGENT); }
__device__ __forceinline__ unsigned xb_add(unsigned* p, unsigned v) { return __hip_atomic_fetch_add(p, v, __ATOMIC_RELAXED, __HIP_MEMORY_SCOPE_AGENT); }
__device__ __forceinline__ unsigned xb_xcc_id() { return (unsigned)__builtin_amdgcn_s_getreg((3 << 11) | 20) & 0xFu; }
#define XB_SPIN(cond, bar) do { unsigned _sp = 0; while (cond) { __builtin_amdgcn_s_sleep(1); \
    if ((++_sp & 255u) == 0u) { if (xb_ld(&(bar)[XB_TMO])) break; if (_sp > XB_SPIN_CAP) { atomicAdd(&(bar)[XB_TMO], 1u); break; } } } } while (0)
struct XcdBarrier { unsigned* bar; unsigned x; volatile LAS unsigned* st; };
__device__ __forceinline__ XcdBarrier xcd_barrier_post(unsigned* bar, volatile LAS unsigned* st) {
    XcdBarrier b; b.bar = bar; b.x = xb_xcc_id(); b.st = st;
    if (threadIdx.x == 0) (void)xb_add(&bar[XB_XCNT(b.x)], 1u);
    return b;
}
__device__ __forceinline__ void xcd_barrier_complete(unsigned* bar, unsigned x, unsigned& nloc, unsigned& nx) {
    const unsigned G = gridDim.x * gridDim.y * gridDim.z;
    unsigned sum, cnt, mine, sp = 0u;
    for (;;) {
        sum = 0u; cnt = 0u; mine = 0u;
#pragma unroll
        for (unsigned j = 0; j < 16; ++j) { const unsigned c = xb_ld(&bar[XB_XCNT(j)]); sum += c; cnt += (c > 0u) ? 1u : 0u; mine = (j == x) ? c : mine; }
        if (sum == G) break;
        __builtin_amdgcn_s_sleep(1);
        if ((++sp & 255u) == 0u) { if (xb_ld(&bar[XB_TMO])) break; if (sp > XB_SPIN_CAP) { atomicAdd(&bar[XB_TMO], 1u); break; } }
    }
    nloc = mine > 0u ? mine : 1u; nx = cnt > 0u ? cnt : 1u;
}
__device__ __forceinline__ void xcd_barrier(const XcdBarrier& b) {
    asm volatile("s_waitcnt vmcnt(0)" ::: "memory");
    __syncthreads();
    if (threadIdx.x == 0) {
        unsigned* bar = b.bar;
        __builtin_amdgcn_s_waitcnt(0);
        unsigned nloc = b.st[0], nx = b.st[1];
        if (nloc == 0u) { xcd_barrier_complete(bar, b.x, nloc, nx); b.st[0] = nloc; b.st[1] = nx; }
        const unsigned old = xb_add(&bar[XB_XSUB(b.x)], 1u);
        const unsigned gen = old / nloc;
        if (old + 1u == (gen + 1u) * nloc) {
            __builtin_amdgcn_fence(__ATOMIC_RELEASE, "agent");
            asm volatile("s_waitcnt vmcnt(0)" ::: "memory");
            const unsigned og = xb_add(&bar[XB_TOP], 1u);
            const unsigned tg = og / nx;
            if (og + 1u == (tg + 1u) * nx) xb_add(&bar[XB_TOPGEN], 1u);
            else XB_SPIN(xb_ld(&bar[XB_TOPGEN]) == tg, bar);
            __builtin_amdgcn_fence(__ATOMIC_ACQUIRE, "agent");
            xb_add(&bar[XB_XGEN(b.x)], 1u);
            asm volatile("s_waitcnt vmcnt(0)" ::: "memory");
        } else {
            XB_SPIN(xb_ld(&bar[XB_XGEN(b.x)]) == gen, bar);
            __builtin_amdgcn_fence(__ATOMIC_ACQUIRE, "agent");
            asm volatile("s_waitcnt vmcnt(0)" ::: "memory");
        }
    }
    __syncthreads();
}
__device__ __forceinline__ void wg_global_sync() {
    asm volatile("s_waitcnt vmcnt(0)" ::: "memory");
    __syncthreads();
    if (threadIdx.x < 64) {
        __builtin_amdgcn_fence(__ATOMIC_ACQUIRE, "agent");
        asm volatile("s_waitcnt vmcnt(0)" ::: "memory");
    }
    __syncthreads();
}

namespace pg8 {
constexpr int BM = 256, BK = 64, HALF = 128, HTB = HALF * BK * 2, STAGE_BYTES = 8 * HTB;
__host__ __device__ __forceinline__ int lds_byte(int r, int c) { const int st = (r >> 4) * 2 + (c >> 5), rr = r & 15, cc = c & 31, ob = rr * 64 + cc * 2; return st * 1024 + (ob ^ (((ob >> 9) & 1) << 5)); }
__host__ __device__ __forceinline__ void stage_rc(int b, int& R, int& C) { const int st = b / 1024, sb = b % 1024, swz = sb ^ (((sb >> 9) & 1) << 5); R = (st >> 1) * 16 + swz / 64; C = (st & 1) * 32 + (swz % 64) / 2; }
__host__ __device__ __forceinline__ int perm32(int rho) { const int n = rho >> 4, i = rho & 15; return 8 * (i >> 2) + 4 * n + (i & 3); }
struct Unit { int pm, pn; };
struct Gemm { const bf16_t* A; const bf16_t* Bt; int K; const int* rowidx; };
struct StaticOrder {
    int nM, nN, nwg, G, c, remap;
    __device__ void init(int M, int N, int G_, int c_) { nM = M / BM; nN = N / BM; nwg = nM * nN; G = G_; c = c_; remap = 0; }
    __device__ bool next(int i, Unit& u) const {
        const long L = (long)i * G + c; if (L >= nwg) return false;
        int wgid = (int)L; { const int q = nwg / 8, r = nwg % 8, xcd = wgid % 8, off = wgid / 8; wgid = (xcd < r ? xcd * (q + 1) : r * (q + 1) + (xcd - r) * q) + off; }
        const int nig = 8 * nN, gid = wgid / nig, fm = gid * 8, gsz = (nM - fm) < 8 ? (nM - fm) : 8;
        u.pm = fm + ((wgid % nig) % gsz); u.pn = (wgid % nig) / gsz; if (remap) u.pn = 24; return true;
    }
};
struct PanelOrder {
    int pm, nN, pn0;
    __device__ bool next(int i, Unit& u) const { int nq = nN; asm volatile("; opaque nN" : "+s"(nq)); if (i >= nq) return false; int a = pm, b = pn0 + i; asm volatile("; opaque unit" : "+s"(a), "+s"(b)); u.pm = a; u.pn = b; return true; }
};

typedef int i32x8 __attribute__((ext_vector_type(8)));
template <class Epi, class Sched, bool GATHER, bool FP8 = false>
__device__ __forceinline__ void gemm_phase(LAS unsigned char* lds, const Gemm g, const Sched& S, const Epi& E) {
    int tid_ = threadIdx.x; asm volatile("; pg8 ids" : "+v"(tid_));
    const int tid = tid_, wid = __builtin_amdgcn_readfirstlane(tid >> 6), lane = tid & 63, wr = wid >> 2, wc = wid & 3, fr = lane & 15, fq = lane >> 4;
    int Kq = g.K; asm volatile("; opaque K" : "+s"(Kq));
    const int K = Kq, nt = K / BK;
    Unit cur, nxt; int ui = 0;
    if (!S.next(0, cur)) return;
    unsigned aoff[2][2], voffB[2];
#pragma unroll
    for (int i = 0; i < 2; ++i) { int R, C; stage_rc(tid * 16 + i * 8192, R, C); const int Rb = Epi::PERM ? ((R & ~31) + perm32(R & 31)) : R;
        voffB[i] = (unsigned)(Rb * K + C) * 2u;
#pragma unroll
        for (int h = 0; h < 2; ++h) {
            if (GATHER) { int t = g.rowidx[cur.pm * BM + h * HALF + R]; t = t < 0 ? 0 : t; aoff[h][i] = (unsigned)(t * K + C) * 2u; }
            else aoff[h][i] = (unsigned)((h * HALF + R) * K + C) * 2u;
        } }
    const size_t kstep = (size_t)(BK * 2);
    const size_t hstep = (size_t)HALF * K * 2;
    const size_t tstep = 2 * hstep;
    const unsigned ldsw = (unsigned)wid * 1024u;
    const int aoffl0 = lds_byte(wr * 64 + fr, fq * 8), aoffl1 = aoffl0 + 1024;
    const int boffl0 = lds_byte(wc * 32 + fr, fq * 8), boffl1 = boffl0 + 1024;
#define PG8_SA(b, h) (((b) * 2 + (h)) * HTB)
#define PG8_SB(b, h) ((4 + (b) * 2 + (h)) * HTB)
#define PG8_STAGE(bufoff, gbase, voff) do { _Pragma("unroll") for (int _i = 0; _i < 2; ++_i) \
        __builtin_amdgcn_global_load_lds((const unsigned*)((const char*)(gbase) + (voff)[_i]), (LAS unsigned*)(lds + (bufoff) + ldsw + _i * 8192), 16, 0, 0); } while (0)
#define PG8_STAGE_A(bufoff, gbase, h) PG8_STAGE(bufoff, gbase, aoff[h])
#define PG8_LDA(dst, b, h) do { _Pragma("unroll") for (int m = 0; m < 4; ++m) _Pragma("unroll") for (int k = 0; k < 2; ++k) dst[m][k] = *(const LAS bf16x8*)(lds + PG8_SA(b, h) + aoffl0 + m * 2048 + k * 1024); } while (0)
#define PG8_LDA8(dst, b, h) do { _Pragma("unroll") for (int m = 0; m < 4; ++m) { const u32x4 x0_ = *(const LAS u32x4*)(lds + PG8_SA(b, h) + aoffl0 + m * 2048), x1_ = *(const LAS u32x4*)(lds + PG8_SA(b, h) + aoffl1 + m * 2048); dst[m] = __builtin_bit_cast(i32x8, __builtin_shufflevector(x0_, x1_, 0, 1, 2, 3, 4, 5, 6, 7)); } } while (0)
#define PG8_LDB(dst, b, h) do { _Pragma("unroll") for (int n = 0; n < 2; ++n) _Pragma("unroll") for (int k = 0; k < 2; ++k) dst[n][k] = *(const LAS bf16x8*)(lds + PG8_SB(b, h) + boffl0 + n * 2048 + k * 1024); } while (0)
#define PG8_LDB8(dst, b, h) do { _Pragma("unroll") for (int n = 0; n < 2; ++n) { const u32x4 x0_ = *(const LAS u32x4*)(lds + PG8_SB(b, h) + boffl0 + n * 2048), x1_ = *(const LAS u32x4*)(lds + PG8_SB(b, h) + boffl1 + n * 2048); dst[n] = __builtin_bit_cast(i32x8, __builtin_shufflevector(x0_, x1_, 0, 1, 2, 3, 4, 5, 6, 7)); } } while (0)
#define PG8_MMA(ai, bj, At, Bt) do { __builtin_amdgcn_s_setprio(1); _Pragma("unroll") for (int m = 0; m < 4; ++m) _Pragma("unroll") for (int n = 0; n < 2; ++n) _Pragma("unroll") for (int k = 0; k < 2; ++k) \
        acc[ai][bj][m][n] = __builtin_amdgcn_mfma_f32_16x16x32_bf16(Bt[n][k], At[m][k], acc[ai][bj][m][n], 0, 0, 0); __builtin_amdgcn_s_setprio(0); } while (0)
#define PG8_MMA8(ai, bj, At, Bt) do { __builtin_amdgcn_s_setprio(1); _Pragma("unroll") for (int m = 0; m < 4; ++m) _Pragma("unroll") for (int n = 0; n < 2; ++n) \
        asm volatile("v_mfma_f32_16x16x128_f8f6f4 %0, %1, %2, %0" : "+v"(acc[ai][bj][m][n]) : "v"(Bt[n]), "v"(At[m])); __builtin_amdgcn_s_setprio(0); } while (0)
#define PG8_WAIT_V(n) asm volatile("s_waitcnt vmcnt(" #n ")" ::: "memory")
#define PG8_WAIT_L(n) asm volatile("s_waitcnt lgkmcnt(" #n ")" ::: "memory")
#define PG8_BAR __builtin_amdgcn_s_barrier()
#define PG8_SCHED __builtin_amdgcn_sched_barrier(0)
    f32x4 acc[2][2][4][2];
#pragma unroll
    for (int a = 0; a < 2; ++a)
#pragma unroll
        for (int b = 0; b < 2; ++b)
#pragma unroll
            for (int m = 0; m < 4; ++m)
#pragma unroll
                for (int n = 0; n < 2; ++n) acc[a][b][m][n] = (f32x4){0.f, 0.f, 0.f, 0.f};
    bf16x8 At[4][2], B0[2][2], B1[2][2]; i32x8 At8[4], B08[2], B18[2];
    const char* cA = (const char*)g.A + (GATHER ? (size_t)0 : (size_t)cur.pm * tstep); const char* cB = (const char*)g.Bt + (size_t)cur.pn * tstep;
    if (GATHER) PG8_WAIT_V(0);
    PG8_STAGE(PG8_SB(0, 0), cB, voffB); PG8_STAGE_A(PG8_SA(0, 0), cA, 0); PG8_STAGE(PG8_SB(0, 1), cB + hstep, voffB); PG8_STAGE_A(PG8_SA(0, 1), cA, 1);
    if (wr == 1) PG8_BAR;
    PG8_WAIT_V(4); PG8_BAR;
    PG8_STAGE(PG8_SB(1, 0), cB + kstep, voffB); PG8_STAGE_A(PG8_SA(1, 0), cA + kstep, 0); PG8_STAGE(PG8_SB(1, 1), cB + hstep + kstep, voffB);
    PG8_WAIT_V(6); PG8_BAR;
    for (;;) {
        const bool has_next = S.next(ui + 1, nxt);
        const char* nA = has_next ? (const char*)g.A + (GATHER ? (size_t)0 : (size_t)nxt.pm * tstep) : cA; const char* nB = has_next ? (const char*)g.Bt + (size_t)nxt.pn * tstep : cB;
        for (int t = 0; t < nt; t += 2) {
            const bool last = (t == nt - 2);
            const char* a1 = cA + (size_t)(t + 1) * kstep;
            const char* a2 = last ? nA : cA + (size_t)(t + 2) * kstep; const char* b2 = last ? nB : cB + (size_t)(t + 2) * kstep;
            const char* a3 = a2 + kstep; const char* b3 = b2 + kstep;
            if constexpr (FP8) {
            PG8_LDB8(B08, 0, 0); PG8_SCHED; PG8_LDA8(At8, 0, 0); PG8_STAGE_A(PG8_SA(1, 1), a1, 1);
            PG8_WAIT_L(8); PG8_BAR; PG8_WAIT_L(0); PG8_MMA8(0, 0, At8, B08); PG8_BAR; PG8_SCHED;
            PG8_LDB8(B18, 0, 1); PG8_STAGE(PG8_SB(0, 0), b2, voffB);
            PG8_BAR; PG8_WAIT_L(0); PG8_MMA8(0, 1, At8, B18); PG8_BAR;
            PG8_LDA8(At8, 0, 1); PG8_STAGE_A(PG8_SA(0, 0), a2, 0);
            PG8_BAR; PG8_WAIT_L(0); PG8_MMA8(1, 0, At8, B08); PG8_BAR; PG8_SCHED;
            PG8_STAGE(PG8_SB(0, 1), b2 + hstep, voffB);
            PG8_WAIT_V(6); PG8_BAR; PG8_MMA8(1, 1, At8, B18); PG8_BAR;
            PG8_LDB8(B08, 1, 0); PG8_SCHED; PG8_LDA8(At8, 1, 0); PG8_STAGE_A(PG8_SA(0, 1), a2, 1);
            PG8_WAIT_L(8); PG8_BAR; PG8_WAIT_L(0); PG8_MMA8(0, 0, At8, B08); PG8_BAR; PG8_SCHED;
            PG8_LDB8(B18, 1, 1); PG8_STAGE(PG8_SB(1, 0), b3, voffB);
            PG8_BAR; PG8_WAIT_L(0); PG8_MMA8(0, 1, At8, B18); PG8_BAR;
            PG8_LDA8(At8, 1, 1); PG8_STAGE_A(PG8_SA(1, 0), a3, 0);
            PG8_BAR; PG8_WAIT_L(0); PG8_MMA8(1, 0, At8, B08); PG8_BAR; PG8_SCHED;
            PG8_STAGE(PG8_SB(1, 1), b3 + hstep, voffB);
            PG8_WAIT_V(6); PG8_BAR; PG8_MMA8(1, 1, At8, B18); PG8_BAR;
            } else {
            PG8_LDB(B0, 0, 0); PG8_SCHED; PG8_LDA(At, 0, 0); PG8_STAGE_A(PG8_SA(1, 1), a1, 1);
            PG8_WAIT_L(8); PG8_BAR; PG8_WAIT_L(0); PG8_MMA(0, 0, At, B0); PG8_BAR; PG8_SCHED;
            PG8_LDB(B1, 0, 1); PG8_STAGE(PG8_SB(0, 0), b2, voffB);
            PG8_BAR; PG8_WAIT_L(0); PG8_MMA(0, 1, At, B1); PG8_BAR;
            PG8_LDA(At, 0, 1); PG8_STAGE_A(PG8_SA(0, 0), a2, 0);
            PG8_BAR; PG8_WAIT_L(0); PG8_MMA(1, 0, At, B0); PG8_BAR; PG8_SCHED;
            PG8_STAGE(PG8_SB(0, 1), b2 + hstep, voffB);
            PG8_WAIT_V(6); PG8_BAR; PG8_MMA(1, 1, At, B1); PG8_BAR;
            PG8_LDB(B0, 1, 0); PG8_SCHED; PG8_LDA(At, 1, 0); PG8_STAGE_A(PG8_SA(0, 1), a2, 1);
            PG8_WAIT_L(8); PG8_BAR; PG8_WAIT_L(0); PG8_MMA(0, 0, At, B0); PG8_BAR; PG8_SCHED;
            PG8_LDB(B1, 1, 1); PG8_STAGE(PG8_SB(1, 0), b3, voffB);
            PG8_BAR; PG8_WAIT_L(0); PG8_MMA(0, 1, At, B1); PG8_BAR;
            PG8_LDA(At, 1, 1); PG8_STAGE_A(PG8_SA(1, 0), a3, 0);
            PG8_BAR; PG8_WAIT_L(0); PG8_MMA(1, 0, At, B0); PG8_BAR; PG8_SCHED;
            PG8_STAGE(PG8_SB(1, 1), b3 + hstep, voffB);
            PG8_WAIT_V(6); PG8_BAR; PG8_MMA(1, 1, At, B1); PG8_BAR;
            }
        }
        if constexpr (FP8) asm volatile("s_nop 15\n\ts_nop 15\n\ts_nop 15\n\ts_nop 15" ::: "memory");
        E(acc, cur, wr, wc, fr, fq);
        if (!has_next) break;
#pragma unroll
        for (int a = 0; a < 2; ++a)
#pragma unroll
            for (int b = 0; b < 2; ++b)
#pragma unroll
                for (int m = 0; m < 4; ++m)
#pragma unroll
                    for (int n = 0; n < 2; ++n) acc[a][b][m][n] = (f32x4){0.f, 0.f, 0.f, 0.f};
        cur = nxt; cA = nA; cB = nB; ++ui;
    }
    PG8_WAIT_V(0);
    if (wr == 0) PG8_BAR;
    PG8_BAR;
#undef PG8_SA
#undef PG8_SB
#undef PG8_STAGE
#undef PG8_STAGE_A
#undef PG8_LDA
#undef PG8_LDB
#undef PG8_MMA
#undef PG8_MMA8
#undef PG8_LDA8
#undef PG8_LDB8
#undef PG8_WAIT_V
#undef PG8_WAIT_L
#undef PG8_BAR
#undef PG8_SCHED
}
}
using pg8::Unit;
typedef f32x4 AccT[2][2][4][2];

typedef float f32x16 __attribute__((ext_vector_type(16)));
#ifndef K256_DIST
#define K256_DIST 2
#endif
constexpr int K256_BUF = 32768, K256_NB = 3, K256_SCR_OFF = K256_NB * K256_BUF, K256_SCR_WAVE = 4608;
struct K256Store {
    bf16_t* O; int ld; const float* rs; float rs_mul; bf16_t* O2; int split; int fp8;
};
constexpr float F8_SCALE = 16.0f;
__device__ __forceinline__ void gemm_k256(LAS unsigned char* lds, const bf16_t* A, const bf16_t* Bt, int nchunks, int row0, const K256Store& E) {
    int tid_ = threadIdx.x; asm volatile("; k256 ids" : "+v"(tid_));
    const int tid = tid_, lane = tid & 63, wave = __builtin_amdgcn_readfirstlane(tid >> 6), r = lane & 31, h = lane >> 5;
    bf16x8 af[16];
    { const bf16_t* arow = A + (size_t)(32 * wave + r) * 256 + 8 * h;
#pragma unroll
      for (int s = 0; s < 16; ++s) af[s] = *(const bf16x8*)(arow + 16 * s); }
    float rscale = 1.0f;
    if (E.rs) rscale = rsqrtf(E.rs[row0 + 32 * wave + r] * E.rs_mul + RMS_EPS);
    unsigned foff[4];
#pragma unroll
    for (int q = 0; q < 4; ++q) { const int n = 2 * (4 * wave + q) + (lane >> 5); foff[q] = (unsigned)(n * 256 + (((lane & 31) ^ (n & 15)) << 3)) * 2u; }
#define K256_FILL(chunk, buf) do { const char* _src = (const char*)Bt + (size_t)(chunk) * (64 * 256 * 2); _Pragma("unroll") for (int q = 0; q < 4; ++q) \
        __builtin_amdgcn_global_load_lds((const unsigned*)(_src + foff[q]), (LAS unsigned*)(lds + (buf) * K256_BUF + (4 * wave + q) * 1024), 16, 0, 0); } while (0)
    K256_FILL(0, 0);
    if (K256_DIST == 2 && nchunks > 1) K256_FILL(1, 1);
    const int boff = (r * 32) * 16;
    LAS unsigned char* scr = lds + K256_SCR_OFF + wave * K256_SCR_WAVE;
    for (int i = 0; i < nchunks; ++i) {
        {
            const int ns = E.fp8 ? 2 : 4;
            const int yo = K256_DIST == 2 ? ns * ((i >= 2 ? 1 : 0) + (i >= 1 ? 1 : 0)) + (i + 1 < nchunks ? 4 : 0) : ns * (i >= 1 ? 1 : 0);
            if (yo >= 12) asm volatile("s_waitcnt vmcnt(12)" ::: "memory"); else if (yo >= 8) asm volatile("s_waitcnt vmcnt(8)" ::: "memory");
            else if (yo >= 6) asm volatile("s_waitcnt vmcnt(6)" ::: "memory"); else if (yo >= 4) asm volatile("s_waitcnt vmcnt(4)" ::: "memory");
            else if (yo >= 2) asm volatile("s_waitcnt vmcnt(2)" ::: "memory"); else asm volatile("s_waitcnt vmcnt(0)" ::: "memory");
        }
        __builtin_amdgcn_s_barrier(); asm volatile("" ::: "memory");
        if (i + K256_DIST < nchunks) K256_FILL(i + K256_DIST, (i + K256_DIST) % K256_NB);
        const LAS unsigned char* bb = lds + (i % K256_NB) * K256_BUF + boff;
        f32x16 acc0, acc1;
#pragma unroll
        for (int j = 0; j < 16; ++j) { acc0[j] = 0.f; acc1[j] = 0.f; }
        {
            bf16x8 bq[3][2];
#define K256_LDB(s_) do { const int co_ = (((2 * (s_) + h) ^ (r & 15)) << 4); bq[(s_) % 3][0] = *(const LAS bf16x8*)(bb + co_); bq[(s_) % 3][1] = *(const LAS bf16x8*)(bb + 32 * 512 + co_); } while (0)
            K256_LDB(0); K256_LDB(1);
#pragma unroll
            for (int s = 0; s < 16; ++s) {
                if (s + 2 < 16) K256_LDB(s + 2);
                acc0 = __builtin_amdgcn_mfma_f32_32x32x16_bf16(bq[s % 3][0], af[s], acc0, 0, 0, 0);
                acc1 = __builtin_amdgcn_mfma_f32_32x32x16_bf16(bq[s % 3][1], af[s], acc1, 0, 0, 0);
            }
            __builtin_amdgcn_sched_group_barrier(0x100, 4, 0);
#pragma unroll
            for (int s = 0; s < 16; ++s) { if (s + 2 < 16) __builtin_amdgcn_sched_group_barrier(0x100, 2, 0); __builtin_amdgcn_sched_group_barrier(0x008, 2, 0); }
#undef K256_LDB
        }
        if (E.fp8) {
#pragma unroll
            for (int g = 0; g < 4; ++g) {
                unsigned d0 = 0u, d1 = 0u;
                d0 = __builtin_amdgcn_cvt_pk_fp8_f32(acc0[4 * g] * F8_SCALE, acc0[4 * g + 1] * F8_SCALE, d0, false); d0 = __builtin_amdgcn_cvt_pk_fp8_f32(acc0[4 * g + 2] * F8_SCALE, acc0[4 * g + 3] * F8_SCALE, d0, true);
                d1 = __builtin_amdgcn_cvt_pk_fp8_f32(acc1[4 * g] * F8_SCALE, acc1[4 * g + 1] * F8_SCALE, d1, false); d1 = __builtin_amdgcn_cvt_pk_fp8_f32(acc1[4 * g + 2] * F8_SCALE, acc1[4 * g + 3] * F8_SCALE, d1, true);
                *(LAS unsigned*)(scr + r * 80 + 8 * g + 4 * h) = d0; *(LAS unsigned*)(scr + r * 80 + 32 + 8 * g + 4 * h) = d1;
            }
            asm volatile("s_waitcnt lgkmcnt(0)" ::: "memory");
            unsigned char* ob8 = (unsigned char*)E.O;
#pragma unroll
            for (int pq = 0; pq < 2; ++pq) { const int rr = (lane >> 2) + 16 * pq;
                const u32x4 v = *(const LAS u32x4*)(scr + rr * 80 + (lane & 3) * 16);
                __builtin_nontemporal_store(v, (u32x4*)(ob8 + (size_t)(row0 + 32 * wave + rr) * E.ld + i * 64 + (lane & 3) * 16)); }
        } else {
#pragma unroll
        for (int g = 0; g < 4; ++g) {
            u32x2 w0, w1;
            w0.x = pk2(acc0[4 * g] * rscale, acc0[4 * g + 1] * rscale); w0.y = pk2(acc0[4 * g + 2] * rscale, acc0[4 * g + 3] * rscale);
            w1.x = pk2(acc1[4 * g] * rscale, acc1[4 * g + 1] * rscale); w1.y = pk2(acc1[4 * g + 2] * rscale, acc1[4 * g + 3] * rscale);
            *(LAS u32x2*)(scr + r * 144 + (8 * g + 4 * h) * 2) = w0; *(LAS u32x2*)(scr + r * 144 + 64 + (8 * g + 4 * h) * 2) = w1;
        }
        asm volatile("s_waitcnt lgkmcnt(0)" ::: "memory");
        int col = i * 64 + (lane & 7) * 8; bf16_t* ob = E.O;
        if (E.O2 && col >= E.split) { col -= E.split; ob = E.O2; }
#pragma unroll
        for (int pq = 0; pq < 4; ++pq) { const int rr = (lane >> 3) + 8 * pq;
            const u32x4 v = *(const LAS u32x4*)(scr + rr * 144 + (lane & 7) * 16);
            *(u32x4*)(ob + (size_t)(row0 + 32 * wave + rr) * E.ld + col) = v; }
        }
    }
#undef K256_FILL
    asm volatile("s_waitcnt vmcnt(0) lgkmcnt(0)" ::: "memory");
    __builtin_amdgcn_s_barrier(); asm volatile("" ::: "memory");
}


typedef int i32x8k __attribute__((ext_vector_type(8)));
constexpr int K8_BUF = 32768, K8_SCR_OFF = 3 * K8_BUF;
__device__ __forceinline__ void gemm_k256_f8(LAS unsigned char* lds, const unsigned char* A8, const unsigned char* Bt8, int nchunks  , int row0, unsigned char* O8, int ld, float oscale, const K256Store* Eb = nullptr) {
    int tid_ = threadIdx.x; asm volatile("; k256f8 ids" : "+v"(tid_));
    const int tid = tid_, lane = tid & 63, wave = __builtin_amdgcn_readfirstlane(tid >> 6), r = lane & 31, h = lane >> 5;
    i32x8k af[4];
    { const unsigned char* arow = A8 + (size_t)(32 * wave + r) * 256 + 32 * h;
#pragma unroll
      for (int s = 0; s < 4; ++s) { const u32x4 x0 = *(const u32x4*)(arow + 64 * s), x1 = *(const u32x4*)(arow + 64 * s + 16); af[s] = __builtin_bit_cast(i32x8k, __builtin_shufflevector(x0, x1, 0, 1, 2, 3, 4, 5, 6, 7)); } }
    unsigned foff[4];
#pragma unroll
    for (int q = 0; q < 4; ++q) { const int n = 4 * (4 * wave + q) + (lane >> 4); foff[q] = (unsigned)(n * 256 + (((lane & 15) ^ (n & 15)) << 4)); }
#define K8_FILL(chunk, buf) do { const unsigned char* _src = Bt8 + (size_t)(chunk) * (128 * 256); _Pragma("unroll") for (int q = 0; q < 4; ++q) \
        __builtin_amdgcn_global_load_lds((const unsigned*)(_src + foff[q]), (LAS unsigned*)(lds + (buf) * K8_BUF + (4 * wave + q) * 1024), 16, 0, 0); } while (0)
    K8_FILL(0, 0);
    if (nchunks > 1) K8_FILL(1, 1);
    LAS unsigned char* scr = lds + K8_SCR_OFF + wave * 4608;
    const float osc = F8_SCALE * oscale;
    float rscale = oscale;
    if (Eb && Eb->rs) rscale = rsqrtf(Eb->rs[row0 + 32 * wave + r] * Eb->rs_mul + RMS_EPS) * oscale;
    for (int i = 0; i < nchunks; ++i) {
        {
            const int ns = Eb ? 8 : 4;
            const int yo = ns * ((i >= 2 ? 1 : 0) + (i >= 1 ? 1 : 0)) + (i + 1 < nchunks ? 4 : 0);
            if (yo >= 20) asm volatile("s_waitcnt vmcnt(20)" ::: "memory"); else if (yo >= 16) asm volatile("s_waitcnt vmcnt(16)" ::: "memory");
            else if (yo >= 12) asm volatile("s_waitcnt vmcnt(12)" ::: "memory"); else if (yo >= 8) asm volatile("s_waitcnt vmcnt(8)" ::: "memory");
            else if (yo >= 4) asm volatile("s_waitcnt vmcnt(4)" ::: "memory"); else asm volatile("s_waitcnt vmcnt(0)" ::: "memory");
        }
        __builtin_amdgcn_s_barrier(); asm volatile("" ::: "memory");
        if (i + 2 < nchunks) K8_FILL(i + 2, (i + 2) % 3);
        const LAS unsigned char* bb = lds + (i % 3) * K8_BUF + r * 256;
        f32x16 acc[4];
#pragma unroll
        for (int nt = 0; nt < 4; ++nt)
#pragma unroll
            for (int j = 0; j < 16; ++j) acc[nt][j] = 0.f;
        i32x8k bq[2][4];
#define K8_LDB(s_) do { const int c0_ = ((4 * (s_) + 2 * h) ^ (r & 15)) << 4, c1_ = ((4 * (s_) + 2 * h + 1) ^ (r & 15)) << 4; _Pragma("unroll") for (int nt = 0; nt < 4; ++nt) { \
            const u32x4 p0_ = *(const LAS u32x4*)(bb + nt * 32 * 256 + c0_), p1_ = *(const LAS u32x4*)(bb + nt * 32 * 256 + c1_); \
            bq[(s_) & 1][nt] = __builtin_bit_cast(i32x8k, __builtin_shufflevector(p0_, p1_, 0, 1, 2, 3, 4, 5, 6, 7)); } } while (0)
        K8_LDB(0);
#pragma unroll
        for (int s = 0; s < 4; ++s) {
            if (s + 1 < 4) K8_LDB(s + 1);
#pragma unroll
            for (int nt = 0; nt < 4; ++nt) acc[nt] = __builtin_amdgcn_mfma_scale_f32_32x32x64_f8f6f4(bq[s & 1][nt], af[s], acc[nt], 0, 0, 0, 0, 0, 0);
        }
#undef K8_LDB
        if (Eb) {
#pragma unroll
            for (int hf = 0; hf < 2; ++hf) {
#pragma unroll
                for (int n2 = 0; n2 < 2; ++n2)
#pragma unroll
                    for (int g = 0; g < 4; ++g) { const int nt = 2 * hf + n2; u32x2 w;
                        w.x = pk2(acc[nt][4 * g] * rscale, acc[nt][4 * g + 1] * rscale); w.y = pk2(acc[nt][4 * g + 2] * rscale, acc[nt][4 * g + 3] * rscale);
                        *(LAS u32x2*)(scr + r * 144 + 64 * n2 + (8 * g + 4 * h) * 2) = w; }
                asm volatile("s_waitcnt lgkmcnt(0)" ::: "memory");
                int col = i * 128 + 64 * hf + (lane & 7) * 8; bf16_t* ob = Eb->O;
                if (Eb->O2 && col >= Eb->split) { col -= Eb->split; ob = Eb->O2; }
#pragma unroll
                for (int pq = 0; pq < 4; ++pq) { const int rr = (lane >> 3) + 8 * pq;
                    const u32x4 v = *(const LAS u32x4*)(scr + rr * 144 + (lane & 7) * 16);
                    *(u32x4*)(ob + (size_t)(row0 + 32 * wave + rr) * Eb->ld + col) = v; }
            }
            continue;
        }
#pragma unroll
        for (int nt = 0; nt < 4; ++nt)
#pragma unroll
            for (int g = 0; g < 4; ++g) {
                unsigned d0 = 0u;
                d0 = __builtin_amdgcn_cvt_pk_fp8_f32(acc[nt][4 * g] * osc, acc[nt][4 * g + 1] * osc, d0, false); d0 = __builtin_amdgcn_cvt_pk_fp8_f32(acc[nt][4 * g + 2] * osc, acc[nt][4 * g + 3] * osc, d0, true);
                *(LAS unsigned*)(scr + r * 144 + 32 * nt + 8 * g + 4 * h) = d0;
            }
        asm volatile("s_waitcnt lgkmcnt(0)" ::: "memory");
#pragma unroll
        for (int pq = 0; pq < 4; ++pq) { const int rr = (lane >> 3) + 8 * pq;
            const u32x4 v = *(const LAS u32x4*)(scr + rr * 144 + (lane & 7) * 16);
            __builtin_nontemporal_store(v, (u32x4*)(O8 + (size_t)(row0 + 32 * wave + rr) * ld + i * 128 + (lane & 7) * 16)); }
    }
#undef K8_FILL
    asm volatile("s_waitcnt vmcnt(0) lgkmcnt(0)" ::: "memory");
    __builtin_amdgcn_s_barrier(); asm volatile("" ::: "memory");
}

__device__ __forceinline__ u32x4 pack8(const f32x4 a, const f32x4 b) { u32x4 w; w.x = pk2(a[0], a[1]); w.y = pk2(a[2], a[3]); w.z = pk2(b[0], b[1]); w.w = pk2(b[2], b[3]); return w; }
__device__ __forceinline__ void unpack8(const u32x4 w, f32x4& a, f32x4& b) { a = (f32x4){bflo(w.x), bfhi(w.x), bflo(w.y), bfhi(w.y)}; b = (f32x4){bflo(w.z), bfhi(w.z), bflo(w.w), bfhi(w.w)}; }

struct EpiWin {
    static constexpr bool PERM = true;
    bf16_t *q, *k, *v, *gr, *cq, *ckv, *sa, *sb, *kr; float* ga; const float* rope; int f8; float ascale;
    __device__ __forceinline__ void operator()(const AccT& acc, const Unit& u, int wr, int wc, int fr, int fq) const {
        const int pn = f8 ? (u.pn < 12 ? u.pn : u.pn < 20 ? 4 + u.pn : u.pn < 24 ? u.pn - 8 : 24) : u.pn, row0 = u.pm * 256 + wr * 64 + fr, lc0 = wc * 32 + 8 * fq;
        if (pn < 24) {
            bf16_t* dst; int ld, cb, mode = 0;
            if (pn < 2) { dst = q; ld = 512; cb = pn * 256; mode = 1; }
            else if (pn < 4) { dst = k; ld = 512; cb = (pn - 2) * 256; }
            else if (pn < 8) { dst = v; ld = 1024; cb = (pn - 4) * 256; }
            else if (pn < 12) { dst = gr; ld = 1024; cb = (pn - 8) * 256; mode = 2; }
            else if (pn < 15) { dst = cq; ld = 768; cb = (pn - 12) * 256; mode = 4; }
            else if (pn < 16) { dst = ckv; ld = 256; cb = 0; mode = 4; }
            else if (pn < 20) { dst = sa; ld = 512; cb = (pn - 16) * 128; mode = 3; }
            else { dst = sb; ld = 512; cb = (pn - 20) * 128; mode = 3; }
#pragma unroll
            for (int ai = 0; ai < 2; ++ai)
#pragma unroll
                for (int m = 0; m < 4; ++m) {
                    const int row = row0 + ai * 128 + m * 16;
#pragma unroll
                    for (int bj = 0; bj < 2; ++bj) {
                        f32x4 v0 = acc[ai][bj][m][0] * ascale, v1 = acc[ai][bj][m][1] * ascale;
                        if (mode == 1) { v0 *= 0.08838834764831845f; v1 *= 0.08838834764831845f; }
                        else if (mode == 2) {
#pragma unroll
                            for (int j = 0; j < 4; ++j) { v0[j] = silu(v0[j]); v1[j] = silu(v1[j]); } }
                        else if (mode == 3) {
#pragma unroll
                            for (int j = 0; j < 4; ++j) { v0[j] = sigm(v0[j]); v1[j] = sigm(v1[j]); } }
                        if (mode == 3) {
                            unsigned d0 = 0u, d1 = 0u;
#pragma unroll
                            for (int j = 0; j < 4; ++j) { d0 = __builtin_amdgcn_cvt_pk_u8_f32(v0[j] * 255.0f, j, d0); d1 = __builtin_amdgcn_cvt_pk_u8_f32(v1[j] * 255.0f, j, d1); }
                            *(u32x2*)((unsigned char*)dst + (size_t)row * 1024 + (size_t)cb * 2 + bj * 128 + lc0) = (u32x2){d0, d1};
                        } else if (mode == 4) {
                            unsigned d0 = 0u, d1 = 0u;
                            d0 = __builtin_amdgcn_cvt_pk_fp8_f32(v0[0], v0[1], d0, false); d0 = __builtin_amdgcn_cvt_pk_fp8_f32(v0[2], v0[3], d0, true);
                            d1 = __builtin_amdgcn_cvt_pk_fp8_f32(v1[0], v1[1], d1, false); d1 = __builtin_amdgcn_cvt_pk_fp8_f32(v1[2], v1[3], d1, true);
                            *(u32x2*)((unsigned char*)dst + (size_t)row * ld + cb + bj * 128 + lc0) = (u32x2){d0, d1};
                        } else
                        *(u32x4*)(dst + (size_t)row * ld + cb + bj * 128 + lc0) = pack8(v0, v1);
                    }
                }
        } else {
#pragma unroll
            for (int ai = 0; ai < 2; ++ai)
#pragma unroll
                for (int m = 0; m < 4; ++m) {
                    const int row = row0 + ai * 128 + m * 16;
#pragma unroll
                    for (int bj = 0; bj < 2; ++bj) {
                        const int col = bj * 128 + lc0; const f32x4 v0 = acc[ai][bj][m][0] * ascale, v1 = acc[ai][bj][m][1] * ascale;
                        if (col < 64) {
                            const int j = col >> 3;
                            const f32x4 cs = *(const f32x4*)(rope + (size_t)row * 64 + 4 * j), sn = *(const f32x4*)(rope + (size_t)row * 64 + 32 + 4 * j);
                            const f32x4 o1 = v0 * cs - v1 * sn, o2 = v1 * cs + v0 * sn;
                            u32x2 w1, w2; w1.x = pk2(o1[0], o1[1]); w1.y = pk2(o1[2], o1[3]); w2.x = pk2(o2[0], o2[1]); w2.y = pk2(o2[2], o2[3]);
                            *(u32x2*)(kr + (size_t)row * 64 + 4 * j) = w1; *(u32x2*)(kr + (size_t)row * 64 + 32 + 4 * j) = w2;
                        } else if (col < 80) {
                            *(f32x4*)(ga + (size_t)row * 16 + (col - 64)) = v0; *(f32x4*)(ga + (size_t)row * 16 + (col - 64) + 4) = v1;
                        }
                    }
                }
        }
    }
};
struct EpiQF {
    static constexpr bool PERM = true;
    bf16_t* qm; const float* cq_ss; const float* rope;
    __device__ __forceinline__ void operator()(const AccT& acc, const Unit& u, int wr, int wc, int fr, int fq) const {
        const int row0 = u.pm * 256 + wr * 64 + fr, lc0 = wc * 32 + 8 * fq;
        int colb[2], headb[2], jb[2]; bool ropeb[2];
#pragma unroll
        for (int bj = 0; bj < 2; ++bj) { colb[bj] = u.pn * 256 + bj * 128 + lc0; headb[bj] = colb[bj] / 192; const int within = colb[bj] - headb[bj] * 192; ropeb[bj] = within >= 128; jb[bj] = ropeb[bj] ? (within - 128) >> 3 : 0; }
#pragma unroll
        for (int ai = 0; ai < 2; ++ai) {
            float rsv[4]; f32x4 cs[4][2], sn[4][2];
#pragma unroll
            for (int m = 0; m < 4; ++m) { const int row = row0 + ai * 128 + m * 16; rsv[m] = cq_ss[row];
#pragma unroll
                for (int bj = 0; bj < 2; ++bj) if (ropeb[bj]) { cs[m][bj] = *(const f32x4*)(rope + (size_t)row * 64 + 4 * jb[bj]); sn[m][bj] = *(const f32x4*)(rope + (size_t)row * 64 + 32 + 4 * jb[bj]); } }
#pragma unroll
            for (int m = 0; m < 4; ++m) {
                const int row = row0 + ai * 128 + m * 16;
                const float rs = rsqrtf(rsv[m] * (1.0f / 768.0f) + RMS_EPS) * (QSCALE * (1.0f / 32.0f));
#pragma unroll
                for (int bj = 0; bj < 2; ++bj) {
                    const f32x4 v0 = acc[ai][bj][m][0] * rs, v1 = acc[ai][bj][m][1] * rs;
                    if (!ropeb[bj]) *(u32x4*)(qm + (size_t)row * 1536 + colb[bj]) = pack8(v0, v1);
                    else {
                        const f32x4 o1 = v0 * cs[m][bj] - v1 * sn[m][bj], o2 = v1 * cs[m][bj] + v0 * sn[m][bj];
                        u32x2 w1, w2; w1.x = pk2(o1[0], o1[1]); w1.y = pk2(o1[2], o1[3]); w2.x = pk2(o2[0], o2[1]); w2.y = pk2(o2[2], o2[3]);
                        bf16_t* p = qm + (size_t)row * 1536 + headb[bj] * 192 + 128 + 4 * jb[bj];
                        *(u32x2*)p = w1; *(u32x2*)(p + 32) = w2;
                    }
                }
            }
        }
    }
};
struct EpiKV {
    static constexpr bool PERM = true;
    bf16_t *kn, *vm; const float* ckv_ss;
    __device__ __forceinline__ void operator()(const AccT& acc, const Unit& u, int wr, int wc, int fr, int fq) const {
        const int row0 = u.pm * 256 + wr * 64 + fr, lc0 = wc * 32 + 8 * fq;
        bf16_t* dst = u.pn < 4 ? kn : vm; const int cb = (u.pn & 3) * 256;
#pragma unroll
        for (int ai = 0; ai < 2; ++ai)
#pragma unroll
            for (int m = 0; m < 4; ++m) {
                const int row = row0 + ai * 128 + m * 16;
                const float rs = rsqrtf(ckv_ss[row] * (1.0f / 256.0f) + RMS_EPS);
#pragma unroll
                for (int bj = 0; bj < 2; ++bj)
                    *(u32x4*)(dst + (size_t)row * 1024 + cb + bj * 128 + lc0) = pack8(acc[ai][bj][m][0] * rs, acc[ai][bj][m][1] * rs);
            }
    }
};
template <bool ADD> struct EpiGate {
    static constexpr bool PERM = true;
    bf16_t* Y; const unsigned char* gate; unsigned char* Y8; float ascale;
    __device__ __forceinline__ void operator()(const AccT& acc, const Unit& u, int wr, int wc, int fr, int fq) const {
        const int row0 = u.pm * 256 + wr * 64 + fr, lc0 = u.pn * 256 + wc * 32 + 8 * fq;
#pragma unroll
        for (int ai = 0; ai < 2; ++ai) {
            u32x2 gq[4][2]; u32x4 yq[4][2];
#pragma unroll
            for (int m = 0; m < 4; ++m)
#pragma unroll
                for (int bj = 0; bj < 2; ++bj) { const size_t o = (size_t)(row0 + ai * 128 + m * 16) * 1024 + lc0 + bj * 128; gq[m][bj] = *(const u32x2*)(gate + o); if (ADD) yq[m][bj] = *(const u32x4*)(Y + o); }
#pragma unroll
            for (int m = 0; m < 4; ++m)
#pragma unroll
                for (int bj = 0; bj < 2; ++bj) {
                    const size_t o = (size_t)(row0 + ai * 128 + m * 16) * 1024 + lc0 + bj * 128;
                    const unsigned ga_ = gq[m][bj].x, gb_ = gq[m][bj].y; const float k255 = 1.0f / 255.0f;
                    const f32x4 g0 = (f32x4){(float)(ga_ & 255u), (float)((ga_ >> 8) & 255u), (float)((ga_ >> 16) & 255u), (float)(ga_ >> 24)} * k255;
                    const f32x4 g1 = (f32x4){(float)(gb_ & 255u), (float)((gb_ >> 8) & 255u), (float)((gb_ >> 16) & 255u), (float)(gb_ >> 24)} * k255;
                    f32x4 v0 = acc[ai][bj][m][0] * (g0 * ascale), v1 = acc[ai][bj][m][1] * (g1 * ascale);
                    if (ADD) { f32x4 y0, y1; unpack8(yq[m][bj], y0, y1); v0 += y0; v1 += y1;
                        unsigned q0 = 0u, q1 = 0u; q0 = __builtin_amdgcn_cvt_pk_fp8_f32(v0[0], v0[1], q0, false); q0 = __builtin_amdgcn_cvt_pk_fp8_f32(v0[2], v0[3], q0, true); q1 = __builtin_amdgcn_cvt_pk_fp8_f32(v1[0], v1[1], q1, false); q1 = __builtin_amdgcn_cvt_pk_fp8_f32(v1[2], v1[3], q1, true);
                        *(u32x2*)(Y8 + o) = (u32x2){q0, q1}; }
                    else *(u32x4*)(Y + o) = pack8(v0, v1);
                }
        }
    }
};
struct EpiZ {
    static constexpr bool PERM = false;
    float* z; const float* x; const float* mod;
    __device__ __forceinline__ void operator()(const AccT& acc, const Unit& u, int wr, int wc, int fr, int fq) const {
        const int row0 = u.pm * 256 + wr * 64 + fr, col0 = u.pn * 256 + wc * 32 + 4 * fq;
        const float* g = mod + (size_t)(u.pm >> 3) * 6144 + 2048;
        f32x4 gv[2][2];
#pragma unroll
        for (int bj = 0; bj < 2; ++bj)
#pragma unroll
            for (int n = 0; n < 2; ++n) gv[bj][n] = *(const f32x4*)(g + col0 + bj * 128 + n * 16) + 1.0f;
#pragma unroll
        for (int ai = 0; ai < 2; ++ai)
#pragma unroll
            for (int m = 0; m < 4; ++m) {
                const size_t ro = (size_t)(row0 + ai * 128 + m * 16) * 1024 + col0;
#pragma unroll
                for (int bj = 0; bj < 2; ++bj)
#pragma unroll
                    for (int n = 0; n < 2; ++n) { const size_t o = ro + bj * 128 + n * 16; *(f32x4*)(z + o) = *(const f32x4*)(x + o) * ALPHA + gv[bj][n] * acc[ai][bj][m][n]; }
            }
    }
};
struct EpiF32 {
    static constexpr bool PERM = false;
    float* C; int ldc;
    __device__ __forceinline__ void operator()(const AccT& acc, const Unit& u, int wr, int wc, int fr, int fq) const {
        const int row0 = u.pm * 256 + wr * 64 + fr, col0 = u.pn * 256 + wc * 32 + 4 * fq;
#pragma unroll
        for (int ai = 0; ai < 2; ++ai)
#pragma unroll
            for (int m = 0; m < 4; ++m) { float* rowp = C + (size_t)(row0 + ai * 128 + m * 16) * ldc + col0;
#pragma unroll
                for (int bj = 0; bj < 2; ++bj)
#pragma unroll
                    for (int n = 0; n < 2; ++n) *(f32x4*)(rowp + bj * 128 + n * 16) = acc[ai][bj][m][n]; }
    }
};
struct EpiGLU {
    static constexpr bool PERM = true;
    bf16_t* hid; float scale; int f8;
    __device__ __forceinline__ void operator()(const AccT& acc, const Unit& u, int wr, int wc, int fr, int fq) const {
        const int row0 = u.pm * 256 + wr * 64 + fr, lc0 = u.pn * 256 + wc * 32 + 8 * fq;
#pragma unroll
        for (int ai = 0; ai < 2; ++ai)
#pragma unroll
            for (int m = 0; m < 4; ++m) {
                const int row = row0 + ai * 128 + m * 16;
                unsigned d8[2] = {0u, 0u};
#pragma unroll
                for (int bj = 0; bj < 2; ++bj) {
                    const f32x4 gg = acc[ai][bj][m][0] * scale, uu = acc[ai][bj][m][1] * scale;
                    const float h0 = silu(gg[0]) * uu[0], h1 = silu(gg[1]) * uu[1], h2_ = silu(gg[2]) * uu[2], h3 = silu(gg[3]) * uu[3];
                    if (f8) { unsigned d = 0u; d = __builtin_amdgcn_cvt_pk_fp8_f32(h0, h1, d, false); d = __builtin_amdgcn_cvt_pk_fp8_f32(h2_, h3, d, true); d8[bj] = d; }
                    else { u32x2 w; w.x = pk2(h0, h1); w.y = pk2(h2_, h3); *(u32x2*)(hid + (size_t)row * 256 + ((lc0 + bj * 128) >> 1)) = w; }
                }
                if (f8) *(u32x2*)((unsigned char*)hid + (size_t)row * 256 + u.pn * 128 + wc * 32 + fq * 8) = (u32x2){d8[0], d8[1]};
            }
    }
};
struct EpiBf16 {
    static constexpr bool PERM = true;
    bf16_t* O; int ld; float scale;
    __device__ __forceinline__ void operator()(const AccT& acc, const Unit& u, int wr, int wc, int fr, int fq) const {
        const int row0 = u.pm * 256 + wr * 64 + fr, lc0 = u.pn * 256 + wc * 32 + 8 * fq;
#pragma unroll
        for (int ai = 0; ai < 2; ++ai)
#pragma unroll
            for (int m = 0; m < 4; ++m) {
                const int row = row0 + ai * 128 + m * 16;
#pragma unroll
                for (int bj = 0; bj < 2; ++bj) *(u32x4*)(O + (size_t)row * ld + lc0 + bj * 128) = pack8(acc[ai][bj][m][0] * scale, acc[ai][bj][m][1] * scale);
            }
    }
};
typedef __bf16 bf16v2 __attribute__((ext_vector_type(2)));
__device__ __forceinline__ void atom_pk_bf16(bf16_t* p, unsigned w) {
    asm volatile("global_atomic_pk_add_bf16 %0, %1, off" :: "v"(p), "v"(w) : "memory");
}
struct EpiAtom {
    static constexpr bool PERM = true;
    bf16_t* accb; const int* slot_tok; const float* slot_w;
    __device__ __forceinline__ void operator()(const AccT& acc, const Unit& u, int wr, int wc, int fr, int fq) const {
        const int row0 = u.pm * 256 + wr * 64 + fr, lc0 = u.pn * 256 + wc * 32 + 8 * fq;
#pragma unroll
        for (int ai = 0; ai < 2; ++ai)
#pragma unroll
            for (int m = 0; m < 4; ++m) {
                const int slot = row0 + ai * 128 + m * 16;
                const int tok = slot_tok[slot];
                if (tok >= 0) {
                    const float w = slot_w[slot];
#pragma unroll
                    for (int bj = 0; bj < 2; ++bj) {
                        const u32x4 pw = pack8(acc[ai][bj][m][0] * w, acc[ai][bj][m][1] * w);
                        bf16_t* p = accb + (size_t)tok * 1024 + lc0 + bj * 128;
                        atom_pk_bf16(p, pw.x); atom_pk_bf16(p + 2, pw.y); atom_pk_bf16(p + 4, pw.z); atom_pk_bf16(p + 6, pw.w);
                    }
                }
            }
    }
};

struct Params { const float* in[28]; float* out; unsigned char* ws; int ph_lo, ph_hi, flags, pad; };
enum { I_X = 0, I_C, I_POS, I_WADA, I_BADA, I_WIN, I_WGA2, I_BGA, I_GGN, I_WGLAO, I_GCQ, I_WUQ, I_GCKV, I_WUKV, I_WMLAO, I_WOUT, I_LN1G, I_LN1B, I_WRT, I_BRT, I_WE1, I_WE3, I_WE2, I_WS1, I_WS3, I_WS2, I_LN2G, I_LN2B };
constexpr int LDS_STAGE = 131072, LDS_BYTES = 147456, LDS_MISC = LDS_BYTES - 2048;

template <class Map>
__device__ __forceinline__ void tr_item(const float* W, int K, int Nsrc, bf16_t* WT, const Map& map, const float* kscale, LAS unsigned* scr, int kb, int nb, int lane) {
    const int k0 = 64 * kb, n0 = 64 * nb;
    const int sc = map(n0 + lane);
#pragma unroll 8
    for (int kp = 0; kp < 32; ++kp) {
        float a = 0.f, b = 0.f;
        if (sc >= 0) { a = W[(size_t)(k0 + 2 * kp) * Nsrc + sc]; b = W[(size_t)(k0 + 2 * kp + 1) * Nsrc + sc]; }
        if (kscale) { a *= kscale[k0 + 2 * kp]; b *= kscale[k0 + 2 * kp + 1]; }
        scr[kp * 65 + lane] = pk2(a, b);
    }
    LDS_WAIT(); asm volatile("" ::: "memory");
#pragma unroll
    for (int j = 0; j < 8; ++j) { const int id = lane + 64 * j, n = id >> 3, c = id & 7;
        u32x4 o; o.x = scr[(4 * c + 0) * 65 + n]; o.y = scr[(4 * c + 1) * 65 + n]; o.z = scr[(4 * c + 2) * 65 + n]; o.w = scr[(4 * c + 3) * 65 + n];
        *(u32x4*)(WT + (size_t)(n0 + n) * K + k0 + 8 * c) = o; }
    LDS_WAIT(); asm volatile("" ::: "memory");
}
struct MapId { int off; __device__ __forceinline__ int operator()(int n) const { return off + n; } };
struct MapWin {
    __device__ __forceinline__ int operator()(int n) const {
        if (n < 3072) return n;
        if (n < 3840) return 3088 + (n - 3072);
        if (n < 4096) return 3856 + (n - 3840);
        if (n < 6144) return 4176 + (n - 4096);
        const int t = n - 6144;
        if (t < 64) { const int j = t >> 3, i = t & 7; return 4112 + (i < 4 ? 4 * j + i : 32 + 4 * j + (i - 4)); }
        if (t < 80) return 3072 + (t - 64);
        return -1;
    }
};
struct MapUq { __device__ __forceinline__ int operator()(int n) const { const int h = n / 192, w = n - h * 192; if (w < 128) return n; const int t = w - 128, j = t >> 3, i = t & 7; return h * 192 + 128 + (i < 4 ? 4 * j + i : 32 + 4 * j + (i - 4)); } };
struct MapUkv { __device__ __forceinline__ int operator()(int n) const { const int part = n >> 10, r = n & 1023, h = r >> 7, d = r & 127; return h * 256 + part * 128 + d; } };
struct MapGlu { int coff; __device__ __forceinline__ int operator()(int n) const { return coff + ((n >> 3) << 2) + (n & 3); } };
__device__ __forceinline__ void tr_glu_item(const float* W1, const float* W3, int K, int Nsrc, bf16_t* WT, LAS unsigned* scr, int kb, int nb, int lane) {
    const int k0 = 64 * kb, n0 = 64 * nb, n = n0 + lane;
    const float* W = (n & 4) ? W3 : W1; const int sc = ((n >> 3) << 2) + (n & 3);
#pragma unroll 8
    for (int kp = 0; kp < 32; ++kp) scr[kp * 65 + lane] = pk2(W[(size_t)(k0 + 2 * kp) * Nsrc + sc], W[(size_t)(k0 + 2 * kp + 1) * Nsrc + sc]);
    LDS_WAIT(); asm volatile("" ::: "memory");
#pragma unroll
    for (int j = 0; j < 8; ++j) { const int id = lane + 64 * j, nn = id >> 3, c = id & 7;
        u32x4 o; o.x = scr[(4 * c + 0) * 65 + nn]; o.y = scr[(4 * c + 1) * 65 + nn]; o.z = scr[(4 * c + 2) * 65 + nn]; o.w = scr[(4 * c + 3) * 65 + nn];
        *(u32x4*)(WT + (size_t)(n0 + nn) * K + k0 + 8 * c) = o; }
    LDS_WAIT(); asm volatile("" ::: "memory");
}


__device__ __forceinline__ void tr_glu8_item(const float* W1, const float* W3, int K, int Nsrc, unsigned char* WT, LAS unsigned* scr, int kb, int nb, int lane) {
    const int k0 = 64 * kb, n0 = 64 * nb, n = n0 + lane;
    const float* W = (n & 4) ? W3 : W1; const int sc = ((n >> 3) << 2) + (n & 3);
#pragma unroll 4
    for (int kq = 0; kq < 16; ++kq) { const float* wp = W + (size_t)(k0 + 4 * kq) * Nsrc + sc;
        unsigned d = 0u; d = __builtin_amdgcn_cvt_pk_fp8_f32(wp[0] * 32.0f, wp[Nsrc] * 32.0f, d, false); d = __builtin_amdgcn_cvt_pk_fp8_f32(wp[2 * (size_t)Nsrc] * 32.0f, wp[3 * (size_t)Nsrc] * 32.0f, d, true);
        scr[kq * 65 + lane] = d; }
    LDS_WAIT(); asm volatile("" ::: "memory");
#pragma unroll
    for (int j = 0; j < 4; ++j) { const int id = lane + 64 * j, nn = id >> 2, c = id & 3;
        u32x4 o; o.x = scr[(4 * c + 0) * 65 + nn]; o.y = scr[(4 * c + 1) * 65 + nn]; o.z = scr[(4 * c + 2) * 65 + nn]; o.w = scr[(4 * c + 3) * 65 + nn];
        *(u32x4*)(WT + (size_t)(n0 + nn) * K + k0 + 16 * c) = o; }
    LDS_WAIT(); asm volatile("" ::: "memory");
}

__device__ __forceinline__ constexpr int hid_kperm(int kp) { return (kp & 128) | (((kp >> 2) & 1) << 6) | (((kp >> 5) & 3) << 4) | (((kp >> 3) & 3) << 2) | (kp & 3); }
template <class Map, bool KPERM = false>
__device__ __forceinline__ void tr8_item(const float* W, int K, int Nsrc, unsigned char* WT, const Map& map, LAS unsigned* scr, int kb, int nb, int lane, const float* gk = nullptr) {
    const int k0 = 64 * kb, n0 = 64 * nb; int sc = map(n0 + lane); const bool zr = sc < 0; sc = zr ? 0 : sc;
#pragma unroll 4
    for (int kq = 0; kq < 16; ++kq) { const float* wp = W + (size_t)(KPERM ? hid_kperm(k0 + 4 * kq) : k0 + 4 * kq) * Nsrc + sc;
        f32x4 gs = (f32x4){32.0f, 32.0f, 32.0f, 32.0f}; if (gk) gs = *(const f32x4*)(gk + k0 + 4 * kq) * 32.0f;
        unsigned d = 0u; d = __builtin_amdgcn_cvt_pk_fp8_f32(wp[0] * gs[0], wp[Nsrc] * gs[1], d, false); d = __builtin_amdgcn_cvt_pk_fp8_f32(wp[2 * (size_t)Nsrc] * gs[2], wp[3 * (size_t)Nsrc] * gs[3], d, true); d = zr ? 0u : d;
        scr[kq * 65 + lane] = d; }
    LDS_WAIT(); asm volatile("" ::: "memory");
#pragma unroll
    for (int j = 0; j < 4; ++j) { const int id = lane + 64 * j, nn = id >> 2, c = id & 3;
        u32x4 o; o.x = scr[(4 * c + 0) * 65 + nn]; o.y = scr[(4 * c + 1) * 65 + nn]; o.z = scr[(4 * c + 2) * 65 + nn]; o.w = scr[(4 * c + 3) * 65 + nn];
        *(u32x4*)(WT + (size_t)(n0 + nn) * K + k0 + 16 * c) = o; }
    LDS_WAIT(); asm volatile("" ::: "memory");
}

struct MapWin8 { __device__ __forceinline__ int operator()(int n) const { return n < 2048 ? n : n < 3072 ? (n & ~127) + ((n & 127) >> 3) + 16 * (n & 7) : n < 5120 ? 4176 + (n - 3072) : n < 6144 ? 3088 + (n - 5120) : MapWin{}(n); } };
__device__ __forceinline__ void phase0(const Params& p, LAS unsigned char* lds, int gw, int ngw, int lane, int wave) {
    unsigned char* ws = p.ws;
    {
        const int cb = blockIdx.x, tid = threadIdx.x;
        if (cb < 96) {
            const float* c = p.in[I_C]; const float* wada = p.in[I_WADA]; const float* bada = p.in[I_BADA]; float* mod = (float*)(ws + WS_MOD);
            LAS float* tab = (LAS float*)lds;
            for (int i = tid; i < 32 * 1024 / 4; i += NTHR) { const f32x4 v = ((const f32x4*)c)[i]; f32x4 o; o[0] = silu(v[0]); o[1] = silu(v[1]); o[2] = silu(v[2]); o[3] = silu(v[3]); ((LAS f32x4*)tab)[i] = o; }
            __syncthreads();
            float acc[32];
#pragma unroll
            for (int b = 0; b < 32; ++b) acc[b] = 0.f;
            const int col = cb * 64 + lane;
            for (int k4 = 0; k4 < 32; ++k4) {
                const int k = wave * 128 + k4 * 4;
                float w[4];
#pragma unroll
                for (int q = 0; q < 4; ++q) w[q] = wada[(size_t)(k + q) * 6144 + col];
#pragma unroll
                for (int b = 0; b < 32; ++b) { const f32x4 t = *(const LAS f32x4*)(tab + b * 1024 + k); acc[b] += t[0] * w[0] + t[1] * w[1] + t[2] * w[2] + t[3] * w[3]; }
            }
            __syncthreads();
            LAS float* part = (LAS float*)lds;
#pragma unroll
            for (int b = 0; b < 32; ++b) part[(wave * 32 + b) * 64 + lane] = acc[b];
            __syncthreads();
#pragma unroll
            for (int i = 0; i < 4; ++i) { const int o = tid + 512 * i, b = o >> 6, l = o & 63; float sum = 0.f;
#pragma unroll
                for (int w8 = 0; w8 < 8; ++w8) sum += part[(w8 * 32 + b) * 64 + l];
                mod[b * 6144 + cb * 64 + l] = sum + bada[cb * 64 + l]; }
            __syncthreads();
        }
    }
    LAS unsigned* scr = (LAS unsigned*)(lds + wave * 8448);
    constexpr int T_WIN = 0, T_GLAO = 16 * 16, T_UQ = 12 * 24, T_UKV = 4 * 32, T_MLAO = 256, T_OUT = 256, T_RT = 16 * 4, T_S13 = 16 * 8, T_S2 = 4 * 16, T_WIN8 = 16 * 100;
    constexpr int T_ALL = T_WIN + T_GLAO + T_UQ + T_UKV + T_MLAO + T_OUT + T_RT + T_S13 + T_S2 + T_WIN8;
    for (int it = gw; it < T_ALL; it += ngw) {
        int r = it;
        if (r < T_WIN) { tr_item(p.in[I_WIN], 1024, 6224, (bf16_t*)(ws + WS_WIN), MapWin{}, nullptr, scr, r / 4, 96 + r % 4, lane); continue; }        r -= T_WIN;
        if (r < T_GLAO) { tr8_item(p.in[I_WGLAO], 1024, 1024, ws + WS_WGLAO, MapId{0}, scr, r / 16, r % 16, lane); continue; } r -= T_GLAO;
        if (r < T_UQ) { tr8_item(p.in[I_WUQ], 768, 1536, ws + WS_WUQ, MapUq{}, scr, r / 24, r % 24, lane, p.in[I_GCQ]); continue; } r -= T_UQ;
        if (r < T_UKV) { tr8_item(p.in[I_WUKV], 256, 2048, ws + WS_WUKV, MapUkv{}, scr, r / 32, r % 32, lane, p.in[I_GCKV]); continue; } r -= T_UKV;
        if (r < T_MLAO) { tr8_item(p.in[I_WMLAO], 1024, 1024, ws + WS_WMLAO, MapId{0}, scr, r / 16, r % 16, lane); continue; } r -= T_MLAO;
        if (r < T_OUT) { tr8_item(p.in[I_WOUT], 1024, 1024, ws + WS_WOUT, MapId{0}, scr, r / 16, r % 16, lane); continue; } r -= T_OUT;
        if (r < T_RT) { tr_item(p.in[I_WRT], 1024, 256, (bf16_t*)(ws + WS_WRT), MapId{0}, nullptr, scr, r / 4, r % 4, lane); continue; } r -= T_RT;
        if (r < T_S13) { tr_glu8_item(p.in[I_WS1], p.in[I_WS3], 1024, 256, ws + WS_WS13, scr, r / 8, r % 8, lane); continue; } r -= T_S13;
        if (r < T_S2) { tr8_item<MapId, true>(p.in[I_WS2], 256, 1024, ws + WS_WS2, MapId{0}, scr, r / 16, r % 16, lane); continue; } r -= T_S2;
        tr8_item(p.in[I_WIN], 1024, 6224, ws + WS_WIN, MapWin8{}, scr, r / 100, r % 100, lane);
    }
    { int* st = (int*)(ws + WS_STOK); for (int i = gw * 64 + lane; i < NSLOT; i += ngw * 64) st[i] = -1; }
}

__device__ __forceinline__ void phase1(const Params& p, int gw, int ngw, int lane) {
    const float* x = p.in[I_X]; const float* mod = (const float*)(p.ws + WS_MOD);
    const int* pos = (const int*)p.in[I_POS]; float* rope = (float*)((unsigned char*)p.out + 192 * MiB);
    const float invf = exp2f(-(float)(lane & 31) * (13.287712379549449f / 32.0f));
    for (int m0 = gw; m0 < NTOK; m0 += 4 * ngw) {
        f32x4 v[4][4]; int ps[4];
#pragma unroll
        for (int r = 0; r < 4; ++r) { const int m = m0 + r * ngw; const f32x4* xr = (const f32x4*)(x + (size_t)m * 1024) + lane; ps[r] = pos[m];
#pragma unroll
            for (int j = 0; j < 4; ++j) v[r][j] = xr[64 * j]; }
#pragma unroll
        for (int r = 0; r < 4; ++r) { const int m = m0 + r * ngw, b = m >> 11; const float* sh = mod + b * 6144; const float* sc = sh + 1024;
#pragma unroll
            for (int j = 0; j < 4; ++j) { const f32x4 s = *((const f32x4*)sc + lane + 64 * j) + 1.0f, t = *((const f32x4*)sh + lane + 64 * j);
                const f32x4 q = v[r][j] * s + t;
                unsigned w8 = 0u; w8 = __builtin_amdgcn_cvt_pk_fp8_f32(q[0], q[1], w8, false); w8 = __builtin_amdgcn_cvt_pk_fp8_f32(q[2], q[3], w8, true);
                ((unsigned*)(p.ws + WS_BIG(7) + (size_t)m * 1024))[lane + 64 * j] = w8; }
            const float ang = (float)ps[r] * invf;
            const float rev = ang * 0.15915494309189535f, frv = rev - floorf(rev);
            rope[(size_t)m * 64 + lane] = __builtin_amdgcn_sinf(lane < 32 ? frv + 0.25f : frv); }
    }
}

__device__ __forceinline__ void ln1_row(float* zrow, bf16_t* h2row, const float* g, const float* bta, const float* sh2, const float* sc2, int lane) {
    f32x4* zr = (f32x4*)zrow + lane; f32x4 v[4]; float s = 0.f;
#pragma unroll
    for (int j = 0; j < 4; ++j) { v[j] = zr[64 * j]; s += (v[j][0] + v[j][1]) + (v[j][2] + v[j][3]); }
    const float mean = wave_sum(s) * (1.f / 1024.f); float s2 = 0.f;
#pragma unroll
    for (int j = 0; j < 4; ++j) { v[j] = v[j] - mean; s2 += (v[j][0] * v[j][0] + v[j][1] * v[j][1]) + (v[j][2] * v[j][2] + v[j][3] * v[j][3]); }
    const float rstd = rsqrtf(wave_sum(s2) * (1.f / 1024.f) + LN_EPS);
    u32x2* o = (u32x2*)h2row + lane;
#pragma unroll
    for (int j = 0; j < 4; ++j) {
        const int ci = lane + 64 * j;
        const f32x4 x1 = v[j] * rstd * ((const f32x4*)g)[ci] + ((const f32x4*)bta)[ci];
        zr[64 * j] = x1;
        const f32x4 hh = x1 * (((const f32x4*)sc2)[ci] + 1.0f) + ((const f32x4*)sh2)[ci];
        u32x2 w; w.x = pk2(hh[0], hh[1]); w.y = pk2(hh[2], hh[3]); o[64 * j] = w;
    }
}
__device__ __forceinline__ void ln2_row(float* orow, const bf16_t* frow, const float* g, const float* bta, const float* gt2, int lane) {
    f32x4* zr = (f32x4*)orow + lane; const u32x2* fr = (const u32x2*)frow + lane; f32x4 v[4]; float s = 0.f;
#pragma unroll
    for (int j = 0; j < 4; ++j) { const u32x2 w = fr[64 * j]; const f32x4 f = (f32x4){bflo(w.x), bfhi(w.x), bflo(w.y), bfhi(w.y)};
        v[j] = zr[64 * j] * ALPHA + (((const f32x4*)gt2)[lane + 64 * j] + 1.0f) * f; s += (v[j][0] + v[j][1]) + (v[j][2] + v[j][3]); }
    const float mean = wave_sum(s) * (1.f / 1024.f); float s2 = 0.f;
#pragma unroll
    for (int j = 0; j < 4; ++j) { v[j] = v[j] - mean; s2 += (v[j][0] * v[j][0] + v[j][1] * v[j][1]) + (v[j][2] * v[j][2] + v[j][3] * v[j][3]); }
    const float rstd = rsqrtf(wave_sum(s2) * (1.f / 1024.f) + LN_EPS);
#pragma unroll
    for (int j = 0; j < 4; ++j) { const int ci = lane + 64 * j; zr[64 * j] = v[j] * rstd * ((const f32x4*)g)[ci] + ((const f32x4*)bta)[ci]; }
}

#define GLA_BAR() do { asm volatile("s_waitcnt lgkmcnt(0)" ::: "memory"); __builtin_amdgcn_s_barrier(); asm volatile("" ::: "memory"); } while (0)
__device__ __forceinline__ void gla_phase(const Params& p, LAS unsigned char* lds, int bh, bool nostore) {
    const int tid = threadIdx.x, lane = tid & 63, wave = __builtin_amdgcn_readfirstlane(tid >> 6), fr = lane & 15, g = lane >> 4;
    const int b = bh >> 2, h = bh & 3;
    const bf16_t* qg = (const bf16_t*)(p.ws + WS_BIG(1)); const bf16_t* kg = qg + (size_t)NTOK * 512; const bf16_t* vg = (const bf16_t*)(p.ws + WS_BIG(2));
    bf16_t* gr = (bf16_t*)(p.ws + WS_BIG(3)); const float* gag = (const float*)(p.ws + WS_GA);
    LAS bf16_t* KdT = (LAS bf16_t*)lds;
    LAS bf16_t* VT = (LAS bf16_t*)(lds + 18432);
    LAS bf16_t* ST = (LAS bf16_t*)lds;
    LAS bf16_t* QS = (LAS bf16_t*)(lds + 69632);
    LAS float* DEC = (LAS float*)(lds + 87040);
    LAS float* PART = (LAS float*)(lds + 87552);
    LAS float* GAC = (LAS float*)(lds + 89600);
    LAS float* SS = (LAS float*)(lds + 93696);
    const int dk = tid & 127, tq = tid >> 7;
    float w2[16];
#pragma unroll
    for (int r = 0; r < 16; ++r) w2[r] = p.in[I_WGA2][r * 512 + h * 128 + dk];
    const float bias = p.in[I_BGA][h * 128 + dk];
    const int rg = wave & 3, ch = wave >> 2;
    float gnv[8];
#pragma unroll
    for (int nt = 0; nt < 8; ++nt) gnv[nt] = p.in[I_GGN][128 * ch + 16 * nt + fr];
    f32x4 st[8][2];
#pragma unroll
    for (int mt = 0; mt < 8; ++mt) { st[mt][0] = (f32x4){0.f, 0.f, 0.f, 0.f}; st[mt][1] = (f32x4){0.f, 0.f, 0.f, 0.f}; }
    const int dvp = tid & 127, tq4 = tid >> 7;
    bf16_t kraw[16]; unsigned vraw[16]; u32x4 qraw[2]; f32x4 garaw = (f32x4){0.f, 0.f, 0.f, 0.f};
#define GLA_LOAD(n_) do { const int tk_ = b * 2048 + (n_) * 64; \
        if (tid < 256) garaw = *(const f32x4*)(gag + (size_t)(tk_ + (tid >> 2)) * 16 + (tid & 3) * 4); \
        _Pragma("unroll") for (int j = 0; j < 16; ++j) kraw[j] = kg[(size_t)(tk_ + 16 * tq + j) * 512 + h * 128 + dk]; \
        _Pragma("unroll") for (int j = 0; j < 16; ++j) vraw[j] = *(const unsigned*)(vg + (size_t)(tk_ + 16 * tq4 + j) * 1024 + h * 256 + 2 * dvp); \
        _Pragma("unroll") for (int i = 0; i < 2; ++i) { const int id = tid + 512 * i; qraw[i] = *(const u32x4*)(qg + (size_t)(tk_ + (id >> 4)) * 512 + h * 128 + (id & 15) * 8); } } while (0)
    GLA_LOAD(0);
    if (tid < 256) *(LAS f32x4*)(GAC + tid * 4) = garaw;
    GLA_BAR();
    for (int n = 0; n < 32; ++n) {
        const int tok0 = b * 2048 + n * 64;
        float cs[16]; float run = 0.f;
#pragma unroll
        for (int j = 0; j < 16; ++j) {
            const LAS f32x4* gp = (const LAS f32x4*)(GAC + (16 * tq + j) * 16);
            float d = bias;
#pragma unroll
            for (int r4 = 0; r4 < 4; ++r4) { const f32x4 gv = gp[r4]; d += gv[0] * w2[4 * r4] + gv[1] * w2[4 * r4 + 1] + gv[2] * w2[4 * r4 + 2] + gv[3] * w2[4 * r4 + 3]; }
            const float ls = fminf(d, 0.f) - __logf(1.0f + __expf(-fabsf(d)));
            run += ls * (1.0f / 16.0f); cs[j] = run;
        }
        PART[tq * 128 + dk] = run;
        GLA_BAR();
        {
            const float p0 = PART[dk], p1 = PART[128 + dk], p2 = PART[256 + dk], p3 = PART[384 + dk];
            const float total = (p0 + p1) + (p2 + p3);
            const float off = tq == 0 ? 0.f : tq == 1 ? p0 : tq == 2 ? (p0 + p1) : (p0 + p1) + p2;
            if (tq == 0) DEC[dk] = __expf(total);
            unsigned kd[8];
#pragma unroll
            for (int j = 0; j < 8; ++j) kd[j] = pk2(bf2f(kraw[2 * j]) * __expf(total - (off + cs[2 * j])), bf2f(kraw[2 * j + 1]) * __expf(total - (off + cs[2 * j + 1])));
            LAS u32x4* kdst = (LAS u32x4*)(KdT + dk * 72 + 16 * tq);
            kdst[0] = (u32x4){kd[0], kd[1], kd[2], kd[3]}; kdst[1] = (u32x4){kd[4], kd[5], kd[6], kd[7]};
            unsigned v0[8], v1[8];
#pragma unroll
            for (int j = 0; j < 8; ++j) { v0[j] = (vraw[2 * j] & 0xffffu) | (vraw[2 * j + 1] << 16); v1[j] = (vraw[2 * j] >> 16) | (vraw[2 * j + 1] & 0xffff0000u); }
            LAS u32x4* vd0 = (LAS u32x4*)(VT + (2 * dvp) * 72 + 16 * tq4); LAS u32x4* vd1 = (LAS u32x4*)(VT + (2 * dvp + 1) * 72 + 16 * tq4);
            vd0[0] = (u32x4){v0[0], v0[1], v0[2], v0[3]}; vd0[1] = (u32x4){v0[4], v0[5], v0[6], v0[7]};
            vd1[0] = (u32x4){v1[0], v1[1], v1[2], v1[3]}; vd1[1] = (u32x4){v1[4], v1[5], v1[6], v1[7]};
#pragma unroll
            for (int i = 0; i < 2; ++i) { const int id = tid + 512 * i; *(LAS u32x4*)(QS + (id >> 4) * 136 + (id & 15) * 8) = qraw[i]; }
        }
        if (n + 1 < 32) GLA_LOAD(n + 1);
        GLA_BAR();
#pragma unroll
        for (int mt = 0; mt < 8; ++mt) { const f32x4 d4 = *(const LAS f32x4*)(DEC + 16 * mt + 4 * g); st[mt][0] *= d4; st[mt][1] *= d4; }
        {
            bf16x8 bfr[2][2], ka[3];
#pragma unroll
            for (int ks = 0; ks < 2; ++ks)
#pragma unroll
                for (int nt = 0; nt < 2; ++nt) bfr[ks][nt] = *(const LAS bf16x8*)(VT + (32 * wave + 16 * nt + fr) * 72 + 32 * ks + 8 * g);
            const LAS bf16_t* kab = KdT + fr * 72 + 8 * g;
#define GLA_LDA(ix) ka[(ix) % 3] = *(const LAS bf16x8*)(kab + (16 * ((ix) & 7)) * 72 + 32 * ((ix) >> 3))
            GLA_LDA(0); GLA_LDA(1);
#pragma unroll
            for (int ix = 0; ix < 16; ++ix) {
                if (ix + 2 < 16) { GLA_LDA(ix + 2); asm volatile("s_waitcnt lgkmcnt(2)" ::: "memory"); }
                else if (ix + 1 < 16) asm volatile("s_waitcnt lgkmcnt(1)" ::: "memory");
                else asm volatile("s_waitcnt lgkmcnt(0)" ::: "memory");
                __builtin_amdgcn_sched_barrier(0);
                st[ix & 7][0] = __builtin_amdgcn_mfma_f32_16x16x32_bf16(ka[ix % 3], bfr[ix >> 3][0], st[ix & 7][0], 0, 0, 0);
                st[ix & 7][1] = __builtin_amdgcn_mfma_f32_16x16x32_bf16(ka[ix % 3], bfr[ix >> 3][1], st[ix & 7][1], 0, 0, 0);
                __builtin_amdgcn_sched_barrier(0);
            }
#undef GLA_LDA
        }
        GLA_BAR();
#pragma unroll
        for (int mt = 0; mt < 8; ++mt)
#pragma unroll
            for (int nt = 0; nt < 2; ++nt) { u32x2 w; w.x = pk2(st[mt][nt][0], st[mt][nt][1]); w.y = pk2(st[mt][nt][2], st[mt][nt][3]);
                *(LAS u32x2*)(ST + (32 * wave + 16 * nt + fr) * 136 + 16 * mt + 4 * g) = w; }
        GLA_BAR();
        u32x4 grw[4];
#pragma unroll
        for (int r = 0; r < 4; ++r) grw[r] = *(const u32x4*)(gr + (size_t)(tok0 + 16 * rg + 4 * g + r) * 1024 + h * 256 + 128 * ch + 8 * fr);
        f32x4 o[8];
#pragma unroll
        for (int nt = 0; nt < 8; ++nt) o[nt] = (f32x4){0.f, 0.f, 0.f, 0.f};
        {
            bf16x8 qa[4], sb[3];
#pragma unroll
            for (int ks = 0; ks < 4; ++ks) qa[ks] = *(const LAS bf16x8*)(QS + (16 * rg + fr) * 136 + 32 * ks + 8 * g);
            const LAS bf16_t* sbb = ST + (128 * ch + fr) * 136 + 8 * g;
#define GLA_LDB(ix) sb[(ix) % 3] = *(const LAS bf16x8*)(sbb + (16 * ((ix) & 7)) * 136 + 32 * ((ix) >> 3))
            GLA_LDB(0); GLA_LDB(1);
#pragma unroll
            for (int ix = 0; ix < 32; ++ix) {
                if (ix + 2 < 32) { GLA_LDB(ix + 2); asm volatile("s_waitcnt lgkmcnt(2)" ::: "memory"); }
                else if (ix + 1 < 32) asm volatile("s_waitcnt lgkmcnt(1)" ::: "memory");
                else asm volatile("s_waitcnt lgkmcnt(0)" ::: "memory");
                __builtin_amdgcn_sched_barrier(0);
                o[ix & 7] = __builtin_amdgcn_mfma_f32_16x16x32_bf16(qa[ix >> 3], sb[ix % 3], o[ix & 7], 0, 0, 0);
                __builtin_amdgcn_sched_barrier(0);
            }
#undef GLA_LDB
        }
        {
            f32x4 s2 = (f32x4){0.f, 0.f, 0.f, 0.f};
#pragma unroll
            for (int nt = 0; nt < 8; ++nt) s2 += o[nt] * o[nt];
#pragma unroll
            for (int r = 0; r < 4; ++r) { float s = s2[r]; s += __shfl_xor(s, 1); s += __shfl_xor(s, 2); s += __shfl_xor(s, 4); s += __shfl_xor(s, 8); if (fr == 0) SS[(16 * rg + 4 * g + r) * 2 + ch] = s; }
        }
        if (n + 1 < 32 && tid < 256) *(LAS f32x4*)(GAC + tid * 4) = garaw;
        GLA_BAR();
#pragma unroll
        for (int r = 0; r < 4; ++r) {
            const int t = 16 * rg + 4 * g + r;
            const float rstd = rsqrtf((SS[t * 2] + SS[t * 2 + 1]) * (1.0f / 256.0f) + RMS_EPS);
            float y[8];
#pragma unroll
            for (int nt = 0; nt < 8; ++nt) { const unsigned w = grw[r][nt >> 1]; y[nt] = o[nt][r] * rstd * gnv[nt] * __uint_as_float((nt & 1) ? (w & 0xffff0000u) : (w << 16)); }
            unsigned char* orow8 = p.ws + WS_BIG(5) + 64 * MiB + (size_t)(tok0 + t) * 1024 + h * 256 + 128 * ch + 16 * (lane & 3) + 4 * ((lane >> 2) & 3);
            const unsigned psel = (unsigned)(lane & 3) | ((4u + (lane & 3)) << 8) | 0x0c0c0000u;
#pragma unroll
            for (int hf = 0; hf < 2; ++hf) {
                unsigned P = 0u; P = __builtin_amdgcn_cvt_pk_fp8_f32(y[4 * hf], y[4 * hf + 1], P, false); P = __builtin_amdgcn_cvt_pk_fp8_f32(y[4 * hf + 2], y[4 * hf + 3], P, true);
                const unsigned X0 = (unsigned)__builtin_amdgcn_update_dpp(0, (int)P, 0x00, 0xf, 0xf, false), X1 = (unsigned)__builtin_amdgcn_update_dpp(0, (int)P, 0x55, 0xf, 0xf, false);
                const unsigned X2 = (unsigned)__builtin_amdgcn_update_dpp(0, (int)P, 0xAA, 0xf, 0xf, false), X3 = (unsigned)__builtin_amdgcn_update_dpp(0, (int)P, 0xFF, 0xf, 0xf, false);
                const unsigned t01 = __builtin_amdgcn_perm(X1, X0, psel), t23 = __builtin_amdgcn_perm(X3, X2, psel);
                if (!nostore) *(unsigned*)(orow8 + 64 * hf) = t01 | (t23 << 16);
            }
        }
    }
#undef GLA_LOAD
    __syncthreads();
}

__device__ __forceinline__ float xor16_max(float v) { const auto r = __builtin_amdgcn_permlane16_swap(__float_as_uint(v), __float_as_uint(v), false, false); return fmaxf(__uint_as_float(r[0]), __uint_as_float(r[1])); }
__device__ __forceinline__ float xor32_max(float v) { const auto r = __builtin_amdgcn_permlane32_swap(__float_as_uint(v), __float_as_uint(v), false, false); return fmaxf(__uint_as_float(r[0]), __uint_as_float(r[1])); }
__device__ __forceinline__ float xor16_sum(float v) { const auto r = __builtin_amdgcn_permlane16_swap(__float_as_uint(v), __float_as_uint(v), false, false); return __uint_as_float(r[0]) + __uint_as_float(r[1]); }
__device__ __forceinline__ float xor32_sum(float v) { const auto r = __builtin_amdgcn_permlane32_swap(__float_as_uint(v), __float_as_uint(v), false, false); return __uint_as_float(r[0]) + __uint_as_float(r[1]); }
constexpr int ATT_BUF = 43008, ATT_VOFF = 24576;
__device__ __forceinline__ void attn_phase(const Params& p, LAS unsigned char* lds, int bh) {
    const int tid = threadIdx.x, lane = tid & 63, wave = __builtin_amdgcn_readfirstlane(tid >> 6), fr = lane & 15, g = lane >> 4;
    const int b = bh >> 3, h = bh & 7;
    const bf16_t* qm = (const bf16_t*)p.out; const bf16_t* kn = (const bf16_t*)(p.ws + WS_BIG(0)); const bf16_t* vm = (const bf16_t*)(p.ws + WS_BIG(7));
    const bf16_t* kr = (const bf16_t*)(p.ws + WS_KR); bf16_t* ob = (bf16_t*)(p.ws + WS_BIG(1));
    const int kp = tid & 31, dvc = tid >> 5;
    unsigned koff[3]; bool krope[3];
#pragma unroll
    for (int j = 0; j < 3; ++j) { const int L = (8 * j + wave) * 64 + lane, key = L / 24, sl = L % 24, c = (sl & ~7) | ((sl & 7) ^ (key & 7));
        krope[j] = c >= 16; koff[j] = krope[j] ? (unsigned)(key * 128 + 16 * (c - 16)) : (unsigned)(key * 2048 + h * 256 + 16 * c); }
    for (int qb = 0; qb < 8; ++qb) {
        const int q0 = b * 2048 + 256 * qb + 32 * wave;
        bf16x8 qf[2][6];
#pragma unroll
        for (int nt = 0; nt < 2; ++nt)
#pragma unroll
            for (int ks = 0; ks < 6; ++ks) qf[nt][ks] = *(const bf16x8*)(qm + (size_t)(q0 + 16 * nt + fr) * 1536 + h * 192 + 32 * ks + 8 * g);
        f32x4 O[8][2];
#pragma unroll
        for (int mt = 0; mt < 8; ++mt) { O[mt][0] = (f32x4){0.f, 0.f, 0.f, 0.f}; O[mt][1] = (f32x4){0.f, 0.f, 0.f, 0.f}; }
        float m_run[2] = {-1e30f, -1e30f}, l_part[2] = {0.f, 0.f};
        const int ntile = 4 * qb + 4, my_last = 4 * qb + (wave >> 1);
        u32x4 vreg[2];
#define ATT_PREFETCH(kt, buf) do { const int tk0 = b * 2048 + 64 * (kt); const char* knb = (const char*)(kn + (size_t)tk0 * 1024); const char* krb = (const char*)(kr + (size_t)tk0 * 64); \
            _Pragma("unroll") for (int j = 0; j < 3; ++j) __builtin_amdgcn_global_load_lds((const unsigned*)((krope[j] ? krb : knb) + koff[j]), (LAS unsigned*)(lds + (buf) * ATT_BUF + (8 * j + wave) * 1024), 16, 0, 0); \
            vreg[0] = *(const u32x4*)(vm + (size_t)(tk0 + 2 * kp) * 1024 + h * 128 + 8 * dvc); vreg[1] = *(const u32x4*)(vm + (size_t)(tk0 + 2 * kp + 1) * 1024 + h * 128 + 8 * dvc); } while (0)
#define ATT_WRITE(buf) do { LAS unsigned* VTw = (LAS unsigned*)(lds + (buf) * ATT_BUF + ATT_VOFF); \
            _Pragma("unroll") for (int i = 0; i < 4; ++i) { const unsigned a_ = vreg[0][i], b_ = vreg[1][i]; \
                VTw[(8 * dvc + 2 * i) * 36 + kp] = (a_ & 0xffffu) | (b_ << 16); VTw[(8 * dvc + 2 * i + 1) * 36 + kp] = (a_ >> 16) | (b_ & 0xffff0000u); } \
            asm volatile("s_waitcnt vmcnt(0)" ::: "memory"); } while (0)
        __syncthreads();
        ATT_PREFETCH(0, 0);
        ATT_WRITE(0);
        __syncthreads();
        for (int kt = 0; kt < ntile; ++kt) {
            if (kt + 1 < ntile) ATT_PREFETCH(kt + 1, (kt + 1) & 1);
            if (kt <= my_last) {
                const LAS unsigned char* KS = lds + (kt & 1) * ATT_BUF; const LAS unsigned* VT = (const LAS unsigned*)(lds + (kt & 1) * ATT_BUF + ATT_VOFF);
                f32x4 s[4][2];
#pragma unroll
                for (int mt = 0; mt < 4; ++mt) { s[mt][0] = (f32x4){0.f, 0.f, 0.f, 0.f}; s[mt][1] = (f32x4){0.f, 0.f, 0.f, 0.f}; }
                {
                    bf16x8 ka[2][4];
                    const LAS unsigned char* kb0 = KS + fr * 384 + 16 * (g ^ (fr & 7));
                    const LAS unsigned char* kb1 = KS + fr * 384 + 16 * ((4 + g) ^ (fr & 7));
#pragma unroll
                    for (int mt = 0; mt < 4; ++mt) ka[0][mt] = *(const LAS bf16x8*)(kb0 + mt * 6144);
#pragma unroll
                    for (int ks = 0; ks < 6; ++ks) {
                        if (ks < 5) {
#pragma unroll
                            for (int mt = 0; mt < 4; ++mt) ka[(ks + 1) & 1][mt] = *(const LAS bf16x8*)((((ks + 1) & 1) ? kb1 : kb0) + mt * 6144 + 128 * ((ks + 1) >> 1));
                            asm volatile("s_waitcnt lgkmcnt(4)" ::: "memory");
                        } else asm volatile("s_waitcnt lgkmcnt(0)" ::: "memory");
                        __builtin_amdgcn_sched_barrier(0);
#pragma unroll
                        for (int mt = 0; mt < 4; ++mt) {
                            s[mt][0] = __builtin_amdgcn_mfma_f32_16x16x32_bf16(ka[ks & 1][mt], qf[0][ks], s[mt][0], 0, 0, 0);
                            s[mt][1] = __builtin_amdgcn_mfma_f32_16x16x32_bf16(ka[ks & 1][mt], qf[1][ks], s[mt][1], 0, 0, 0);
                        }
                        __builtin_amdgcn_sched_barrier(0);
                    }
                }
                bf16x8 pf[2][2]; float al[2];
#pragma unroll
                for (int nt = 0; nt < 2; ++nt) {
                    float mx = fmaxf(fmaxf(s[0][nt][0], s[0][nt][1]), fmaxf(s[0][nt][2], s[0][nt][3]));
#pragma unroll
                    for (int mt = 1; mt < 4; ++mt) mx = fmaxf(mx, fmaxf(fmaxf(s[mt][nt][0], s[mt][nt][1]), fmaxf(s[mt][nt][2], s[mt][nt][3])));
                    mx = xor16_max(mx); mx = xor32_max(mx);
                    const float mn = fmaxf(m_run[nt], mx); al[nt] = __builtin_amdgcn_exp2f(m_run[nt] - mn); m_run[nt] = mn;
                    float rs = 0.f;
#pragma unroll
                    for (int mt = 0; mt < 4; ++mt)
#pragma unroll
                        for (int r = 0; r < 4; ++r) { const float e = __builtin_amdgcn_exp2f(s[mt][nt][r] - mn); s[mt][nt][r] = e; rs += e; }
                    l_part[nt] = l_part[nt] * al[nt] + rs;
#pragma unroll
                    for (int k2 = 0; k2 < 2; ++k2) {
                        u32x4 w; w.x = pk2(s[2 * k2][nt][0], s[2 * k2][nt][1]); w.y = pk2(s[2 * k2][nt][2], s[2 * k2][nt][3]);
                        w.z = pk2(s[2 * k2 + 1][nt][0], s[2 * k2 + 1][nt][1]); w.w = pk2(s[2 * k2 + 1][nt][2], s[2 * k2 + 1][nt][3]);
                        pf[nt][k2] = __builtin_bit_cast(bf16x8, w);
                    }
                }
                if (__any(al[0] != 1.0f || al[1] != 1.0f)) {
#pragma unroll
                    for (int mt = 0; mt < 8; ++mt) { O[mt][0] *= al[0]; O[mt][1] *= al[1]; }
                }
                {
                    u32x2 vf[2][2][2];
                    const LAS unsigned* vbase = VT + fr * 36 + 2 * g;
#pragma unroll
                    for (int k2 = 0; k2 < 2; ++k2) { vf[0][k2][0] = *(const LAS u32x2*)(vbase + 16 * k2); vf[0][k2][1] = *(const LAS u32x2*)(vbase + 16 * k2 + 8); }
#pragma unroll
                    for (int mt = 0; mt < 8; ++mt) {
                        if (mt < 7) {
#pragma unroll
                            for (int k2 = 0; k2 < 2; ++k2) { vf[(mt + 1) & 1][k2][0] = *(const LAS u32x2*)(vbase + 16 * (mt + 1) * 36 + 16 * k2); vf[(mt + 1) & 1][k2][1] = *(const LAS u32x2*)(vbase + 16 * (mt + 1) * 36 + 16 * k2 + 8); }
                            asm volatile("s_waitcnt lgkmcnt(4)" ::: "memory");
                        } else asm volatile("s_waitcnt lgkmcnt(0)" ::: "memory");
                        __builtin_amdgcn_sched_barrier(0);
#pragma unroll
                        for (int k2 = 0; k2 < 2; ++k2) {
                            const u32x2 lo = vf[mt & 1][k2][0], hi = vf[mt & 1][k2][1];
                            const bf16x8 a = __builtin_bit_cast(bf16x8, ((u32x4){lo.x, lo.y, hi.x, hi.y}));
                            O[mt][0] = __builtin_amdgcn_mfma_f32_16x16x32_bf16(a, pf[0][k2], O[mt][0], 0, 0, 0);
                            O[mt][1] = __builtin_amdgcn_mfma_f32_16x16x32_bf16(a, pf[1][k2], O[mt][1], 0, 0, 0);
                        }
                        __builtin_amdgcn_sched_barrier(0);
                    }
                }
            }
            if (kt + 1 < ntile) ATT_WRITE((kt + 1) & 1);
            __syncthreads();
        }
#undef ATT_PREFETCH
#undef ATT_WRITE
#pragma unroll
        for (int nt = 0; nt < 2; ++nt) {
            float l = l_part[nt]; l = xor16_sum(l); l = xor32_sum(l);
            const float inv = 1.0f / l;
            unsigned char* orow = (unsigned char*)ob + (size_t)(q0 + 16 * nt + fr) * 1024 + h * 128 + 4 * g;
#pragma unroll
            for (int mt = 0; mt < 8; ++mt) { unsigned d = 0u; d = __builtin_amdgcn_cvt_pk_fp8_f32(O[mt][nt][0] * inv, O[mt][nt][1] * inv, d, false); d = __builtin_amdgcn_cvt_pk_fp8_f32(O[mt][nt][2] * inv, O[mt][nt][3] * inv, d, true); *(unsigned*)(orow + 16 * mt) = d; }
        }
    }
    __syncthreads();
}

__device__ __forceinline__ unsigned dpp_umax_step_shr(unsigned v, int) { return v; }
__device__ __forceinline__ unsigned wave_umax(unsigned v) {
    unsigned t;
    t = (unsigned)__builtin_amdgcn_update_dpp(0, (int)v, 0x111, 0xf, 0xf, true); v = v > t ? v : t;
    t = (unsigned)__builtin_amdgcn_update_dpp(0, (int)v, 0x112, 0xf, 0xf, true); v = v > t ? v : t;
    t = (unsigned)__builtin_amdgcn_update_dpp(0, (int)v, 0x114, 0xf, 0xf, true); v = v > t ? v : t;
    t = (unsigned)__builtin_amdgcn_update_dpp(0, (int)v, 0x118, 0xf, 0xf, true); v = v > t ? v : t;
    t = (unsigned)__builtin_amdgcn_update_dpp(0, (int)v, 0x142, 0xa, 0xf, false); v = v > t ? v : t;
    t = (unsigned)__builtin_amdgcn_update_dpp(0, (int)v, 0x143, 0xc, 0xf, false); v = v > t ? v : t;
    return (unsigned)__builtin_amdgcn_readlane((int)v, 63);
}
template <int CTRL> __device__ __forceinline__ float dpp_f(float v) { return __builtin_bit_cast(float, __builtin_amdgcn_update_dpp(0, __builtin_bit_cast(int, v), CTRL, 0xf, 0xf, false)); }
template <int CTRL> __device__ __forceinline__ void top2_merge(float& t1, float& t2) { const float p1 = dpp_f<CTRL>(t1), p2 = dpp_f<CTRL>(t2); const float n1 = fmaxf(t1, p1), n2 = fmaxf(fminf(t1, p1), fmaxf(t2, p2)); t1 = n1; t2 = n2; }
__device__ __forceinline__ void route_row2(const f32x4 lg0, const f32x4 lg1, const f32x4 bb, int* tidx, float* tw, LAS int* etab, int lane) {
    float sc[2][4], mv[2][4], t1[2], t2[2];
#pragma unroll
    for (int q = 0; q < 2; ++q) {
        const f32x4 lg = q ? lg1 : lg0;
#pragma unroll
        for (int i = 0; i < 4; ++i) { sc[q][i] = sigm(lg[i]); mv[q][i] = sc[q][i] + bb[i]; }
        t1[q] = fmaxf(fmaxf(mv[q][0], mv[q][1]), fmaxf(mv[q][2], mv[q][3]));
        const float a = fmaxf(mv[q][0], mv[q][1]), bq = fminf(mv[q][0], mv[q][1]), c = fmaxf(mv[q][2], mv[q][3]), d = fminf(mv[q][2], mv[q][3]); t2[q] = fmaxf(fminf(a, c), fmaxf(bq, d));
    }
    top2_merge<0xB1>(t1[0], t2[0]); top2_merge<0xB1>(t1[1], t2[1]);
    top2_merge<0x4E>(t1[0], t2[0]); top2_merge<0x4E>(t1[1], t2[1]);
    top2_merge<0x141>(t1[0], t2[0]); top2_merge<0x141>(t1[1], t2[1]);
    const int mygrp = lane >> 3;
#pragma unroll
    for (int q = 0; q < 2; ++q) {
        const float gs = t1[q] + t2[q]; int rank = 0;
#pragma unroll
        for (int j = 0; j < 8; ++j) { const float o = __builtin_bit_cast(float, __builtin_amdgcn_readlane(__builtin_bit_cast(int, gs), 8 * j)); rank += (o > gs || (o == gs && j < mygrp)) ? 1 : 0; }
        if (rank >= 4) {
#pragma unroll
            for (int i = 0; i < 4; ++i) mv[q][i] = -3.0e38f;
        }
    }
    float wsel[2] = {0.f, 0.f}, wsum[2] = {0.f, 0.f}; int esel[2] = {0, 0};
#pragma unroll
    for (int r = 0; r < 8; ++r) {
        unsigned key[2];
#pragma unroll
        for (int q = 0; q < 2; ++q) {
            float bv = mv[q][0]; int bi = 0;
#pragma unroll
            for (int i = 1; i < 4; ++i) if (mv[q][i] > bv) { bv = mv[q][i]; bi = i; }
            unsigned u = __builtin_bit_cast(unsigned, bv); u = (u & 0x80000000u) ? ~u : (u | 0x80000000u);
            key[q] = (u & 0xFFFFFF00u) | (unsigned)(255 - (4 * lane + bi));
        }
        unsigned v0 = key[0], v1 = key[1], t0, t1_;
#define RSTEP(ctrl, rm, bc) t0 = (unsigned)__builtin_amdgcn_update_dpp(0, (int)v0, ctrl, rm, 0xf, bc); t1_ = (unsigned)__builtin_amdgcn_update_dpp(0, (int)v1, ctrl, rm, 0xf, bc); v0 = v0 > t0 ? v0 : t0; v1 = v1 > t1_ ? v1 : t1_;
        RSTEP(0x111, 0xf, true) RSTEP(0x112, 0xf, true) RSTEP(0x114, 0xf, true) RSTEP(0x118, 0xf, true) RSTEP(0x142, 0xa, false) RSTEP(0x143, 0xc, false)
#undef RSTEP
        const unsigned km[2] = {(unsigned)__builtin_amdgcn_readlane((int)v0, 63), (unsigned)__builtin_amdgcn_readlane((int)v1, 63)};
#pragma unroll
        for (int q = 0; q < 2; ++q) {
            const int e = 255 - (int)(km[q] & 255u), ii = e & 3;
            const float cand = ii == 0 ? sc[q][0] : ii == 1 ? sc[q][1] : ii == 2 ? sc[q][2] : sc[q][3];
            const float sv = __builtin_bit_cast(float, __builtin_amdgcn_readlane(__builtin_bit_cast(int, cand), e >> 2));
#pragma unroll
            for (int i = 0; i < 4; ++i) mv[q][i] = (4 * lane + i == e) ? -3.0e38f : mv[q][i];
            wsum[q] += sv;
            if (lane == r) { wsel[q] = sv; esel[q] = e; }
        }
    }
    if (lane < 8) {
#pragma unroll
        for (int q = 0; q < 2; ++q) { tidx[q * 8 + lane] = esel[q]; tw[q * 8 + lane] = wsel[q] / wsum[q] * 2.5f; etab[q * 8 + lane] = esel[q]; }
    }
}

__global__ void __launch_bounds__(NTHR, 2) mk_fwd(Params p) {
    extern __shared__ __attribute__((aligned(16))) unsigned char lds_raw[];
    LAS unsigned char* lds = (LAS unsigned char*)lds_raw;
    int tid = threadIdx.x, lane = tid & 63; const int wave = __builtin_amdgcn_readfirstlane(tid >> 6);
#define FRESH_IDS() do { int _t = threadIdx.x; asm volatile("; fresh ids" : "+v"(_t)); tid = _t; lane = _t & 63; } while (0)
    const int c = blockIdx.x, G = gridDim.x;
    const int gw = c * 8 + wave, ngw = G * 8;
    unsigned char* ws = p.ws;
    volatile LAS unsigned* MISC = (volatile LAS unsigned*)(lds + LDS_MISC);
    for (int u = tid; u < (LDS_BYTES - LDS_MISC) / 4; u += NTHR) ((LAS unsigned*)(lds + LDS_MISC))[u] = 0u;
    __syncthreads();
    XcdBarrier bar; bar.bar = (unsigned*)(ws + WS_BAR); bar.x = 0; bar.st = nullptr;
#if MK_ONE_LAUNCH
    bar = xcd_barrier_post((unsigned*)(ws + WS_BAR), MISC + 8);
#endif
    const int lo = p.ph_lo, hi = p.ph_hi;
#ifndef PH_MASK
#define PH_MASK 0x1ffff
#endif
#define IN(k) (((PH_MASK >> (k)) & 1) && lo <= (k) && (k) < hi)
#define SEAM(k) do { if (IN(k) && IN((k) + 1)) xcd_barrier(bar); } while (0)

    if (IN(0)) { FRESH_IDS(); phase0(p, lds, gw, ngw, lane, wave); }
    SEAM(0);
    if (IN(1)) { FRESH_IDS(); phase1(p, gw, ngw, lane); }
    SEAM(1);
    if (IN(2)) { FRESH_IDS();
        EpiWin E; E.q = (bf16_t*)(ws + WS_BIG(1)); E.k = E.q + (size_t)NTOK * 512; E.v = (bf16_t*)(ws + WS_BIG(2)); E.gr = (bf16_t*)(ws + WS_BIG(3));
        E.cq = (bf16_t*)(ws + WS_BIG(4)); E.ckv = E.cq + (size_t)NTOK * 768;        E.sa = (bf16_t*)(ws + WS_BIG(5)); E.sb = (bf16_t*)(ws + WS_BIG(6));
        E.kr = (bf16_t*)(ws + WS_KR); E.ga = (float*)(ws + WS_GA);
        E.rope = (const float*)((unsigned char*)p.out + 192 * MiB);
        pg8::Gemm g8{(const bf16_t*)(ws + WS_BIG(7)), (const bf16_t*)(ws + WS_WIN), 512, nullptr};
        pg8::StaticOrder S8; S8.init(NTOK, 25 * 256, G, c);
        E.f8 = 1; E.ascale = 1.0f / 32.0f;
        pg8::gemm_phase<EpiWin, pg8::StaticOrder, false, true>(lds, g8, S8, E);
    }
    SEAM(2);
    if (IN(3)) { FRESH_IDS();
#ifndef NO_GLA
        if (c < 128 && !(p.flags & 1)) gla_phase(p, lds, c, (p.flags & 2) != 0);
#endif
#ifndef NO_P3GEMM
        if (!(p.flags & 2) && !(c < 128 && G == 256)) {
            const int npan = (G == 256) ? 2 : 1;
            const unsigned char* cq8 = ws + WS_BIG(4); const unsigned char* ckv8 = cq8 + (size_t)NTOK * 1536;
            {
                float* cqss = (float*)(ws + WS_CQSS); float* ckvss = (float*)(ws + WS_CKVSS);
                for (int pi = 0; pi < npan; ++pi) { const int pm = (G == 256) ? c - 128 + 128 * pi : c;
                for (int r = 0; r < 32; r += 8) { const int row = pm * 256 + wave * 32 + r;
                    unsigned wq[8][3], wk[8];
#pragma unroll
                    for (int u = 0; u < 8; ++u) {
#pragma unroll
                        for (int j = 0; j < 3; ++j) wq[u][j] = *((const unsigned*)(cq8 + (size_t)(row + u) * 768) + lane + 64 * j);
                        wk[u] = *((const unsigned*)(ckv8 + (size_t)(row + u) * 256) + lane); }
#pragma unroll
                    for (int u = 0; u < 8; ++u) { float s = 0.f;
#pragma unroll
                        for (int j = 0; j < 3; ++j) { const f32x2 lo = __builtin_amdgcn_cvt_pk_f32_fp8(wq[u][j], false), hi = __builtin_amdgcn_cvt_pk_f32_fp8(wq[u][j], true); s += (lo[0] * lo[0] + lo[1] * lo[1]) + (hi[0] * hi[0] + hi[1] * hi[1]); }
                        const f32x2 lo = __builtin_amdgcn_cvt_pk_f32_fp8(wk[u], false), hi = __builtin_amdgcn_cvt_pk_f32_fp8(wk[u], true); const float t = (lo[0] * lo[0] + lo[1] * lo[1]) + (hi[0] * hi[0] + hi[1] * hi[1]);
                        const float s1 = wave_sum(s), s2 = wave_sum(t); if (lane == 0) { cqss[row + u] = s1; ckvss[row + u] = s2; } } } }
                wg_global_sync();
            }
#ifndef NO_QF
            {
                EpiQF E{(bf16_t*)p.out, (const float*)(ws + WS_CQSS), (const float*)((unsigned char*)p.out + 192 * MiB)};
                pg8::Gemm g{(const bf16_t*)cq8, (const bf16_t*)(ws + WS_WUQ), 384, nullptr};
                for (int pi = 0; pi < npan; ++pi) { const int pm = (G == 256) ? c - 128 + 128 * pi : c; pg8::PanelOrder S{pm, 6, 0}; pg8::gemm_phase<EpiQF, pg8::PanelOrder, false, true>(lds, g, S, E); }
            }
#endif
#ifndef NO_KV
            for (int pi = 0; pi < npan; ++pi) { const int pm = (G == 256) ? c - 128 + 128 * pi : c;
              const K256Store E{(bf16_t*)(ws + WS_BIG(0)), 1024, (const float*)(ws + WS_CKVSS), 1.0f / 256.0f, (bf16_t*)(ws + WS_BIG(7)), 1024, 0};
              gemm_k256_f8(lds, ckv8 + (size_t)pm * 65536, ws + WS_WUKV, 16, pm * 256, nullptr, 0, 1.0f / 32.0f, &E); }
#endif
        }
#endif
    }
    SEAM(3);
    if (IN(4)) { FRESH_IDS(); attn_phase(p, lds, c); }
    SEAM(4);
    if (IN(5)) { FRESH_IDS();
        LAS int* hist = (LAS int*)lds;
        { const int pm = c;
            bf16_t* Y = (bf16_t*)(ws + WS_BIG(2));
            { pg8::Gemm g{(const bf16_t*)(ws + WS_BIG(5) + 64 * MiB), (const bf16_t*)(ws + WS_WGLAO), 512, nullptr}; pg8::PanelOrder S{pm, 4, 0};
              EpiGate<false> E{Y, (const unsigned char*)(ws + WS_BIG(5)), nullptr, 1.0f / 32.0f}; pg8::gemm_phase<EpiGate<false>, pg8::PanelOrder, false, true>(lds, g, S, E); }
            { pg8::Gemm g{(const bf16_t*)(ws + WS_BIG(1)), (const bf16_t*)(ws + WS_WMLAO), 512, nullptr}; pg8::PanelOrder S{pm, 4, 0};
              EpiGate<true> E{Y, (const unsigned char*)(ws + WS_BIG(6)), ws + WS_BIG(6) + 64 * MiB, 1.0f / 32.0f};   pg8::gemm_phase<EpiGate<true>, pg8::PanelOrder, false, true>(lds, g, S, E); }
            wg_global_sync();
            { pg8::Gemm g{(const bf16_t*)(ws + WS_BIG(6) + 64 * MiB), (const bf16_t*)(ws + WS_WOUT), 512, nullptr}; pg8::PanelOrder S{pm, 4, 0};
              EpiBf16 E{(bf16_t*)p.out + 1024, 2048, 1.0f / 32.0f};   pg8::gemm_phase<EpiBf16, pg8::PanelOrder, false, true>(lds, g, S, E); }
            wg_global_sync();
            if (!(p.flags & 4)) {
                const int b = pm >> 3; const float* mod = (const float*)(ws + WS_MOD) + b * 6144;
                const bf16_t* mix = (const bf16_t*)p.out + 1024; bf16_t* h2 = (bf16_t*)(ws + WS_BIG(4));
                f32x4 g1[4], gg[4], gb[4], s2v[4], h2v[4];
#pragma unroll
                for (int j = 0; j < 4; ++j) { const int ci = lane + 64 * j; g1[j] = ((const f32x4*)(mod + 2048))[ci] + 1.0f; gg[j] = ((const f32x4*)p.in[I_LN1G])[ci]; gb[j] = ((const f32x4*)p.in[I_LN1B])[ci];
                    s2v[j] = ((const f32x4*)(mod + 4096))[ci] + 1.0f; h2v[j] = ((const f32x4*)(mod + 3072))[ci]; }
                for (int r0 = 0; r0 < 32; r0 += 4) {
                    const int row0 = pm * 256 + wave * 32 + r0;
                    f32x4 v[4][4]; u32x2 mw[4][4];
#pragma unroll
                    for (int t = 0; t < 4; ++t)
#pragma unroll
                        for (int j = 0; j < 4; ++j) { v[t][j] = ((const f32x4*)(p.in[I_X] + (size_t)(row0 + t) * 1024))[lane + 64 * j]; mw[t][j] = ((const u32x2*)(mix + (size_t)(row0 + t) * 2048))[lane + 64 * j]; }
#pragma unroll
                    for (int t = 0; t < 4; ++t) {
                        float s = 0.f;
#pragma unroll
                        for (int j = 0; j < 4; ++j) { const u32x2 w = mw[t][j]; v[t][j] = v[t][j] * ALPHA + g1[j] * (f32x4){bflo(w.x), bfhi(w.x), bflo(w.y), bfhi(w.y)}; s += (v[t][j][0] + v[t][j][1]) + (v[t][j][2] + v[t][j][3]); }
                        const float mean = wave_sum(s) * (1.f / 1024.f); float q = 0.f;
#pragma unroll
                        for (int j = 0; j < 4; ++j) { v[t][j] = v[t][j] - mean; q += (v[t][j][0] * v[t][j][0] + v[t][j][1] * v[t][j][1]) + (v[t][j][2] * v[t][j][2] + v[t][j][3] * v[t][j][3]); }
                        const float rstd = rsqrtf(wave_sum(q) * (1.f / 1024.f) + LN_EPS);
#pragma unroll
                        for (int j = 0; j < 4; ++j) { const f32x4 x1 = v[t][j] * rstd * gg[j] + gb[j];
                            { u32x2 xw; xw.x = pk2(x1[0], x1[1]); xw.y = pk2(x1[2], x1[3]); ((u32x2*)(p.out + (size_t)(row0 + t) * 1024))[lane + 64 * j] = xw; }
                            const f32x4 hh = x1 * s2v[j] + h2v[j]; u32x2 w; w.x = pk2(hh[0], hh[1]); w.y = pk2(hh[2], hh[3]);
                            ((u32x2*)(h2 + (size_t)(row0 + t) * 1024))[lane + 64 * j] = w;
                            unsigned w8 = 0u; w8 = __builtin_amdgcn_cvt_pk_fp8_f32(hh[0], hh[1], w8, false); w8 = __builtin_amdgcn_cvt_pk_fp8_f32(hh[2], hh[3], w8, true);
                            ((unsigned*)(ws + WS_BIG(6) + 64 * MiB + (size_t)(row0 + t) * 1024))[lane + 64 * j] = w8; }
                    }
                }
            }
            wg_global_sync();
            { pg8::Gemm g{(const bf16_t*)(ws + WS_BIG(4)), (const bf16_t*)(ws + WS_WRT), 1024, nullptr}; pg8::PanelOrder S{pm, 1, 0};
              EpiF32 E{(float*)(ws + WS_BIG(3)), 256}; pg8::gemm_phase<EpiF32, pg8::PanelOrder, false>(lds, g, S, E); }
            { pg8::Gemm g{(const bf16_t*)(ws + WS_BIG(6) + 64 * MiB), (const bf16_t*)(ws + WS_WS13), 512, nullptr}; pg8::PanelOrder S{pm, 2, 0};
              EpiGLU E{(bf16_t*)(ws + WS_BIG(0) + 64 * MiB), 1.0f / 32.0f, 1}; pg8::gemm_phase<EpiGLU, pg8::PanelOrder, false, true>(lds, g, S, E); }
            wg_global_sync();
            { const K256Store E{(bf16_t*)(ws + WS_BIG(7)), 1024, nullptr, 0.f, nullptr, 0, 0};
              gemm_k256_f8(lds, ws + WS_BIG(0) + 64 * MiB + (size_t)pm * 65536, ws + WS_WS2, 8, pm * 256, nullptr, 0, 1.0f / 32.0f, &E); }
        }
    }
    SEAM(5);
    if (IN(6)) { FRESH_IDS();
        const int pm = c;
        LAS unsigned* scr = (LAS unsigned*)(lds + 8192 + wave * 8448);
        LAS int* hist = (LAS int*)lds;
        LAS int* etab = (LAS int*)(lds + 81920);
        LAS int* lrk = (LAS int*)(lds + 90112);
        unsigned char* e13 = ws + WS_BIG(5); unsigned char* e2 = ws + WS_BIG(0);
        int pi = 0; f32x4 bb = *(const f32x4*)(p.in[I_BRT] + 4 * lane); asm volatile("s_waitcnt vmcnt(0)" : "+v"(bb) :: "memory");
        const int ng = lane & 15, kr = lane >> 4;
        for (int it = gw; it < 256 * 192; it += ngw) {
            const int e = it / 192, r = it % 192;
            const float* src; int K; unsigned char* dst;
            if (r < 128) { const int kb = r >> 3, nb = r & 7; const float* W = ((ng & 1) ? p.in[I_WE3] : p.in[I_WE1]) + (size_t)e * 262144;
                src = W + (size_t)(64 * kb + 4 * kr) * 256 + 32 * nb + 4 * (ng >> 1); K = 1024; dst = e13 + (size_t)e * 524288 + (size_t)(64 * nb) * 1024 + 64 * kb; }
            else { const int r2 = r - 128, kb = r2 >> 4, nb = r2 & 15;
                src = p.in[I_WE2] + (size_t)e * 262144 + (size_t)(hid_kperm(64 * kb) + (kr & 1) * 64 + (kr >> 1) * 4) * 1024 + 64 * nb + 4 * ng; K = 256; dst = e2 + (size_t)e * 262144 + (size_t)(64 * nb) * 256 + 64 * kb; }
            const bool rt = pi < 16; const int rl = wave * 32 + 2 * (rt ? pi : 0), row = pm * 256 + rl; ++pi;
            f32x4 lg0, lg1;
            { const f32x4* lp = (const f32x4*)((const float*)(ws + WS_BIG(3)) + (size_t)row * 256) + lane;
              asm volatile("global_load_dwordx4 %0, %2, off\n\tglobal_load_dwordx4 %1, %2, off offset:1024" : "=&v"(lg0), "=&v"(lg1) : "v"(lp) : "memory"); }
            f32x4 w[4][4];
            if (r < 128) {
#pragma unroll
                for (int jj = 0; jj < 4; ++jj)
#pragma unroll
                    for (int j = 0; j < 4; ++j) w[jj][j] = *(const f32x4*)(src + (size_t)(16 * jj + j) * 256);
            } else {
#pragma unroll
                for (int jj = 0; jj < 4; ++jj)
#pragma unroll
                    for (int j = 0; j < 4; ++j) w[jj][j] = *(const f32x4*)(src + (size_t)((jj & 1) * 8 + (jj >> 1) * 16 + j) * 1024);
            }
            asm volatile("s_waitcnt vmcnt(16)" : "+v"(lg0), "+v"(lg1) :: "memory");
            if (rt) route_row2(lg0, lg1, bb, (int*)(ws + WS_TIDX) + row * 8, (float*)(ws + WS_TW) + row * 8, etab + rl * 8, lane);
#pragma unroll
            for (int jj = 0; jj < 4; ++jj)
#pragma unroll
                for (int i = 0; i < 4; ++i) { unsigned d = 0u; d = __builtin_amdgcn_cvt_pk_fp8_f32(w[jj][0][i] * 32.0f, w[jj][1][i] * 32.0f, d, false); d = __builtin_amdgcn_cvt_pk_fp8_f32(w[jj][2][i] * 32.0f, w[jj][3][i] * 32.0f, d, true);
                    scr[(kr + 4 * jj) * 65 + 4 * ng + i] = d; }
            LDS_WAIT(); asm volatile("" ::: "memory");
#pragma unroll
            for (int j = 0; j < 4; ++j) { const int id = lane + 64 * j, nn = id >> 2, cc = id & 3;
                u32x4 o; o.x = scr[(4 * cc + 0) * 65 + nn]; o.y = scr[(4 * cc + 1) * 65 + nn]; o.z = scr[(4 * cc + 2) * 65 + nn]; o.w = scr[(4 * cc + 3) * 65 + nn];
                *(u32x4*)(dst + (size_t)nn * K + 16 * cc) = o; }
            LDS_WAIT(); asm volatile("" ::: "memory");
        }
        for (; pi < 16; ++pi) { const int rl = wave * 32 + 2 * pi, row = pm * 256 + rl; const f32x4* lp = (const f32x4*)((const float*)(ws + WS_BIG(3)) + (size_t)row * 256) + lane;
            route_row2(lp[0], lp[64], bb, (int*)(ws + WS_TIDX) + row * 8, (float*)(ws + WS_TW) + row * 8, etab + rl * 8, lane); }
        if (tid < 256) hist[tid] = 0;
        __syncthreads();
#pragma unroll
        for (int i = 0; i < 4; ++i) { const int a2 = tid + 512 * i; lrk[a2] = __hip_atomic_fetch_add(hist + etab[a2], 1, __ATOMIC_RELAXED, __HIP_MEMORY_SCOPE_WORKGROUP); }
        __syncthreads();
        if (tid < 256) ((int*)(ws + WS_CNTWG))[pm * 256 + tid] = hist[tid];
#pragma unroll
        for (int i = 0; i < 4; ++i) ((int*)(ws + WS_LRANK))[pm * 2048 + tid + 512 * i] = lrk[tid + 512 * i];
        __syncthreads();
    }
    SEAM(6);
    if (IN(7)) { FRESH_IDS();
        LAS int* pstart = (LAS int*)lds;
        LAS int* wbase = (LAS int*)(lds + 2048);
        LAS int* tot = (LAS int*)(lds + 4096);
        const int* cntwg = (const int*)(ws + WS_CNTWG);
        const int pm = c;
        {
            LAS int* part_t = (LAS int*)(lds + 8192); LAS int* part_b = (LAS int*)(lds + 10240);
            const int e = tid & 255, w0 = (tid >> 8) * 128; int t = 0, bs = 0;
            for (int wb = 0; wb < 128; wb += 16) { int v[16];
#pragma unroll
                for (int u = 0; u < 16; ++u) v[u] = cntwg[(w0 + wb + u) * 256 + e];
#pragma unroll
                for (int u = 0; u < 16; ++u) { t += v[u]; bs += (w0 + wb + u < pm) ? v[u] : 0; } }
            part_t[tid] = t; part_b[tid] = bs;
            __syncthreads();
            if (tid < 256) { tot[tid] = part_t[tid] + part_t[256 + tid]; wbase[tid] = part_b[tid] + part_b[256 + tid]; }
        }
        __syncthreads();
        if (tid < 64) {
            int pq[4];
#pragma unroll
            for (int i = 0; i < 4; ++i) pq[i] = (tot[4 * tid + i] + 255) & ~255;
            const int loc = (pq[0] + pq[1]) + (pq[2] + pq[3]); int inc = loc;
#pragma unroll
            for (int d = 1; d < 64; d <<= 1) { const int o = __shfl_up(inc, d); if (tid >= d) inc += o; }
            const int base = inc - loc;
            pstart[4 * tid] = base; pstart[4 * tid + 1] = base + pq[0]; pstart[4 * tid + 2] = base + pq[0] + pq[1]; pstart[4 * tid + 3] = base + pq[0] + pq[1] + pq[2];
            if (tid == 63) pstart[256] = inc;
        }
        __syncthreads();
        if (pm == 0 && tid <= 256) ((int*)(ws + WS_TAB))[tid] = pstart[tid];
        const int* tidx = (const int*)(ws + WS_TIDX); int* lrank = (int*)(ws + WS_LRANK);
        int* stok = (int*)(ws + WS_STOK);
#pragma unroll
        for (int i = 0; i < 4; ++i) { const int a = pm * 2048 + tid * 4 + i; const int e = tidx[a]; const int slot = pstart[e] + wbase[e] + lrank[a]; stok[slot] = a >> 3; ((int*)(ws + WS_SW))[a] = slot; }
        __syncthreads();
    }
    SEAM(7);
    const bf16_t* ffn = (const bf16_t*)(ws + WS_BIG(7));
    unsigned char* out8 = ws + WS_BIG(0) + 64 * MiB;
    bf16_t* hidscr = c < 192 ? (bf16_t*)(ws + WS_WIN) + (size_t)c * 65536 : (bf16_t*)(ws + WS_KR) + (size_t)(c - 192) * 65536;
    if (IN(8)) { FRESH_IDS();
        LAS int* pstart = (LAS int*)(lds + LDS_MISC + 256);
        for (int i = tid; i <= 256; i += NTHR) pstart[i] = ((const int*)(ws + WS_TAB))[i];
        __syncthreads();
        const int ntiles = pstart[256] >> 8;
        for (int T = (c & 7) * 32 + (c >> 3); T < ntiles; T += G) {
            int e = 0; { int lo_ = 0, hi_ = 256; while (hi_ - lo_ > 1) { const int mid = (lo_ + hi_) >> 1; if ((pstart[mid] >> 8) <= T) lo_ = mid; else hi_ = mid; } e = lo_; }
            e = __builtin_amdgcn_readfirstlane(e);
            if (!(p.flags & 32)) { pg8::Gemm g{(const bf16_t*)(ws + WS_BIG(6) + 64 * MiB), (const bf16_t*)(ws + WS_BIG(5)) + (size_t)e * 262144, 512, (const int*)(ws + WS_STOK)}; pg8::PanelOrder S{T, 2, 0};
              EpiGLU E{(bf16_t*)((unsigned char*)hidscr - (ptrdiff_t)T * 65536), 1.0f / 32.0f, 1}; pg8::gemm_phase<EpiGLU, pg8::PanelOrder, true, true>(lds, g, S, E); }
            wg_global_sync();
            if (!(p.flags & 64)) gemm_k256_f8(lds, (const unsigned char*)hidscr, ws + WS_BIG(0) + (size_t)e * 262144, 8, T * 256, out8, 1024, 1.0f / 32.0f);
        }
    }
    SEAM(8);
    if (IN(9)) { FRESH_IDS();
        const int* slot_of = (const int*)(ws + WS_SW); const float* tw = (const float*)(ws + WS_TW);
#define F8_ACC(dst, w16, wk) do { const u32x4 w_ = (w16); const float k_ = (wk); _Pragma("unroll") for (int j_ = 0; j_ < 4; ++j_) { \
            const f32x2 lo_ = __builtin_amdgcn_cvt_pk_f32_fp8(w_[j_], false), hi_ = __builtin_amdgcn_cvt_pk_f32_fp8(w_[j_], true); \
            dst[j_] += (f32x4){lo_[0], lo_[1], hi_[0], hi_[1]} * k_; } } while (0)
        int sl_n = 0; float wv_n = 0.f;
        if (lane < 16 && gw * 2 < NTOK) { sl_n = slot_of[gw * 16 + lane]; wv_n = tw[gw * 16 + lane]; }
        for (int m0 = gw * 2; m0 < NTOK; m0 += ngw * 2) {
            const int sl = sl_n; const float wv = wv_n * (1.0f / F8_SCALE);
            { const int m1 = m0 + ngw * 2; if (lane < 16 && m1 < NTOK) { sl_n = slot_of[m1 * 8 + lane]; wv_n = tw[m1 * 8 + lane]; } }
            u32x4 rw[2][8]; float rwt[2][8];
#pragma unroll
            for (int t = 0; t < 2; ++t)
#pragma unroll
                for (int q = 0; q < 8; ++q) { const int sk = __shfl(sl, 8 * t + q); rwt[t][q] = __shfl(wv, 8 * t + q); rw[t][q] = __builtin_nontemporal_load((const u32x4*)(out8 + (size_t)sk * 1024) + lane); }
            f32x4 a[2][4], v[2][4];
#pragma unroll
            for (int t = 0; t < 2; ++t) { const u32x4* fr4 = (const u32x4*)(ffn + (size_t)(m0 + t) * 1024) + 2 * lane; const u32x4 f0 = fr4[0], f1 = fr4[1];
                const u32x4* xr4 = (const u32x4*)(p.out + (size_t)(m0 + t) * 1024) + 2 * lane; const u32x4 x0 = xr4[0], x1w = xr4[1];
                unpack8(f0, a[t][0], a[t][1]); unpack8(f1, a[t][2], a[t][3]); unpack8(x0, v[t][0], v[t][1]); unpack8(x1w, v[t][2], v[t][3]); }
            const int b = m0 >> 11; const float* gt2 = (const float*)(ws + WS_MOD) + b * 6144 + 5 * 1024;
            f32x4 gv[4], lg[4], lb[4];
#pragma unroll
            for (int j = 0; j < 4; ++j) { gv[j] = ((const f32x4*)gt2)[4 * lane + j] + 1.0f; lg[j] = ((const f32x4*)p.in[I_LN2G])[4 * lane + j]; lb[j] = ((const f32x4*)p.in[I_LN2B])[4 * lane + j]; }
#pragma unroll
            for (int t = 0; t < 2; ++t) {
#pragma unroll
                for (int q = 0; q < 8; ++q) F8_ACC(a[t], rw[t][q], rwt[t][q]);
                float sacc = 0.f;
#pragma unroll
                for (int j = 0; j < 4; ++j) { v[t][j] = v[t][j] * ALPHA + gv[j] * a[t][j]; sacc += (v[t][j][0] + v[t][j][1]) + (v[t][j][2] + v[t][j][3]); }
                const float mean = wave_sum(sacc) * (1.f / 1024.f); float s2 = 0.f;
#pragma unroll
                for (int j = 0; j < 4; ++j) { v[t][j] = v[t][j] - mean; s2 += (v[t][j][0] * v[t][j][0] + v[t][j][1] * v[t][j][1]) + (v[t][j][2] * v[t][j][2] + v[t][j][3] * v[t][j][3]); }
                const float rstd = rsqrtf(wave_sum(s2) * (1.f / 1024.f) + LN_EPS);
#pragma unroll
                for (int j = 0; j < 4; ++j) ((f32x4*)(p.out + (size_t)(m0 + t) * 1024))[4 * lane + j] = v[t][j] * rstd * lg[j] + lb[j];
            }
        }
#undef F8_ACC
    }
}


__global__ void dump_bf16(const bf16_t* src, float* dst, size_t n) { for (size_t i = (size_t)blockIdx.x * blockDim.x + threadIdx.x; i < n; i += (size_t)gridDim.x * blockDim.x) dst[i] = bf2f(src[i]); }
extern "C" void kernel_launch(void* const* d_in, const int* in_sizes, int n_in, void* d_out, int out_size, void* d_ws, size_t ws_size, hipStream_t stream) {
    static int ready = 0;
    if (!ready) {
        if (n_in != 28 || out_size != NTOK * DM || ws_size < WS_END) { fprintf(stderr, "kernel_launch: unexpected problem (n_in %d out %d ws %zu need %zu)\n", n_in, out_size, ws_size, (size_t)WS_END); return; }
        if (hipFuncSetAttribute((const void*)mk_fwd, hipFuncAttributeMaxDynamicSharedMemorySize, LDS_BYTES) != hipSuccess) { fprintf(stderr, "kernel_launch: hipFuncSetAttribute failed\n"); return; }
        ready = 1;
    }
    (void)hipMemsetAsync((char*)d_ws + WS_CTL, 0, CTL_ZERO_BYTES, stream);
    Params p{};
    for (int i = 0; i < 28; ++i) p.in[i] = (const float*)d_in[i];
    p.out = (float*)d_out; p.ws = (unsigned char*)d_ws;
#if MK_ONE_LAUNCH
    p.ph_lo = 0; p.ph_hi = 10;
    hipLaunchKernelGGL(mk_fwd, dim3(NWG), dim3(NTHR), LDS_BYTES, stream, p);
#else
#ifndef DIAG_NPH
#define DIAG_NPH 10
#endif
#ifndef DIAG_REP_MASK
#define DIAG_REP_MASK 0
#endif
#ifndef DIAG_REP_FLAGS
#define DIAG_REP_FLAGS 1
#endif
    for (int k = 0; k < DIAG_NPH; ++k) { p.ph_lo = k; p.ph_hi = k + 1;
        if (((DIAG_REP_MASK >> k) & 1) && (DIAG_REP_FLAGS & ~31)) { p.flags = DIAG_REP_FLAGS; hipLaunchKernelGGL(mk_fwd, dim3(NWG), dim3(NTHR), LDS_BYTES, stream, p); }
        p.flags = 0; hipLaunchKernelGGL(mk_fwd, dim3(NWG), dim3(NTHR), LDS_BYTES, stream, p);
        if (((DIAG_REP_MASK >> k) & 1) && !(DIAG_REP_FLAGS & ~31)) { p.flags = DIAG_REP_FLAGS; hipLaunchKernelGGL(mk_fwd, dim3(NWG), dim3(NTHR), LDS_BYTES, stream, p); } }
#ifdef DIAG_DUMP
    hipLaunchKernelGGL(dump_bf16, dim3(2048), dim3(256), 0, stream, (const bf16_t*)((unsigned char*)d_ws + DIAG_DUMP), (float*)d_out, (size_t)NTOK * 1024);
#endif
#endif
}
```
